# Optimizing an MI355X kernel written in HIP

```python
import math
import jax, jax.numpy as jnp
from jax import lax
import numpy as np

D_MODEL = 2048
BATCH = 4
SEQ = 2048
DEPTH = 2

CONV_DIM = D_MODEL
CONV_WIDTH = 3
GDN_K_HEADS = 16
GDN_V_HEADS = 32
GDN_K_DIM = D_MODEL // GDN_K_HEADS
GDN_V_DIM = D_MODEL // GDN_V_HEADS
GDN_QK_WIDTH = GDN_K_HEADS * GDN_K_DIM
GDN_V_WIDTH = GDN_V_HEADS * GDN_V_DIM
GDN_CONV_WIDTH = 4
GDN_CHUNK = 64
FOX_HEADS = 16
FOX_DIM = D_MODEL // FOX_HEADS
FOX_WIDTH = FOX_HEADS * FOX_DIM
Q_BLOCK = 128
D_FF = 4 * D_MODEL
LN_EPS = 1e-5
NORM_EPS = 1e-6
DEEPNORM_ALPHA = (2 * DEPTH) ** 0.25
DEEPNORM_BETA = (8 * DEPTH) ** -0.25
SPLIT_SIZES = (CONV_DIM, CONV_DIM, CONV_DIM,
               GDN_QK_WIDTH, GDN_QK_WIDTH, GDN_V_WIDTH, GDN_V_WIDTH,
               GDN_V_HEADS, GDN_V_HEADS,
               FOX_WIDTH, FOX_WIDTH, FOX_WIDTH, FOX_HEADS,
               D_MODEL, D_MODEL, D_MODEL)
IN_WIDTH = sum(SPLIT_SIZES)

kernel_name = 'hybrid_conv_gdn_fox_gated_merge_deepnorm_adaln'


def layer_norm(x, g, b):
    xf = x.astype(jnp.float32)
    mu = jnp.mean(xf, axis=-1, keepdims=True)
    var = jnp.mean(jnp.square(xf - mu), axis=-1, keepdims=True)
    return ((xf - mu) * lax.rsqrt(var + LN_EPS) * g + b).astype(x.dtype)


def causal_depthwise_conv(x, w):
    width = w.shape[0]
    seq = x.shape[1]
    xp = jnp.pad(x, ((0, 0), (width - 1, 0), (0, 0)))
    out = xp[:, 0:seq] * w[0]
    for i in range(1, width):
        out = out + xp[:, i:i + seq] * w[i]
    return out


def l2_normalize(t):
    tf = t.astype(jnp.float32)
    return tf * lax.rsqrt(jnp.sum(tf * tf, axis=-1, keepdims=True) + NORM_EPS)


def short_conv_branch(b_gate, c_gate, h, conv_w):
    return b_gate * causal_depthwise_conv(c_gate * h, conv_w)


def chunked_gated_delta_rule(q, k, v, beta, g):
    bsz, seq, heads, dk = q.shape
    dv = v.shape[-1]
    n_chunks = seq // GDN_CHUNK

    def chunks(t):
        t = t.reshape((bsz, n_chunks, GDN_CHUNK, heads) + t.shape[3:])
        return jnp.moveaxis(t, 3, 1)

    q = chunks(q) * (dk ** -0.5)
    k = chunks(k)
    v = chunks(v)
    beta = chunks(beta)
    g = jnp.cumsum(chunks(g), axis=-1)
    tril = jnp.tril(jnp.ones((GDN_CHUNK, GDN_CHUNK), dtype=bool))
    strict = jnp.tril(jnp.ones((GDN_CHUNK, GDN_CHUNK), dtype=bool), k=-1)
    decay = jnp.exp(jnp.where(tril, g[..., :, None] - g[..., None, :], -jnp.inf))
    k_beta = k * beta[..., None]
    lower = jnp.where(strict, jnp.einsum('bhncd,bhnsd->bhncs', k_beta, k) * decay, 0.0)
    eye = jnp.eye(GDN_CHUNK, dtype=lower.dtype)
    rhs = jnp.concatenate([v * beta[..., None], k_beta * jnp.exp(g)[..., None]], axis=-1)
    sol = lax.linalg.triangular_solve(lower + eye, rhs, left_side=True, lower=True, unit_diagonal=True)
    u = sol[..., :dv]
    w = sol[..., dv:]
    intra = jnp.where(tril, jnp.einsum('bhncd,bhnsd->bhncs', q, k) * decay, 0.0)
    q_decay = q * jnp.exp(g)[..., None]
    k_state = k * jnp.exp(g[..., -1:] - g)[..., None]
    chunk_decay = jnp.exp(g[..., -1])

    def step(state, xs):
        u_i, w_i, qd_i, intra_i, ks_i, cd_i = xs
        v_new = u_i - jnp.einsum('bhck,bhkv->bhcv', w_i, state)
        o_i = jnp.einsum('bhck,bhkv->bhcv', qd_i, state) + jnp.einsum('bhcs,bhsv->bhcv', intra_i, v_new)
        state = state * cd_i[..., None, None] + jnp.einsum('bhck,bhcv->bhkv', ks_i, v_new)
        return state, o_i

    xs = tuple(jnp.moveaxis(t, 2, 0) for t in (u, w, q_decay, intra, k_state, chunk_decay))
    state0 = jnp.zeros((bsz, heads, dk, dv), jnp.float32)
    _, o = lax.scan(step, state0, xs)
    return jnp.transpose(o, (1, 0, 3, 2, 4)).reshape(bsz, seq, heads, dv)


def gated_deltanet_branch(q, k, v, z, b_logit, a_logit, conv_w, a_log, dt_bias, norm_w):
    bsz, seq, _ = q.shape
    qkv = jax.nn.silu(causal_depthwise_conv(jnp.concatenate([q, k, v], axis=-1), conv_w))
    q, k, v = jnp.split(qkv, [GDN_QK_WIDTH, 2 * GDN_QK_WIDTH], axis=-1)
    rep = GDN_V_HEADS // GDN_K_HEADS
    q = jnp.repeat(l2_normalize(q.reshape(bsz, seq, GDN_K_HEADS, GDN_K_DIM)), rep, axis=2)
    k = jnp.repeat(l2_normalize(k.reshape(bsz, seq, GDN_K_HEADS, GDN_K_DIM)), rep, axis=2)
    v = v.reshape(bsz, seq, GDN_V_HEADS, GDN_V_DIM).astype(jnp.float32)
    beta = jax.nn.sigmoid(b_logit.astype(jnp.float32))
    g = -jnp.exp(a_log.astype(jnp.float32)) * jax.nn.softplus(a_logit.astype(jnp.float32) + dt_bias.astype(jnp.float32))
    o = chunked_gated_delta_rule(q, k, v, beta, g)
    o = o * lax.rsqrt(jnp.mean(o * o, axis=-1, keepdims=True) + NORM_EPS) * norm_w
    o = o * jax.nn.silu(z.reshape(bsz, seq, GDN_V_HEADS, GDN_V_DIM).astype(jnp.float32))
    return o.reshape(bsz, seq, GDN_V_WIDTH).astype(z.dtype)


def forgetting_attention_branch(q, k, v, f_logit, f_bias):
    bsz, seq, _ = q.shape

    def heads(t):
        return t.reshape(bsz, seq, FOX_HEADS, FOX_DIM).transpose(0, 2, 1, 3)

    q, k, v = heads(q), heads(k), heads(v)
    log_f = jax.nn.log_sigmoid(f_logit.astype(jnp.float32) + f_bias.astype(jnp.float32))
    cum = jnp.cumsum(log_f, axis=1).transpose(0, 2, 1)
    scale = FOX_DIM ** -0.5
    outs = []
    for blk in range(seq // Q_BLOCK):
        q0, q1 = blk * Q_BLOCK, (blk + 1) * Q_BLOCK
        s = jnp.einsum('bhqd,bhkd->bhqk', q[:, :, q0:q1], k[:, :, :q1],
                       preferred_element_type=jnp.float32) * scale
        s = s + cum[:, :, q0:q1, None] - cum[:, :, None, :q1]
        causal = (q0 + jnp.arange(Q_BLOCK))[:, None] >= jnp.arange(q1)[None, :]
        p = jax.nn.softmax(jnp.where(causal, s, -jnp.inf), axis=-1)
        outs.append(jnp.einsum('bhqk,bhkd->bhqd', p.astype(v.dtype), v[:, :, :q1]))
    o = jnp.concatenate(outs, axis=2)
    return o.transpose(0, 2, 1, 3).reshape(bsz, seq, FOX_WIDTH)


def setup_inputs(seed: int = 0) -> dict:
    key = jax.random.key(seed)
    ks = jax.random.split(key, 24)
    f32 = jnp.float32

    def nrm(k, shape, scale):
        return jax.random.normal(k, shape, f32) * scale

    x = nrm(ks[0], (BATCH, SEQ, D_MODEL), 1.0)
    c = nrm(ks[1], (BATCH, D_MODEL), 1.0)
    w_ada = nrm(ks[2], (DEPTH, D_MODEL, 6 * D_MODEL), 0.5 * D_MODEL ** -0.5)
    b_ada = nrm(ks[3], (DEPTH, 6 * D_MODEL), 0.02)
    w_in = nrm(ks[4], (DEPTH, D_MODEL, IN_WIDTH), D_MODEL ** -0.5)
    conv_w = nrm(ks[5], (DEPTH, CONV_WIDTH, CONV_DIM), CONV_WIDTH ** -0.5)
    gdn_conv_w = nrm(ks[6], (DEPTH, GDN_CONV_WIDTH, 2 * GDN_QK_WIDTH + GDN_V_WIDTH), GDN_CONV_WIDTH ** -0.5)
    gdn_a_log = jnp.log(jax.random.uniform(ks[7], (DEPTH, GDN_V_HEADS), f32, 1.0, 16.0))
    dt = jnp.exp(jax.random.uniform(ks[8], (DEPTH, GDN_V_HEADS), f32, math.log(1e-3), math.log(1e-1)))
    gdn_dt_bias = dt + jnp.log(-jnp.expm1(-dt))
    gdn_norm_w = 1.0 + nrm(ks[9], (DEPTH, GDN_V_DIM), 0.02)
    fox_f_bias = jax.random.uniform(ks[10], (DEPTH, FOX_HEADS), f32, 1.0, 4.0)
    w_branch_a = nrm(ks[11], (DEPTH, CONV_DIM, D_MODEL), DEEPNORM_BETA * CONV_DIM ** -0.5)
    w_branch_b = nrm(ks[12], (DEPTH, GDN_V_WIDTH, D_MODEL), DEEPNORM_BETA * GDN_V_WIDTH ** -0.5)
    w_branch_c = nrm(ks[13], (DEPTH, FOX_WIDTH, D_MODEL), DEEPNORM_BETA * FOX_WIDTH ** -0.5)
    w_o = nrm(ks[14], (DEPTH, D_MODEL, D_MODEL), DEEPNORM_BETA * D_MODEL ** -0.5)
    ln1_g = 1.0 + nrm(ks[15], (DEPTH, D_MODEL), 0.02)
    ln1_b = nrm(ks[16], (DEPTH, D_MODEL), 0.02)
    w_ff1 = nrm(ks[17], (DEPTH, D_MODEL, D_FF), D_MODEL ** -0.5)
    w_ff2 = nrm(ks[18], (DEPTH, D_FF, D_MODEL), DEEPNORM_BETA * D_FF ** -0.5)
    ln2_g = 1.0 + nrm(ks[19], (DEPTH, D_MODEL), 0.02)
    ln2_b = nrm(ks[20], (DEPTH, D_MODEL), 0.02)
    return {'x': x, 'c': c, 'w_ada': w_ada, 'b_ada': b_ada, 'w_in': w_in, 'conv_w': conv_w,
            'gdn_conv_w': gdn_conv_w, 'gdn_a_log': gdn_a_log, 'gdn_dt_bias': gdn_dt_bias,
            'gdn_norm_w': gdn_norm_w, 'fox_f_bias': fox_f_bias, 'w_branch_a': w_branch_a,
            'w_branch_b': w_branch_b, 'w_branch_c': w_branch_c, 'w_o': w_o, 'ln1_g': ln1_g,
            'ln1_b': ln1_b, 'w_ff1': w_ff1, 'w_ff2': w_ff2, 'ln2_g': ln2_g, 'ln2_b': ln2_b}


def reference(x, c, w_ada, b_ada, w_in, conv_w, gdn_conv_w, gdn_a_log, gdn_dt_bias, gdn_norm_w,
              fox_f_bias, w_branch_a, w_branch_b, w_branch_c, w_o, ln1_g, ln1_b, w_ff1, w_ff2,
              ln2_g, ln2_b):
    split_points = np.cumsum(SPLIT_SIZES)[:-1].tolist()
    c_act = jax.nn.silu(c)
    for l in range(DEPTH):
        mod = c_act @ w_ada[l] + b_ada[l]
        shift1, scale1, gate1, shift2, scale2, gate2 = jnp.split(mod[:, None, :], 6, axis=-1)

        u = x * (1 + scale1) + shift1
        (cb, cc, ch, gq, gk, gv, gz, gb, ga, fq, fk, fv, ff, ma, mb, mc) = jnp.split(
            u @ w_in[l], split_points, axis=-1)
        y_a = short_conv_branch(cb, cc, ch, conv_w[l])
        y_b = gated_deltanet_branch(gq, gk, gv, gz, gb, ga, gdn_conv_w[l], gdn_a_log[l],
                                    gdn_dt_bias[l], gdn_norm_w[l])
        y_c = forgetting_attention_branch(fq, fk, fv, ff, fox_f_bias[l])
        merged = (jax.nn.sigmoid(ma) * (y_a @ w_branch_a[l])
                  + jax.nn.sigmoid(mb) * (y_b @ w_branch_b[l])
                  + jax.nn.sigmoid(mc) * (y_c @ w_branch_c[l]))
        x = layer_norm(DEEPNORM_ALPHA * x + gate1 * (merged @ w_o[l]), ln1_g[l], ln1_b[l])

        u = x * (1 + scale2) + shift2
        h = jnp.square(jax.nn.relu(u @ w_ff1[l]))
        x = layer_norm(DEEPNORM_ALPHA * x + gate2 * (h @ w_ff2[l]), ln2_g[l], ln2_b[l])
    return x
```

```cpp
#include <hip/hip_runtime.h>
#include <cstdio>
#include <cstdint>
namespace pg8 {
#define PG8_LAS __attribute__((address_space(3)))
typedef unsigned short bf16_t;
typedef short bf16x8 __attribute__((ext_vector_type(8)));
typedef float f32x4 __attribute__((ext_vector_type(4)));
typedef unsigned u32x4 __attribute__((ext_vector_type(4)));
constexpr int BM = 256, BK = 64, HALF = 128, HTB = HALF * BK * 2  , STAGE_BYTES = 8 * HTB, NXCD = 8, WGM = 8;

__host__ __device__ __forceinline__ int lds_byte(int r, int c) { const int st = (r >> 4) * 2 + (c >> 5), rr = r & 15, cc = c & 31, ob = rr * 64 + cc * 2; return st * 1024 + (ob ^ (((ob >> 9) & 1) << 5)); }
__host__ __device__ __forceinline__ void stage_rc(int b, int& R, int& C) { const int st = b / 1024, sb = b % 1024, swz = sb ^ (((sb >> 9) & 1) << 5); R = (st >> 1) * 16 + swz / 64; C = (st & 1) * 32 + (swz % 64) / 2; }
__host__ __device__ __forceinline__ int perm32(int rho) { const int n = rho >> 4, i = rho & 15; return 8 * (i >> 2) + 4 * n + (i & 3); }

struct Unit { int pm, pn; };
struct Gemm { const bf16_t* A; const bf16_t* Bt; int M, N, K; };

struct StaticOrder {
    int nM, nN, nwg, G, c;
    __host__ __device__ void init(int M, int N, int G_, int c_) { nM = M / BM; nN = N / BM; nwg = nM * nN; G = G_; c = c_; }
    __host__ __device__ bool next(int i, Unit& u) const {
        const long L = (long)i * G + c; if (L >= nwg) return false;
        int wgid = (int)L; { const int q = nwg / NXCD, r = nwg % NXCD, xcd = wgid % NXCD, off = wgid / NXCD; wgid = (xcd < r ? xcd * (q + 1) : r * (q + 1) + (xcd - r) * q) + off; }
        const int nig = WGM * nN, gid = wgid / nig, fm = gid * WGM, gsz = (nM - fm) < WGM ? (nM - fm) : WGM;
        u.pm = fm + ((wgid % nig) % gsz); u.pn = (wgid % nig) / gsz; return true;
    }
    __device__ __forceinline__ void a_ready(const Unit&) const {}
    __device__ __forceinline__ void done(const Unit&) const {}
};

__device__ __forceinline__ unsigned cvt_pk_bf16(float lo, float hi) { unsigned r; asm volatile("v_cvt_pk_bf16_f32 %0, %1, %2" : "=v"(r) : "v"(lo), "v"(hi)); return r; }
typedef float f32x2 __attribute__((ext_vector_type(2)));
__device__ __forceinline__ f32x2 gelu_pk(f32x2 v) {
    const f32x2 av = __builtin_elementwise_abs(v), d = av * 0.2316418882f + 1.0f;
    f32x2 t; t.x = __builtin_amdgcn_rcpf(d.x); t.y = __builtin_amdgcn_rcpf(d.y);
    f32x2 q = t * 0.5307027145f + (-0.7265760135f); q = q * t + 0.7107068705f; q = q * t + (-0.142248368f); q = q * t + 0.127414796f; q = q * t;
    const f32x2 s = (v * v) * (-0.72134752044f);
    f32x2 e; e.x = __builtin_amdgcn_exp2f(s.x); e.y = __builtin_amdgcn_exp2f(s.y);
    const f32x2 m = v * (q * e), r = v - m;
    f32x2 o; o.x = v.x < 0.f ? m.x : r.x; o.y = v.y < 0.f ? m.y : r.y; return o;
}

template <int ACT  > struct EpiBf16 {
    static constexpr bool PERM = true, AFTER_DRAIN = false; static_assert(ACT == 0 || ACT == 1, "EpiBf16: ACT is 0 (none) or 1 (gelu_pk)");
    bf16_t* O; int ldc; const float* bias; int split_cols; size_t split_stride; float scale0;
    __device__ __forceinline__ void operator()(const f32x4 (&acc)[2][2][4][2], const Unit& u, int wr, int wc, int fr, int fq) const {
        const int row0 = u.pm * BM + wr * 64 + fr; int colt = u.pn * BM; bf16_t* base = O;
        float sc = 1.f; if (split_cols) { const int t = colt / split_cols; base += (size_t)t * split_stride; colt -= t * split_cols; if (t == 0) sc = scale0; }
        const int col0 = colt + wc * 32 + 8 * fq, bcol0 = u.pn * BM + wc * 32 + 8 * fq;
        f32x4 bv[2][2];
#pragma unroll
        for (int bj = 0; bj < 2; ++bj)
#pragma unroll
            for (int n = 0; n < 2; ++n) bv[bj][n] = bias ? *(const f32x4*)(bias + bcol0 + bj * HALF + 4 * n) : (f32x4){0.f, 0.f, 0.f, 0.f};
#pragma unroll
        for (int ai = 0; ai < 2; ++ai)
#pragma unroll
            for (int m = 0; m < 4; ++m) { bf16_t* rowp = base + (size_t)(row0 + ai * HALF + m * 16) * ldc + col0;
#pragma unroll
                for (int bj = 0; bj < 2; ++bj) { f32x4 v0 = acc[ai][bj][m][0] + bv[bj][0], v1 = acc[ai][bj][m][1] + bv[bj][1];
                    if (ACT == 1) { f32x2 a = gelu_pk((f32x2){v0[0], v0[1]}), b = gelu_pk((f32x2){v0[2], v0[3]}), c = gelu_pk((f32x2){v1[0], v1[1]}), d = gelu_pk((f32x2){v1[2], v1[3]});
                        v0 = (f32x4){a.x, a.y, b.x, b.y}; v1 = (f32x4){c.x, c.y, d.x, d.y}; }
                    v0 = v0 * sc; v1 = v1 * sc; u32x4 w; w.x = cvt_pk_bf16(v0[0], v0[1]); w.y = cvt_pk_bf16(v0[2], v0[3]); w.z = cvt_pk_bf16(v1[0], v1[1]); w.w = cvt_pk_bf16(v1[2], v1[3]);
                    *(u32x4*)(rowp + bj * HALF) = w; } }
    }
};


template <class Epi, class Sched, bool ALIGN_EPI = false, bool SP2 = false>
__device__ __forceinline__ void gemm_phase(PG8_LAS unsigned char* lds, const Gemm g, const Sched& S, const Epi& E) {
    int tid_l = threadIdx.x; asm volatile("" : "+v"(tid_l));
    const int tid = tid_l, wid = __builtin_amdgcn_readfirstlane(tid >> 6), lane = tid & 63, wr = wid >> 2, wc = wid & 3, fr = lane & 15, fq = lane >> 4;
    const int K = g.K, nt = K / BK;
    unsigned voffA[2], voffB[2];
#pragma unroll
    for (int i = 0; i < 2; ++i) { int R, C; stage_rc(tid * 16 + i * 8192, R, C); const int Rb = Epi::PERM ? ((R & ~31) + perm32(R & 31)) : R;
        voffA[i] = (unsigned)(R * K + C) * 2u; voffB[i] = (unsigned)(Rb * K + C) * 2u; }
    const size_t kstep = (size_t)(BK * 2);
    const size_t hstep = (size_t)HALF * K * 2;
    const size_t tstep = 2 * hstep;
    const unsigned ldsw = (unsigned)wid * 1024u;
    const int aoff = lds_byte(wr * 64 + fr, fq * 8), boff = lds_byte(wc * 32 + fr, fq * 8);
#define PG8_SA(b, h) (((b) * 2 + (h)) * HTB)
#define PG8_SB(b, h) ((4 + (b) * 2 + (h)) * HTB)
#define PG8_STAGE(bufoff, gbase, voff) do { _Pragma("unroll") for (int _i = 0; _i < 2; ++_i) \
        __builtin_amdgcn_global_load_lds((const unsigned*)((const char*)(gbase) + (voff)[_i]), (PG8_LAS unsigned*)(lds + (bufoff) + ldsw + _i * 8192), 16, 0, 0); } while (0)
#define PG8_LDA(dst, b, h) do { _Pragma("unroll") for (int m = 0; m < 4; ++m) _Pragma("unroll") for (int k = 0; k < 2; ++k) dst[m][k] = *(const PG8_LAS bf16x8*)(lds + PG8_SA(b, h) + aoff + m * 2048 + k * 1024); } while (0)
#define PG8_LDB(dst, b, h) do { _Pragma("unroll") for (int n = 0; n < 2; ++n) _Pragma("unroll") for (int k = 0; k < 2; ++k) dst[n][k] = *(const PG8_LAS bf16x8*)(lds + PG8_SB(b, h) + boff + n * 2048 + k * 1024); } while (0)
#define PG8_MMA(ai, bj, At, Bt) do { __builtin_amdgcn_s_setprio(1); _Pragma("unroll") for (int m = 0; m < 4; ++m) _Pragma("unroll") for (int n = 0; n < 2; ++n) _Pragma("unroll") for (int k = 0; k < 2; ++k) \
        acc[ai][bj][m][n] = __builtin_amdgcn_mfma_f32_16x16x32_bf16(Bt[n][k], At[m][k], acc[ai][bj][m][n], 0, 0, 0); __builtin_amdgcn_s_setprio(0); } while (0)
#define PG8_WAIT_V(n) asm volatile("s_waitcnt vmcnt(" #n ")" ::: "memory")
#define PG8_WAIT_L(n) asm volatile("s_waitcnt lgkmcnt(" #n ")" ::: "memory")
#define PG8_BAR __builtin_amdgcn_s_barrier()
#define PG8_SCHED __builtin_amdgcn_sched_barrier(0)
    Unit cur, nxt; int ui = 0;
    if (!S.next(0, cur)) return;
    f32x4 acc[2][2][4][2];
#pragma unroll
    for (int a = 0; a < 2; ++a)
#pragma unroll
        for (int b = 0; b < 2; ++b)
#pragma unroll
            for (int m = 0; m < 4; ++m)
#pragma unroll
                for (int n = 0; n < 2; ++n) acc[a][b][m][n] = (f32x4){0.f, 0.f, 0.f, 0.f};
    bf16x8 At[4][2], B0[2][2], B1[2][2];
    const char* cA = (const char*)g.A + (size_t)cur.pm * tstep; const char* cB = (const char*)g.Bt + (size_t)cur.pn * tstep;
    S.a_ready(cur);
    if constexpr (SP2) {
        PG8_STAGE(PG8_SB(0, 0), cB, voffB); PG8_STAGE(PG8_SB(0, 1), cB + hstep, voffB); PG8_STAGE(PG8_SA(0, 0), cA, voffA); PG8_STAGE(PG8_SA(0, 1), cA + hstep, voffA);
        if (wr == 1) PG8_BAR;
        PG8_WAIT_V(2); PG8_BAR;
        PG8_STAGE(PG8_SB(1, 0), cB + kstep, voffB); PG8_STAGE(PG8_SA(1, 0), cA + kstep, voffA); PG8_STAGE(PG8_SB(1, 1), cB + hstep + kstep, voffB);
        PG8_WAIT_V(6); PG8_BAR;
    } else {
        PG8_STAGE(PG8_SB(0, 0), cB, voffB); PG8_STAGE(PG8_SA(0, 0), cA, voffA); PG8_STAGE(PG8_SB(0, 1), cB + hstep, voffB); PG8_STAGE(PG8_SA(0, 1), cA + hstep, voffA);
        if (wr == 1) PG8_BAR;
        PG8_WAIT_V(4); PG8_BAR;
        PG8_STAGE(PG8_SB(1, 0), cB + kstep, voffB); PG8_STAGE(PG8_SA(1, 0), cA + kstep, voffA); PG8_STAGE(PG8_SB(1, 1), cB + hstep + kstep, voffB);
        PG8_WAIT_V(6); PG8_BAR;
    }
    for (;;) {
        const bool has_next = S.next(ui + 1, nxt);
        const char* nA = has_next ? (const char*)g.A + (size_t)nxt.pm * tstep : cA; const char* nB = has_next ? (const char*)g.Bt + (size_t)nxt.pn * tstep : cB;
        for (int t = 0; t < nt; t += 2) {
            const bool last = (t == nt - 2);
            const char* a1 = cA + (size_t)(t + 1) * kstep;
            const char* a2 = last ? nA : cA + (size_t)(t + 2) * kstep; const char* b2 = last ? nB : cB + (size_t)(t + 2) * kstep;
            const char* a3 = a2 + kstep; const char* b3 = b2 + kstep;
            if (last && has_next) S.a_ready(nxt);
            if constexpr (SP2) {
            PG8_LDB(B0, 0, 0); PG8_LDB(B1, 0, 1); PG8_SCHED; PG8_LDA(At, 0, 0); PG8_STAGE(PG8_SA(1, 1), a1 + hstep, voffA);
            PG8_WAIT_V(8); PG8_WAIT_L(0); PG8_BAR; PG8_MMA(0, 0, At, B0); PG8_MMA(0, 1, At, B1); PG8_BAR; PG8_SCHED;
            PG8_LDA(At, 0, 1); PG8_STAGE(PG8_SB(0, 0), b2, voffB); PG8_STAGE(PG8_SB(0, 1), b2 + hstep, voffB); PG8_STAGE(PG8_SA(0, 0), a2, voffA);
            PG8_WAIT_V(8); PG8_WAIT_L(0); PG8_BAR; PG8_MMA(1, 0, At, B0); PG8_MMA(1, 1, At, B1); PG8_BAR; PG8_SCHED;
            PG8_LDB(B0, 1, 0); PG8_LDB(B1, 1, 1); PG8_SCHED; PG8_LDA(At, 1, 0); PG8_STAGE(PG8_SA(0, 1), a2 + hstep, voffA);
            PG8_WAIT_V(8); PG8_WAIT_L(0); PG8_BAR; PG8_MMA(0, 0, At, B0); PG8_MMA(0, 1, At, B1); PG8_BAR; PG8_SCHED;
            PG8_LDA(At, 1, 1); PG8_STAGE(PG8_SB(1, 0), b3, voffB); PG8_STAGE(PG8_SB(1, 1), b3 + hstep, voffB); PG8_STAGE(PG8_SA(1, 0), a3, voffA);
            PG8_WAIT_V(8); PG8_WAIT_L(0); PG8_BAR; PG8_MMA(1, 0, At, B0); PG8_MMA(1, 1, At, B1); PG8_BAR; PG8_SCHED;
            } else {
            PG8_LDB(B0, 0, 0); PG8_SCHED; PG8_LDA(At, 0, 0); PG8_STAGE(PG8_SA(1, 1), a1 + hstep, voffA);
            PG8_WAIT_L(8); PG8_BAR; PG8_WAIT_L(0); PG8_MMA(0, 0, At, B0); PG8_BAR; PG8_SCHED;
            PG8_LDB(B1, 0, 1); PG8_STAGE(PG8_SB(0, 0), b2, voffB);
            PG8_BAR; PG8_WAIT_L(0); PG8_MMA(0, 1, At, B1); PG8_BAR;
            PG8_LDA(At, 0, 1); PG8_STAGE(PG8_SA(0, 0), a2, voffA);
            PG8_BAR; PG8_WAIT_L(0); PG8_MMA(1, 0, At, B0); PG8_BAR; PG8_SCHED;
            PG8_STAGE(PG8_SB(0, 1), b2 + hstep, voffB);
            PG8_WAIT_V(6); PG8_BAR; PG8_MMA(1, 1, At, B1); PG8_BAR;
            PG8_LDB(B0, 1, 0); PG8_SCHED; PG8_LDA(At, 1, 0); PG8_STAGE(PG8_SA(0, 1), a2 + hstep, voffA);
            PG8_WAIT_L(8); PG8_BAR; PG8_WAIT_L(0); PG8_MMA(0, 0, At, B0); PG8_BAR; PG8_SCHED;
            PG8_LDB(B1, 1, 1); PG8_STAGE(PG8_SB(1, 0), b3, voffB);
            PG8_BAR; PG8_WAIT_L(0); PG8_MMA(0, 1, At, B1); PG8_BAR;
            PG8_LDA(At, 1, 1); PG8_STAGE(PG8_SA(1, 0), a3, voffA);
            PG8_BAR; PG8_WAIT_L(0); PG8_MMA(1, 0, At, B0); PG8_BAR; PG8_SCHED;
            PG8_STAGE(PG8_SB(1, 1), b3 + hstep, voffB);
            PG8_WAIT_V(6); PG8_BAR; PG8_MMA(1, 1, At, B1); PG8_BAR;
            }
        }
        if constexpr (ALIGN_EPI) { if (wr == 0) PG8_BAR; }
        if constexpr (!Epi::AFTER_DRAIN) { E(acc, cur, wr, wc, fr, fq); S.done(cur); }
        if (!has_next) break;
#pragma unroll
        for (int a = 0; a < 2; ++a)
#pragma unroll
            for (int b = 0; b < 2; ++b)
#pragma unroll
                for (int m = 0; m < 4; ++m)
#pragma unroll
                    for (int n = 0; n < 2; ++n) acc[a][b][m][n] = (f32x4){0.f, 0.f, 0.f, 0.f};
        cur = nxt; cA = nA; cB = nB; ++ui;
        if constexpr (ALIGN_EPI) { if (wr == 1) PG8_BAR; }
    }
    PG8_WAIT_V(0);
    if constexpr (!ALIGN_EPI) { if (wr == 0) PG8_BAR; }
    PG8_BAR;
    if constexpr (Epi::AFTER_DRAIN) { E.fused(acc, cur, wr, wc, fr, fq, lds, wid, lane); S.done(cur); }
#undef PG8_SA
#undef PG8_SB
#undef PG8_STAGE
#undef PG8_LDA
#undef PG8_LDB
#undef PG8_MMA
#undef PG8_WAIT_V
#undef PG8_WAIT_L
#undef PG8_BAR
#undef PG8_SCHED
}
}

namespace pg8 {
__device__ __forceinline__ float bf_lo(unsigned w) { return __builtin_bit_cast(float, w << 16); }
__device__ __forceinline__ float bf_hi(unsigned w) { return __builtin_bit_cast(float, w & 0xffff0000u); }
__device__ __forceinline__ float fsigmoid(float x) { return __builtin_amdgcn_rcpf(1.f + __expf(-x)); }

struct EpiInProj {
    static constexpr bool PERM = true, AFTER_DRAIN = false;
    bf16_t* T0; float* SMALL; size_t tstride;
    __device__ __forceinline__ void operator()(const f32x4 (&acc)[2][2][4][2], const Unit& u, int wr, int wc, int fr, int fq) const {
        const int t = u.pn >> 3; const int row0 = u.pm * BM + wr * 64 + fr;
        if (t < 13) {
            bf16_t* base = T0 + (size_t)t * tstride; const int col0 = (u.pn & 7) * BM + wc * 32 + 8 * fq; const bool sg = t >= 10;
#pragma unroll
            for (int ai = 0; ai < 2; ++ai)
#pragma unroll
                for (int m = 0; m < 4; ++m) { bf16_t* rowp = base + (size_t)(row0 + ai * HALF + m * 16) * 2048 + col0;
#pragma unroll
                    for (int bj = 0; bj < 2; ++bj) { f32x4 v0 = acc[ai][bj][m][0], v1 = acc[ai][bj][m][1];
                        if (sg) { v0 = (f32x4){fsigmoid(v0[0]), fsigmoid(v0[1]), fsigmoid(v0[2]), fsigmoid(v0[3])}; v1 = (f32x4){fsigmoid(v1[0]), fsigmoid(v1[1]), fsigmoid(v1[2]), fsigmoid(v1[3])}; }
                        u32x4 w; w.x = cvt_pk_bf16(v0[0], v0[1]); w.y = cvt_pk_bf16(v0[2], v0[3]); w.z = cvt_pk_bf16(v1[0], v1[1]); w.w = cvt_pk_bf16(v1[2], v1[3]);
                        *(u32x4*)(rowp + bj * HALF) = w; } }
        } else {
            const int col0 = wc * 32 + 8 * fq;
#pragma unroll
            for (int ai = 0; ai < 2; ++ai)
#pragma unroll
                for (int m = 0; m < 4; ++m) { float* rowp = SMALL + (size_t)(row0 + ai * HALF + m * 16) * 256 + col0;
#pragma unroll
                    for (int bj = 0; bj < 2; ++bj) { *(f32x4*)(rowp + bj * HALF) = acc[ai][bj][m][0]; *(f32x4*)(rowp + bj * HALF + 4) = acc[ai][bj][m][1]; } }
        }
    }
};

template <int STEP> struct EpiMerge {
    static constexpr bool PERM = true, AFTER_DRAIN = false;
    const bf16_t* G; float* MACC; bf16_t* OUT;
    __device__ __forceinline__ void operator()(const f32x4 (&acc)[2][2][4][2], const Unit& u, int wr, int wc, int fr, int fq) const {
        const int row0 = u.pm * BM + wr * 64 + fr, col0 = u.pn * BM + wc * 32 + 8 * fq;
#pragma unroll
        for (int ai = 0; ai < 2; ++ai)
#pragma unroll
            for (int m = 0; m < 4; ++m) { const size_t ro = (size_t)(row0 + ai * HALF + m * 16) * 2048 + col0;
#pragma unroll
                for (int bj = 0; bj < 2; ++bj) { const size_t o = ro + bj * HALF;
                    const u32x4 g = *(const u32x4*)(G + o);
                    f32x4 r0 = acc[ai][bj][m][0] * (f32x4){bf_lo(g.x), bf_hi(g.x), bf_lo(g.y), bf_hi(g.y)};
                    f32x4 r1 = acc[ai][bj][m][1] * (f32x4){bf_lo(g.z), bf_hi(g.z), bf_lo(g.w), bf_hi(g.w)};
                    if (STEP > 0) { r0 += *(const f32x4*)(MACC + o); r1 += *(const f32x4*)(MACC + o + 4); }
                    if (STEP < 2) { *(f32x4*)(MACC + o) = r0; *(f32x4*)(MACC + o + 4) = r1; }
                    else { u32x4 w; w.x = cvt_pk_bf16(r0[0], r0[1]); w.y = cvt_pk_bf16(r0[2], r0[3]); w.z = cvt_pk_bf16(r1[0], r1[1]); w.w = cvt_pk_bf16(r1[2], r1[3]); *(u32x4*)(OUT + o) = w; } } }
    }
};

struct EpiResid {
    static constexpr bool PERM = false, AFTER_DRAIN = false;
    const float* Xin; const float* gate; float* PRE; float alpha;
    __device__ __forceinline__ void operator()(const f32x4 (&acc)[2][2][4][2], const Unit& u, int wr, int wc, int fr, int fq) const {
        const int row0 = u.pm * BM + wr * 64 + fr, col0 = u.pn * BM + wc * 32 + 4 * fq; const float* gp = gate + (size_t)(u.pm >> 3) * 12288 + col0;
        f32x4 gv[2][2];
#pragma unroll
        for (int bj = 0; bj < 2; ++bj)
#pragma unroll
            for (int n = 0; n < 2; ++n) gv[bj][n] = *(const f32x4*)(gp + bj * HALF + n * 16);
#pragma unroll
        for (int ai = 0; ai < 2; ++ai)
#pragma unroll
            for (int m = 0; m < 4; ++m) { const size_t ro = (size_t)(row0 + ai * HALF + m * 16) * 2048 + col0;
#pragma unroll
                for (int bj = 0; bj < 2; ++bj)
#pragma unroll
                    for (int n = 0; n < 2; ++n) { const size_t o = ro + bj * HALF + n * 16; const f32x4 xv = *(const f32x4*)(Xin + o);
                        *(f32x4*)(PRE + o) = xv * alpha + gv[bj][n] * acc[ai][bj][m][n]; } }
    }
};

struct EpiRelu2 {
    static constexpr bool PERM = true, AFTER_DRAIN = false;
    bf16_t* O; int ldc;
    __device__ __forceinline__ void operator()(const f32x4 (&acc)[2][2][4][2], const Unit& u, int wr, int wc, int fr, int fq) const {
        const int row0 = u.pm * BM + wr * 64 + fr, col0 = u.pn * BM + wc * 32 + 8 * fq;
#pragma unroll
        for (int ai = 0; ai < 2; ++ai)
#pragma unroll
            for (int m = 0; m < 4; ++m) { bf16_t* rowp = O + (size_t)(row0 + ai * HALF + m * 16) * ldc + col0;
#pragma unroll
                for (int bj = 0; bj < 2; ++bj) { f32x4 v0 = acc[ai][bj][m][0], v1 = acc[ai][bj][m][1];
                    v0 = __builtin_elementwise_max(v0, (f32x4){0.f, 0.f, 0.f, 0.f}); v1 = __builtin_elementwise_max(v1, (f32x4){0.f, 0.f, 0.f, 0.f}); v0 = v0 * v0; v1 = v1 * v1;
                    u32x4 w; w.x = cvt_pk_bf16(v0[0], v0[1]); w.y = cvt_pk_bf16(v0[2], v0[3]); w.z = cvt_pk_bf16(v1[0], v1[1]); w.w = cvt_pk_bf16(v1[2], v1[3]);
                    *(u32x4*)(rowp + bj * HALF) = w; } }
    }
};
}

#define GAS __attribute__((address_space(1)))
#define LAS __attribute__((address_space(3)))
typedef unsigned short bf16;
typedef unsigned v4u __attribute__((ext_vector_type(4)));
typedef float f32x4 __attribute__((ext_vector_type(4)));
typedef short bf16x8 __attribute__((ext_vector_type(8)));
typedef GAS unsigned gu32;
typedef GAS unsigned long long gu64;
#define RLX_AGENT __ATOMIC_RELAXED, __HIP_MEMORY_SCOPE_AGENT
#define LDS_WAIT() asm volatile("s_waitcnt lgkmcnt(0)" ::: "memory")
#define VM_WAIT() asm volatile("s_waitcnt vmcnt(0)" ::: "memory")
__device__ __forceinline__ unsigned long long rt() { return __builtin_amdgcn_s_memrealtime(); }
__device__ __forceinline__ unsigned f2bf(float f) { unsigned u = __builtin_bit_cast(unsigned, f); return (u + 0x7fffu + ((u >> 16) & 1u)) >> 16; }
__device__ __forceinline__ unsigned pk2(float lo, float hi) { return f2bf(lo) | (f2bf(hi) << 16); }

#define XB_TMO      128
#define XB_XCNT(j)  (256  + 64 * (j))
#define XB_XSUB(j)  (1280 + 64 * (j))
#define XB_XGEN(j)  (2304 + 64 * (j))
#define XB_TOP      3328
#define XB_TOPGEN   3392
#define XCD_BAR_WORDS 3456
#define XB_SPIN_CAP (1u << 18)

__device__ __forceinline__ unsigned xb_ld(unsigned* p)              { return __hip_atomic_load(p, __ATOMIC_RELAXED, __HIP_MEMORY_SCOPE_AGENT); }
__device__ __forceinline__ unsigned xb_add(unsigned* p, unsigned v) { return __hip_atomic_fetch_add(p, v, __ATOMIC_RELAXED, __HIP_MEMORY_SCOPE_AGENT); }
__device__ __forceinline__ unsigned xb_xcc_id() { return (unsigned)__builtin_amdgcn_s_getreg((3 << 11) | 20) & 0xFu; }
#define XB_SPIN(cond, bar) do { unsigned _sp = 0; while (cond) { __builtin_amdgcn_s_sleep(1); \
    if ((++_sp & 255u) == 0u) { if (xb_ld(&(bar)[XB_TMO])) break; if (_sp > XB_SPIN_CAP) { atomicAdd(&(bar)[XB_TMO], 1u); break; } } } } while (0)

struct XcdBarrier {
    unsigned* bar; unsigned x;
    volatile LAS unsigned* st;
};

__device__ __forceinline__ XcdBarrier xcd_barrier_post(unsigned* bar, volatile LAS unsigned* st) {
    XcdBarrier b; b.bar = bar; b.x = xb_xcc_id(); b.st = st;
    if (threadIdx.x == 0) (void)xb_add(&bar[XB_XCNT(b.x)], 1u);
    return b;
}
__device__ __forceinline__ void xcd_barrier_complete(unsigned* bar, unsigned x, unsigned& nloc, unsigned& nx) {
    const unsigned G = gridDim.x * gridDim.y * gridDim.z;
    unsigned sum, cnt, mine, sp = 0u;
    for (;;) {
        sum = 0u; cnt = 0u; mine = 0u;
#pragma unroll
        for (unsigned j = 0; j < 16; ++j) { const unsigned c = xb_ld(&bar[XB_XCNT(j)]); sum += c; cnt += (c > 0u) ? 1u : 0u; mine = (j == x) ? c : mine; }
        if (sum == G) break;
        __builtin_amdgcn_s_sleep(1);
        if ((++sp & 255u) == 0u) { if (xb_ld(&bar[XB_TMO])) break; if (sp > XB_SPIN_CAP) { atomicAdd(&bar[XB_TMO], 1u); break; } }
    }
    nloc = mine > 0u ? mine : 1u; nx = cnt > 0u ? cnt : 1u;
}

__device__ __forceinline__ void xcd_barrier(const XcdBarrier& b) {
    asm volatile("s_waitcnt vmcnt(0)" ::: "memory");
    __syncthreads();
    if (threadIdx.x == 0) {
        unsigned* bar = b.bar;
        __builtin_amdgcn_s_waitcnt(0);
        unsigned nloc = b.st[0], nx = b.st[1];
        if (nloc == 0u) { xcd_barrier_complete(bar, b.x, nloc, nx); b.st[0] = nloc; b.st[1] = nx; }
        const unsigned old = xb_add(&bar[XB_XSUB(b.x)], 1u);
        const unsigned gen = old / nloc;
        if (old + 1u == (gen + 1u) * nloc) {
            __builtin_amdgcn_fence(__ATOMIC_RELEASE, "agent");
            asm volatile("s_waitcnt vmcnt(0)" ::: "memory");
            const unsigned og = xb_add(&bar[XB_TOP], 1u);
            const unsigned tg = og / nx;
            if (og + 1u == (tg + 1u) * nx) xb_add(&bar[XB_TOPGEN], 1u);
            else XB_SPIN(xb_ld(&bar[XB_TOPGEN]) == tg, bar);
            __builtin_amdgcn_fence(__ATOMIC_ACQUIRE, "agent");
            xb_add(&bar[XB_XGEN(b.x)], 1u);
            asm volatile("s_waitcnt vmcnt(0)" ::: "memory");
        } else {
            XB_SPIN(xb_ld(&bar[XB_XGEN(b.x)]) == gen, bar);
            __builtin_amdgcn_fence(__ATOMIC_ACQUIRE, "agent");
            asm volatile("s_waitcnt vmcnt(0)" ::: "memory");
        }
    }
    __syncthreads();
}

constexpr int NWAVES = 8, NT = NWAVES * 64;
constexpr int BATCH = 4, SEQ = 2048, D = 2048, M = BATCH * SEQ, FF = 8192, DEPTH = 2;
constexpr int INW = 26704, NPAD = 26880;
constexpr int MODW = 6 * D;
constexpr float LN_EPS = 1e-5f, NORM_EPS = 1e-6f, ALPHA = 1.4142135623730951f;
constexpr size_t MiB = 1u << 20;
constexpr size_t ACT_E = (size_t)M * D;
constexpr size_t WS_CTL = 0, CTL_ZERO_BYTES = 1 * MiB;
constexpr size_t WS_MODP = 2 * MiB;
constexpr size_t WS_MOD = 8 * MiB;
constexpr size_t WS_SMALL = 10 * MiB;
constexpr size_t WS_CUM = 18 * MiB;
constexpr size_t WS_BETA = 19 * MiB, WS_GG = 20 * MiB;
constexpr size_t WS_W = 32 * MiB;
constexpr size_t W_LAYER = 201 * MiB, W_IN = 0, W_A = 105 * MiB, W_B = 113 * MiB, W_C = 121 * MiB, W_O = 129 * MiB, W_1 = 137 * MiB, W_2 = 169 * MiB;
constexpr size_t WS_U = 448 * MiB;
constexpr size_t WS_X = 480 * MiB;
constexpr size_t WS_PRE = 544 * MiB;
constexpr size_t WS_T = 608 * MiB;
constexpr size_t WS_H = 608 * MiB;
constexpr size_t WS_YA = 1024 * MiB, WS_YB = 1056 * MiB, WS_YC = 1088 * MiB, WS_MG = 1120 * MiB;
constexpr size_t WS_MACC = 1152 * MiB;
constexpr size_t WS_QN = 1216 * MiB, WS_KN = 1280 * MiB, WS_VN = 1344 * MiB, WS_ORAW = 1408 * MiB;
constexpr size_t WS_END = 1472 * MiB;
constexpr int CW_BAR = 4096;
constexpr int LDS_BYTES = 147456, MISC_OFF = 131072 + 320;
enum { TI_CB = 0, TI_CC, TI_CH, TI_GQ, TI_GK, TI_GV, TI_GZ, TI_FQ, TI_FK, TI_FV, TI_MA, TI_MB, TI_MC };
__host__ __device__ constexpr int src_off(int t) { return t < 7 ? 2048 * t : (t < 10 ? 14400 + 2048 * (t - 7) : 20560 + 2048 * (t - 10)); }
constexpr int SRC_GB = 14336, SRC_FF = 20544;
enum { I_X = 0, I_C, I_WADA, I_BADA, I_WIN, I_CONVW, I_GCONVW, I_ALOG, I_DTB, I_GNORMW, I_FBIAS, I_WA, I_WB, I_WC, I_WO, I_LN1G, I_LN1B, I_W1, I_W2, I_LN2G, I_LN2B, N_IN };

typedef unsigned u32x4 __attribute__((ext_vector_type(4)));
typedef unsigned u32x2 __attribute__((ext_vector_type(2)));
__device__ __forceinline__ float wave_sum(float v) {
#pragma unroll
    for (int o = 1; o < 64; o <<= 1) v += __shfl_xor(v, o);
    return v;
}
__device__ __forceinline__ float wave_max(float v) {
#pragma unroll
    for (int o = 1; o < 64; o <<= 1) v = fmaxf(v, __shfl_xor(v, o));
    return v;
}
__device__ __forceinline__ float bflo(unsigned w) { return __builtin_bit_cast(float, w << 16); }
__device__ __forceinline__ float bfhi(unsigned w) { return __builtin_bit_cast(float, w & 0xffff0000u); }
__device__ __forceinline__ void unpack8(const u32x4 w, float (&f)[8]) { f[0] = bflo(w.x); f[1] = bfhi(w.x); f[2] = bflo(w.y); f[3] = bfhi(w.y); f[4] = bflo(w.z); f[5] = bfhi(w.z); f[6] = bflo(w.w); f[7] = bfhi(w.w); }
__device__ __forceinline__ u32x4 pack8(const float (&f)[8]) { u32x4 w; w.x = pg8::cvt_pk_bf16(f[0], f[1]); w.y = pg8::cvt_pk_bf16(f[2], f[3]); w.z = pg8::cvt_pk_bf16(f[4], f[5]); w.w = pg8::cvt_pk_bf16(f[6], f[7]); return w; }
__device__ __forceinline__ float fsilu(float x) { return x / (1.f + __expf(-x)); }

__device__ __forceinline__ void tr_item(const float* __restrict__ W, size_t ldw, bf16* __restrict__ WT, size_t K, int kb, int nb, int lane) {
    const int kq = lane & 7, nq = lane >> 3;
    const float* src = W + (size_t)(kb * 64 + kq * 8) * ldw + nb * 32 + nq * 4;
    f32x4 v[8];
#pragma unroll
    for (int i = 0; i < 8; ++i) v[i] = *(const f32x4*)(src + (size_t)i * ldw);
    bf16* dst = WT + (size_t)(nb * 32 + nq * 4) * K + kb * 64 + kq * 8;
#pragma unroll
    for (int j = 0; j < 4; ++j) { u32x4 o; o.x = pg8::cvt_pk_bf16(v[0][j], v[1][j]); o.y = pg8::cvt_pk_bf16(v[2][j], v[3][j]); o.z = pg8::cvt_pk_bf16(v[4][j], v[5][j]); o.w = pg8::cvt_pk_bf16(v[6][j], v[7][j]);
        *(u32x4*)(dst + (size_t)j * K) = o; }
}

__device__ __forceinline__ void modulate_row(const float* __restrict__ xr, bf16* __restrict__ ur, const float* __restrict__ shift, const float* __restrict__ scale, int lane) {
#pragma unroll
    for (int j = 0; j < 8; ++j) { const int c = 4 * lane + 256 * j; const f32x4 v = *(const f32x4*)(xr + c), sc = *(const f32x4*)(scale + c), sh = *(const f32x4*)(shift + c);
        const f32x4 y = v * (sc + 1.f) + sh; u32x2 o; o.x = pg8::cvt_pk_bf16(y[0], y[1]); o.y = pg8::cvt_pk_bf16(y[2], y[3]); *(u32x2*)(ur + c) = o; }
}
__device__ __forceinline__ void ln_mod_row(const float* __restrict__ pre, const float* __restrict__ g, const float* __restrict__ bt, float* __restrict__ xo, bf16* __restrict__ uo,
                                           const float* __restrict__ shift, const float* __restrict__ scale, int lane) {
    f32x4 v[8]; float s = 0.f;
#pragma unroll
    for (int j = 0; j < 8; ++j) { v[j] = *(const f32x4*)(pre + 4 * lane + 256 * j); s += (v[j][0] + v[j][1]) + (v[j][2] + v[j][3]); }
    const float mean = wave_sum(s) * (1.f / D); float s2 = 0.f;
#pragma unroll
    for (int j = 0; j < 8; ++j) { v[j] = v[j] - mean; s2 += (v[j][0] * v[j][0] + v[j][1] * v[j][1]) + (v[j][2] * v[j][2] + v[j][3] * v[j][3]); }
    const float rstd = 1.f / sqrtf(wave_sum(s2) * (1.f / D) + LN_EPS);
#pragma unroll
    for (int j = 0; j < 8; ++j) { const int c = 4 * lane + 256 * j; const f32x4 y = v[j] * rstd * *(const f32x4*)(g + c) + *(const f32x4*)(bt + c);
        *(f32x4*)(xo + c) = y;
        if (uo) { const f32x4 u = y * (*(const f32x4*)(scale + c) + 1.f) + *(const f32x4*)(shift + c); u32x2 o; o.x = pg8::cvt_pk_bf16(u[0], u[1]); o.y = pg8::cvt_pk_bf16(u[2], u[3]); *(u32x2*)(uo + c) = o; } }
}

struct Args { const float* in[N_IN]; float* out; unsigned char* ws; int ph_lo, ph_hi; };
constexpr int NPL = 10, NPH = 3 + DEPTH * NPL;

__global__ void __launch_bounds__(NT, 2) fwd_kernel(Args args) {
    extern __shared__ __attribute__((aligned(16))) unsigned char lds_raw[];
    LAS unsigned char* lds = (LAS unsigned char*)lds_raw;
    const int G = gridDim.x, blk = blockIdx.x, NGW = G * NWAVES, NGT = G * NT;
    volatile LAS unsigned* MISC = (volatile LAS unsigned*)(lds + MISC_OFF);
    for (int u = threadIdx.x; u < (LDS_BYTES - 131072) / 4; u += NT) ((LAS unsigned*)(lds + 131072))[u] = 0u;
    __syncthreads();
    XcdBarrier bar = xcd_barrier_post((unsigned*)((gu32*)(args.ws + WS_CTL) + CW_BAR), MISC + 8);
    const int lo = args.ph_lo, hi = args.ph_hi;
#define IN(k) (lo <= (k) && (k) < hi)
#define SEAM(k) do { if (IN(k) && IN((k) + 1)) xcd_barrier(bar); } while (0)
#define PH_BEGIN \
    int tid = threadIdx.x; asm volatile("" : "+v"(tid)); const int lane = tid & 63, wave = __builtin_amdgcn_readfirstlane(tid >> 6); \
    const int gw = blk * NWAVES + wave, gtid = blk * NT + tid; (void)gw; (void)gtid; (void)lane; \
    unsigned char* ws = args.ws; asm volatile("" : "+s"(ws)); \
    const float* x_in = args.in[I_X]; (void)x_in; \
    float* modp = (float*)(ws + WS_MODP); float* mod = (float*)(ws + WS_MOD); float* SMALL = (float*)(ws + WS_SMALL); (void)modp; (void)mod; (void)SMALL; \
    float* CUM = (float*)(ws + WS_CUM); float* BETA = (float*)(ws + WS_BETA); float* GG = (float*)(ws + WS_GG); (void)CUM; (void)BETA; (void)GG; \
    bf16* U = (bf16*)(ws + WS_U); float* X = (float*)(ws + WS_X); float* PRE = (float*)(ws + WS_PRE); (void)U; (void)X; (void)PRE; \
    bf16* T = (bf16*)(ws + WS_T); bf16* H = (bf16*)(ws + WS_H); (void)T; (void)H; \
    bf16* YA = (bf16*)(ws + WS_YA); bf16* YB = (bf16*)(ws + WS_YB); bf16* YC = (bf16*)(ws + WS_YC); bf16* MG = (bf16*)(ws + WS_MG); (void)YA; (void)YB; (void)YC; (void)MG; \
    float* MACC = (float*)(ws + WS_MACC); float* QN = (float*)(ws + WS_QN); float* KN = (float*)(ws + WS_KN); float* VN = (float*)(ws + WS_VN); float* ORAW = (float*)(ws + WS_ORAW); \
    (void)MACC; (void)QN; (void)KN; (void)VN; (void)ORAW;

    if (IN(0)) { PH_BEGIN
        LAS f32x4* ca = (LAS f32x4*)lds;
        const float* c = args.in[I_C];
        for (int k = tid; k < D; k += NT) { f32x4 v; for (int b = 0; b < 4; ++b) { const float cv = c[b * D + k]; v[b] = cv / (1.f + expf(-cv)); } ca[k] = v; }
        __syncthreads();
        const float* w_ada = args.in[I_WADA];
        for (int it = gw; it < 1536; it += NGW) {
            const int l = it / 768, r = it % 768, jblk = r >> 4, kc = r & 15;
            const float* W = w_ada + ((size_t)(l * D + kc * 128)) * MODW + jblk * 256 + lane * 4;
            f32x4 a0 = {0.f, 0.f, 0.f, 0.f}, a1 = a0, a2 = a0, a3 = a0;
#pragma unroll 8
            for (int k = 0; k < 128; ++k) { const f32x4 w = *(const f32x4*)(W + (size_t)k * MODW); const f32x4 cv = ca[kc * 128 + k]; a0 += w * cv[0]; a1 += w * cv[1]; a2 += w * cv[2]; a3 += w * cv[3]; }
            float* P = modp + ((size_t)((l * 16 + kc) * 4)) * MODW + jblk * 256 + lane * 4;
            *(f32x4*)(P) = a0; *(f32x4*)(P + MODW) = a1; *(f32x4*)(P + 2 * MODW) = a2; *(f32x4*)(P + 3 * MODW) = a3;
        }
    }
    SEAM(0);
    if (IN(1)) { PH_BEGIN
        const float* b_ada = args.in[I_BADA];
        for (int i = gtid; i < DEPTH * 4 * MODW; i += NGT) { const int l = i / (4 * MODW), r = i % (4 * MODW), b = r / MODW, j = r % MODW; float s = b_ada[l * MODW + j];
            for (int kc = 0; kc < 16; ++kc) s += modp[((size_t)((l * 16 + kc) * 4 + b)) * MODW + j];
            mod[i] = s; }
        constexpr int I_IN = 13 * 32 * 64, I_TAIL = 96, I_SQ = 4 * 32 * 64, I_F1 = 32 * 256, I_F2 = 128 * 64, I_L = I_IN + I_TAIL + I_SQ + I_F1 + I_F2;
        for (int it = gw; it < DEPTH * I_L; it += NGW) {
            const int l = it / I_L; int r = it % I_L; unsigned char* wl = ws + WS_W + (size_t)l * W_LAYER;
            if (r < I_IN) { const int t = r >> 11, q = r & 2047; tr_item(args.in[I_WIN] + (size_t)l * D * INW + src_off(t), INW, (bf16*)(wl + W_IN) + (size_t)t * D * D, D, q >> 6, q & 63, lane); continue; } r -= I_IN;
            if (r < I_TAIL) { const int nb = r >> 5, kb = r & 31; tr_item(args.in[I_WIN] + (size_t)l * D * INW + (nb < 2 ? SRC_GB + 32 * nb : SRC_FF), INW, (bf16*)(wl + W_IN) + (size_t)(13 * D + 32 * nb) * D, D, kb, 0, lane); continue; } r -= I_TAIL;
            if (r < I_SQ) { const int t = r >> 11, q = r & 2047; tr_item((t == 0 ? args.in[I_WA] : t == 1 ? args.in[I_WB] : t == 2 ? args.in[I_WC] : args.in[I_WO]) + (size_t)l * D * D, D, (bf16*)(wl + W_A + (size_t)t * 8 * MiB), D, q >> 6, q & 63, lane); continue; } r -= I_SQ;
            if (r < I_F1) { tr_item(args.in[I_W1] + (size_t)l * D * FF, FF, (bf16*)(wl + W_1), D, r >> 8, r & 255, lane); continue; } r -= I_F1;
            tr_item(args.in[I_W2] + (size_t)l * FF * D, D, (bf16*)(wl + W_2), FF, r >> 6, r & 63, lane);
        }
        for (int i = gtid; i < DEPTH * 160 * (D / 8); i += NGT) { const int l = i / (160 * 256), r = i % (160 * 256); bf16* p = (bf16*)(ws + WS_W + (size_t)l * W_LAYER + W_IN) + (size_t)(13 * D + 96 + (r >> 8)) * D + (r & 255) * 8;
            *(u32x4*)p = (u32x4){0u, 0u, 0u, 0u}; }
    }
    SEAM(1);
    if (IN(2)) { PH_BEGIN
        for (int m = gw; m < M; m += NGW) { const float* mb = mod + (size_t)(m >> 11) * MODW; modulate_row(x_in + (size_t)m * D, U + (size_t)m * D, mb, mb + D, lane); }
    }
    SEAM(2);

    for (int l = 0; l < DEPTH; ++l) {
        const int pb = 3 + l * NPL;
#define LAYER_PTRS unsigned char* wl = ws + WS_W + (size_t)l * W_LAYER; const float* modl = mod + (size_t)l * 4 * MODW; const float* Xin = (l == 0) ? x_in : X; (void)wl; (void)modl; (void)Xin;
        if (IN(pb + 0)) { PH_BEGIN LAYER_PTRS
            pg8::Gemm g{U, (const bf16*)(wl + W_IN), M, NPAD, D}; pg8::StaticOrder S; S.init(M, NPAD, G, blk);
            pg8::EpiInProj E{T, SMALL, ACT_E};
            pg8::gemm_phase<pg8::EpiInProj, pg8::StaticOrder, true, true>(lds, g, S, E);
        }
        SEAM(pb + 0);
        if (IN(pb + 1)) { PH_BEGIN LAYER_PTRS
            { const float* cw = args.in[I_CONVW] + (size_t)l * 3 * D; const bf16 *CB = T + TI_CB * ACT_E, *CC = T + TI_CC * ACT_E, *CH = T + TI_CH * ACT_E;
              for (int it = gtid; it < (M / 8) * 256; it += NGT) {
                const int col = (it & 255) * 8, m0 = (it >> 8) * 8; const bool first = (m0 & (SEQ - 1)) == 0;
                float w0[8], w1[8], w2[8], p2[8], p1[8];
#pragma unroll
                for (int i = 0; i < 8; ++i) { w0[i] = cw[col + i]; w1[i] = cw[D + col + i]; w2[i] = cw[2 * D + col + i]; p2[i] = 0.f; p1[i] = 0.f; }
                if (!first) { float a[8], b[8];
                    unpack8(*(const u32x4*)(CC + (size_t)(m0 - 2) * D + col), a); unpack8(*(const u32x4*)(CH + (size_t)(m0 - 2) * D + col), b);
#pragma unroll
                    for (int i = 0; i < 8; ++i) p2[i] = a[i] * b[i];
                    unpack8(*(const u32x4*)(CC + (size_t)(m0 - 1) * D + col), a); unpack8(*(const u32x4*)(CH + (size_t)(m0 - 1) * D + col), b);
#pragma unroll
                    for (int i = 0; i < 8; ++i) p1[i] = a[i] * b[i]; }
                for (int r = 0; r < 8; ++r) { const size_t o = (size_t)(m0 + r) * D + col; float a[8], b[8], g[8], y[8];
                    unpack8(*(const u32x4*)(CC + o), a); unpack8(*(const u32x4*)(CH + o), b); unpack8(*(const u32x4*)(CB + o), g);
#pragma unroll
                    for (int i = 0; i < 8; ++i) { const float p0 = a[i] * b[i]; y[i] = g[i] * (w0[i] * p2[i] + w1[i] * p1[i] + w2[i] * p0); p2[i] = p1[i]; p1[i] = p0; }
                    *(u32x4*)(YA + o) = pack8(y); }
              } }
            { const float* gcw = args.in[I_GCONVW] + (size_t)l * 4 * 6144;
              for (int it = gw; it < 6144; it += NGW) {
                const int cgp = it & 3, ten = (it >> 2) % 3, rb = it / 12; const int ch = cgp * 512 + lane * 8; const int m0 = rb * 16; const bool first = (m0 & (SEQ - 1)) == 0;
                const bf16* src = T + (size_t)(TI_GQ + ten) * ACT_E; float* dst = (ten == 0) ? QN : (ten == 1 ? KN : VN);
                float w[4][8], h3[8], h2[8], h1[8];
#pragma unroll
                for (int i = 0; i < 8; ++i) { w[0][i] = gcw[ten * D + ch + i]; w[1][i] = gcw[6144 + ten * D + ch + i]; w[2][i] = gcw[2 * 6144 + ten * D + ch + i]; w[3][i] = gcw[3 * 6144 + ten * D + ch + i]; h3[i] = 0.f; h2[i] = 0.f; h1[i] = 0.f; }
                if (!first) { unpack8(*(const u32x4*)(src + (size_t)(m0 - 3) * D + ch), h3); unpack8(*(const u32x4*)(src + (size_t)(m0 - 2) * D + ch), h2); unpack8(*(const u32x4*)(src + (size_t)(m0 - 1) * D + ch), h1); }
                for (int r = 0; r < 16; ++r) { const size_t o = (size_t)(m0 + r) * D + ch; float h0[8], y[8]; unpack8(*(const u32x4*)(src + o), h0); float ss = 0.f;
#pragma unroll
                    for (int i = 0; i < 8; ++i) { const float a = w[0][i] * h3[i] + w[1][i] * h2[i] + w[2][i] * h1[i] + w[3][i] * h0[i]; y[i] = a / (1.f + expf(-a)); ss += y[i] * y[i]; h3[i] = h2[i]; h2[i] = h1[i]; h1[i] = h0[i]; }
                    if (ten < 2) { ss += __shfl_xor(ss, 1); ss += __shfl_xor(ss, 2); ss += __shfl_xor(ss, 4); ss += __shfl_xor(ss, 8); const float rn = 1.f / sqrtf(ss + NORM_EPS);
#pragma unroll
                        for (int i = 0; i < 8; ++i) y[i] *= rn; }
                    *(f32x4*)(dst + o) = (f32x4){y[0], y[1], y[2], y[3]}; *(f32x4*)(dst + o + 4) = (f32x4){y[4], y[5], y[6], y[7]}; }
              } }
            { const float* alog = args.in[I_ALOG] + l * 32; const float* dtb = args.in[I_DTB] + l * 32;
              for (int i = gtid; i < M * 32; i += NGT) { const int m = i >> 5, hv = i & 31; const float bl = SMALL[(size_t)m * 256 + hv], al = SMALL[(size_t)m * 256 + 32 + hv];
                BETA[i] = 1.f / (1.f + expf(-bl)); const float xx = al + dtb[hv]; const float sp = fmaxf(xx, 0.f) + log1pf(expf(-fabsf(xx))); GG[i] = -expf(alog[hv]) * sp; } }
            { const float* fbias = args.in[I_FBIAS] + l * 16;
              for (int it = gw; it < 64; it += NGW) { const int b = it >> 4, h = it & 15; const float fb = fbias[h]; const size_t mbase = (size_t)b * SEQ + lane * 32; float tot = 0.f;
                for (int i = 0; i < 32; ++i) { const float xx = SMALL[(mbase + i) * 256 + 64 + h] + fb; tot += fminf(xx, 0.f) - log1pf(expf(-fabsf(xx))); }
                float inc = tot;
#pragma unroll
                for (int o = 1; o < 64; o <<= 1) { const float n = __shfl_up(inc, o); if (lane >= o) inc += n; }
                float run = inc - tot;
                for (int i = 0; i < 32; ++i) { const float xx = SMALL[(mbase + i) * 256 + 64 + h] + fb; run += fminf(xx, 0.f) - log1pf(expf(-fabsf(xx))); CUM[(size_t)it * SEQ + lane * 32 + i] = run; }
              } }
        }
        SEAM(pb + 1);
        if (IN(pb + 2)) { PH_BEGIN LAYER_PTRS
            if (wave < 4) {
                const int it = blk * 4 + wave;
                if (it < 1024) {
                    const int b = it >> 8, hv = (it >> 3) & 31, dvc = it & 7, hk = hv >> 1, kq = lane >> 3, col = lane & 7;
                    float S[16];
#pragma unroll
                    for (int i = 0; i < 16; ++i) S[i] = 0.f;
                    const float* kp = KN + (size_t)b * SEQ * D + hk * 128 + kq * 16; const float* qp = QN + (size_t)b * SEQ * D + hk * 128 + kq * 16;
                    const float* vp = VN + (size_t)b * SEQ * D + hv * 64 + dvc * 8 + col; const float* bp = BETA + (size_t)b * SEQ * 32 + hv; const float* gp = GG + (size_t)b * SEQ * 32 + hv;
                    float* op = ORAW + (size_t)b * SEQ * D + hv * 64 + dvc * 8 + col;
                    f32x4 kn[4], qn[4]; float vn, bn, gn;
#pragma unroll
                    for (int i = 0; i < 4; ++i) { kn[i] = *(const f32x4*)(kp + 4 * i); qn[i] = *(const f32x4*)(qp + 4 * i); }
                    vn = vp[0]; bn = bp[0]; gn = gp[0];
                    for (int t = 0; t < SEQ; ++t) {
                        f32x4 kc[4], qc[4]; const float vc = vn, bc = bn, gc = gn;
#pragma unroll
                        for (int i = 0; i < 4; ++i) { kc[i] = kn[i]; qc[i] = qn[i]; }
                        if (t + 1 < SEQ) { const size_t o = (size_t)(t + 1) * D;
#pragma unroll
                            for (int i = 0; i < 4; ++i) { kn[i] = *(const f32x4*)(kp + o + 4 * i); qn[i] = *(const f32x4*)(qp + o + 4 * i); }
                            vn = vp[o]; bn = bp[(size_t)(t + 1) * 32]; gn = gp[(size_t)(t + 1) * 32]; }
                        const float eg = expf(gc); float p = 0.f;
#pragma unroll
                        for (int i = 0; i < 16; ++i) { S[i] *= eg; p += kc[i >> 2][i & 3] * S[i]; }
                        p += __shfl_xor(p, 8); p += __shfl_xor(p, 16); p += __shfl_xor(p, 32);
                        const float dlt = bc * (vc - p); float o = 0.f;
#pragma unroll
                        for (int i = 0; i < 16; ++i) { S[i] += kc[i >> 2][i & 3] * dlt; o += qc[i >> 2][i & 3] * S[i]; }
                        o += __shfl_xor(o, 8); o += __shfl_xor(o, 16); o += __shfl_xor(o, 32);
                        if (kq == 0) op[(size_t)t * D] = o * 0.08838834764831845f;
                    }
                }
            }
            __syncthreads();
            {
                LAS float* Qs = (LAS float*)lds;
                LAS float* Kt = Qs + 128 * 64;
                LAS float* Vs = Kt + 128 * 64;
                LAS float* Ps = Vs + 64 * 128;
                const bf16 *FQ = T + TI_FQ * ACT_E, *FK = T + TI_FK * ACT_E, *FV = T + TI_FV * ACT_E;
                const int bh = blk >> 2, b = bh >> 4, h = bh & 15, rq = blk & 3;
                if (blk < 256)
                for (int i = 0; i < 8; ++i) {
                    const int a = 4 * (i >> 1) + rq, qi = (i & 1) ? 31 - a : a, q0 = qi * 64; const size_t mb = (size_t)b * SEQ;
                    __syncthreads();
                    { const int r = tid & 63, dc = tid >> 6; const bf16* p = FQ + (mb + q0 + r) * D + h * 128 + dc * 16; float f0[8], f1[8]; unpack8(*(const u32x4*)p, f0); unpack8(*(const u32x4*)(p + 8), f1);
#pragma unroll
                      for (int e = 0; e < 8; ++e) { Qs[(dc * 16 + e) * 64 + r] = f0[e]; Qs[(dc * 16 + 8 + e) * 64 + r] = f1[e]; } }
                    float m_run[8], l_run[8], o0[8], o1[8], cq[8];
#pragma unroll
                    for (int rr = 0; rr < 8; ++rr) { m_run[rr] = -1e30f; l_run[rr] = 0.f; o0[rr] = 0.f; o1[rr] = 0.f; cq[rr] = CUM[(size_t)bh * SEQ + q0 + wave * 8 + rr]; }
                    for (int kt = 0; kt <= qi; ++kt) {
                        const int k0 = kt * 64;
                        __syncthreads();
                        { const int j = tid & 63, dc = tid >> 6; const bf16* p = FK + (mb + k0 + j) * D + h * 128 + dc * 16; float f0[8], f1[8]; unpack8(*(const u32x4*)p, f0); unpack8(*(const u32x4*)(p + 8), f1);
#pragma unroll
                          for (int e = 0; e < 8; ++e) { Kt[(dc * 16 + e) * 64 + j] = f0[e]; Kt[(dc * 16 + 8 + e) * 64 + j] = f1[e]; } }
                        { const int j = tid >> 3, dc = tid & 7; const bf16* p = FV + (mb + k0 + j) * D + h * 128 + dc * 16; float f0[8], f1[8]; unpack8(*(const u32x4*)p, f0); unpack8(*(const u32x4*)(p + 8), f1);
                          LAS f32x4* d4 = (LAS f32x4*)(Vs + j * 128 + dc * 16); d4[0] = (f32x4){f0[0], f0[1], f0[2], f0[3]}; d4[1] = (f32x4){f0[4], f0[5], f0[6], f0[7]}; d4[2] = (f32x4){f1[0], f1[1], f1[2], f1[3]}; d4[3] = (f32x4){f1[4], f1[5], f1[6], f1[7]}; }
                        __syncthreads();
                        float s[8];
#pragma unroll
                        for (int rr = 0; rr < 8; ++rr) s[rr] = 0.f;
#pragma unroll 4
                        for (int d = 0; d < 128; ++d) { const float kv = Kt[d * 64 + lane]; const f32x4 qa = *(const LAS f32x4*)(Qs + d * 64 + wave * 8), qb = *(const LAS f32x4*)(Qs + d * 64 + wave * 8 + 4);
                            s[0] += qa[0] * kv; s[1] += qa[1] * kv; s[2] += qa[2] * kv; s[3] += qa[3] * kv; s[4] += qb[0] * kv; s[5] += qb[1] * kv; s[6] += qb[2] * kv; s[7] += qb[3] * kv; }
                        const float ck = CUM[(size_t)bh * SEQ + k0 + lane];
#pragma unroll
                        for (int rr = 0; rr < 8; ++rr) { float sc = s[rr] * 0.08838834764831845f + cq[rr] - ck; if (k0 + lane > q0 + wave * 8 + rr) sc = -__builtin_inff();
                            const float mx = wave_max(sc), mn = fmaxf(m_run[rr], mx), al = expf(m_run[rr] - mn), p = expf(sc - mn);
                            l_run[rr] = l_run[rr] * al + wave_sum(p); m_run[rr] = mn; o0[rr] *= al; o1[rr] *= al; Ps[(wave * 8 + rr) * 64 + lane] = p; }
                        LDS_WAIT();
#pragma unroll 2
                        for (int j4 = 0; j4 < 16; ++j4) { float v0[4], v1[4];
#pragma unroll
                            for (int jj = 0; jj < 4; ++jj) { v0[jj] = Vs[(j4 * 4 + jj) * 128 + lane]; v1[jj] = Vs[(j4 * 4 + jj) * 128 + 64 + lane]; }
#pragma unroll
                            for (int rr = 0; rr < 8; ++rr) { const f32x4 pv = *(const LAS f32x4*)(Ps + (wave * 8 + rr) * 64 + j4 * 4);
#pragma unroll
                                for (int jj = 0; jj < 4; ++jj) { o0[rr] += pv[jj] * v0[jj]; o1[rr] += pv[jj] * v1[jj]; } } }
                    }
#pragma unroll
                    for (int rr = 0; rr < 8; ++rr) { const float inv = 1.f / l_run[rr]; bf16* op = YC + (mb + q0 + wave * 8 + rr) * D + h * 128;
                        op[lane] = (bf16)f2bf(o0[rr] * inv); op[64 + lane] = (bf16)f2bf(o1[rr] * inv); }
                }
            }
        }
        SEAM(pb + 2);
        if (IN(pb + 3)) { PH_BEGIN LAYER_PTRS
            const float* nw = args.in[I_GNORMW] + l * 64; const bf16* GZ = T + TI_GZ * ACT_E;
            float nwv[8];
#pragma unroll
            for (int i = 0; i < 8; ++i) nwv[i] = nw[(lane & 7) * 8 + i];
            for (int it = gw; it < M * 4; it += NGW) { const size_t o = (size_t)(it >> 2) * D + (it & 3) * 512 + lane * 8;
                const f32x4 a = *(const f32x4*)(ORAW + o), b = *(const f32x4*)(ORAW + o + 4); float ov[8] = {a[0], a[1], a[2], a[3], b[0], b[1], b[2], b[3]}, z[8], y[8]; float ss = 0.f;
#pragma unroll
                for (int i = 0; i < 8; ++i) ss += ov[i] * ov[i];
                ss += __shfl_xor(ss, 1); ss += __shfl_xor(ss, 2); ss += __shfl_xor(ss, 4);
                const float rn = 1.f / sqrtf(ss * (1.f / 64.f) + NORM_EPS); unpack8(*(const u32x4*)(GZ + o), z);
#pragma unroll
                for (int i = 0; i < 8; ++i) y[i] = ov[i] * rn * nwv[i] * (z[i] / (1.f + expf(-z[i])));
                *(u32x4*)(YB + o) = pack8(y); }
        }
        SEAM(pb + 3);
        if (IN(pb + 4)) { PH_BEGIN LAYER_PTRS
            pg8::StaticOrder S; S.init(M, D, G, blk);
            { pg8::Gemm g{YA, (const bf16*)(wl + W_A), M, D, D}; pg8::EpiMerge<0> E{T + TI_MA * ACT_E, MACC, MG}; pg8::gemm_phase<pg8::EpiMerge<0>, pg8::StaticOrder, true, true>(lds, g, S, E); }
            { pg8::Gemm g{YB, (const bf16*)(wl + W_B), M, D, D}; pg8::EpiMerge<1> E{T + TI_MB * ACT_E, MACC, MG}; pg8::gemm_phase<pg8::EpiMerge<1>, pg8::StaticOrder, true, true>(lds, g, S, E); }
            { pg8::Gemm g{YC, (const bf16*)(wl + W_C), M, D, D}; pg8::EpiMerge<2> E{T + TI_MC * ACT_E, MACC, MG}; pg8::gemm_phase<pg8::EpiMerge<2>, pg8::StaticOrder, true, true>(lds, g, S, E); }
        }
        SEAM(pb + 4);
        if (IN(pb + 5)) { PH_BEGIN LAYER_PTRS
            pg8::Gemm g{MG, (const bf16*)(wl + W_O), M, D, D}; pg8::StaticOrder S; S.init(M, D, G, blk);
            pg8::EpiResid E{Xin, modl + 2 * D, PRE, ALPHA};
            pg8::gemm_phase<pg8::EpiResid, pg8::StaticOrder, true, true>(lds, g, S, E);
        }
        SEAM(pb + 5);
        if (IN(pb + 6)) { PH_BEGIN LAYER_PTRS
            const float* g1 = args.in[I_LN1G] + (size_t)l * D; const float* b1 = args.in[I_LN1B] + (size_t)l * D;
            for (int m = gw; m < M; m += NGW) { const float* mb = modl + (size_t)(m >> 11) * MODW; ln_mod_row(PRE + (size_t)m * D, g1, b1, X + (size_t)m * D, U + (size_t)m * D, mb + 3 * D, mb + 4 * D, lane); }
        }
        SEAM(pb + 6);
        if (IN(pb + 7)) { PH_BEGIN LAYER_PTRS
            pg8::Gemm g{U, (const bf16*)(wl + W_1), M, FF, D}; pg8::StaticOrder S; S.init(M, FF, G, blk);
            pg8::EpiRelu2 E{H, FF};
            pg8::gemm_phase<pg8::EpiRelu2, pg8::StaticOrder, true, true>(lds, g, S, E);
        }
        SEAM(pb + 7);
        if (IN(pb + 8)) { PH_BEGIN LAYER_PTRS
            pg8::Gemm g{H, (const bf16*)(wl + W_2), M, D, FF}; pg8::StaticOrder S; S.init(M, D, G, blk);
            pg8::EpiResid E{X, modl + 5 * D, PRE, ALPHA};
            pg8::gemm_phase<pg8::EpiResid, pg8::StaticOrder, true, true>(lds, g, S, E);
        }
        SEAM(pb + 8);
        if (IN(pb + 9)) { PH_BEGIN LAYER_PTRS
            const float* g2 = args.in[I_LN2G] + (size_t)l * D; const float* b2 = args.in[I_LN2B] + (size_t)l * D; const bool last = (l == DEPTH - 1);
            float* xo = last ? args.out : X; const float* modn = mod + (size_t)(last ? l : l + 1) * 4 * MODW;
            for (int m = gw; m < M; m += NGW) { const float* mb = modn + (size_t)(m >> 11) * MODW; ln_mod_row(PRE + (size_t)m * D, g2, b2, xo + (size_t)m * D, last ? (bf16*)nullptr : U + (size_t)m * D, mb, mb + D, lane); }
        }
        SEAM(pb + 9);
    }
#undef IN
#undef SEAM
}

#ifndef MK_ONE_LAUNCH
#define MK_ONE_LAUNCH 0
#endif
extern "C" void kernel_launch(void* const* d_in, const int* in_sizes, int n_in, void* d_out, int out_size, void* d_ws, size_t ws_size, hipStream_t stream) {
    static int grid = 0;
    if (grid == 0) {
        if (n_in != N_IN || out_size != M * D || ws_size < WS_END) { fprintf(stderr, "kernel_launch: unexpected shapes: n_in %d out %d ws %zu (need %zu)\n", n_in, out_size, ws_size, (size_t)WS_END); grid = -1; return; }
        int dev = 0, cus = 0, per_cu = 0;
        if (hipGetDevice(&dev) != hipSuccess || hipDeviceGetAttribute(&cus, hipDeviceAttributeMultiprocessorCount, dev) != hipSuccess) { grid = -1; return; }
        if (hipFuncSetAttribute((const void*)fwd_kernel, hipFuncAttributeMaxDynamicSharedMemorySize, LDS_BYTES) != hipSuccess) { fprintf(stderr, "kernel_launch: hipFuncSetAttribute failed\n"); grid = -1; return; }
        if (hipOccupancyMaxActiveBlocksPerMultiprocessor(&per_cu, (const void*)fwd_kernel, NT, LDS_BYTES) != hipSuccess || per_cu < 1) fprintf(stderr, "kernel_launch: occupancy query says %d\n", per_cu);
        (void)hipGetLastError();
        grid = cus;
        if (grid != 256) fprintf(stderr, "kernel_launch: %d CUs (built for 256)\n", grid);
    }
    if (grid < 0) return;
    (void)hipMemsetAsync((char*)d_ws + WS_CTL, 0, CTL_ZERO_BYTES, stream);
    Args a{};
    for (int i = 0; i < N_IN; ++i) a.in[i] = (const float*)d_in[i];
    a.out = (float*)d_out; a.ws = (unsigned char*)d_ws;
#if MK_ONE_LAUNCH
    a.ph_lo = 0; a.ph_hi = NPH;
    hipLaunchKernelGGL(fwd_kernel, dim3(grid), dim3(NT), LDS_BYTES, stream, a);
#else
    for (int p = 0; p < NPH; ++p) { a.ph_lo = p; a.ph_hi = p + 1; hipLaunchKernelGGL(fwd_kernel, dim3(grid), dim3(NT), LDS_BYTES, stream, a); }
#endif
}
```

```cpp
#include <hip/hip_runtime.h>
#include <cstdio>
#include <cstdint>
#define MK_ONE_LAUNCH 1
namespace pg8 {
#define PG8_LAS __attribute__((address_space(3)))
typedef unsigned short bf16_t;
typedef short bf16x8 __attribute__((ext_vector_type(8)));
typedef float f32x4 __attribute__((ext_vector_type(4)));
typedef unsigned u32x4 __attribute__((ext_vector_type(4)));
constexpr int BM = 256, BK = 64, HALF = 128, HTB = HALF * BK * 2  , STAGE_BYTES = 8 * HTB, NXCD = 8, WGM = 8;

__host__ __device__ __forceinline__ int lds_byte(int r, int c) { const int st = (r >> 4) * 2 + (c >> 5), rr = r & 15, cc = c & 31, ob = rr * 64 + cc * 2; return st * 1024 + (ob ^ (((ob >> 9) & 1) << 5)); }
__host__ __device__ __forceinline__ void stage_rc(int b, int& R, int& C) { const int st = b / 1024, sb = b % 1024, swz = sb ^ (((sb >> 9) & 1) << 5); R = (st >> 1) * 16 + swz / 64; C = (st & 1) * 32 + (swz % 64) / 2; }
__host__ __device__ __forceinline__ int perm32(int rho) { const int n = rho >> 4, i = rho & 15; return 8 * (i >> 2) + 4 * n + (i & 3); }

struct Unit { int pm, pn; };
struct Gemm { const bf16_t* A; const bf16_t* Bt; int M, N, K; };

struct StaticOrder {
    int nM, nN, nwg, G, c;
    __host__ __device__ void init(int M, int N, int G_, int c_) { nM = M / BM; nN = N / BM; nwg = nM * nN; G = G_; c = c_; }
    __host__ __device__ bool next(int i, Unit& u) const {
        const long L = (long)i * G + c; if (L >= nwg) return false;
        int wgid = (int)L; { const int q = nwg / NXCD, r = nwg % NXCD, xcd = wgid % NXCD, off = wgid / NXCD; wgid = (xcd < r ? xcd * (q + 1) : r * (q + 1) + (xcd - r) * q) + off; }
        const int nig = WGM * nN, gid = wgid / nig, fm = gid * WGM, gsz = (nM - fm) < WGM ? (nM - fm) : WGM;
        u.pm = fm + ((wgid % nig) % gsz); u.pn = (wgid % nig) / gsz; return true;
    }
    __device__ __forceinline__ void a_ready(const Unit&) const {}
    __device__ __forceinline__ void done(const Unit&) const {}
};

__device__ __forceinline__ unsigned cvt_pk_bf16(float lo, float hi) { unsigned r; asm volatile("v_cvt_pk_bf16_f32 %0, %1, %2" : "=v"(r) : "v"(lo), "v"(hi)); return r; }
typedef float f32x2 __attribute__((ext_vector_type(2)));
__device__ __forceinline__ f32x2 gelu_pk(f32x2 v) {
    const f32x2 av = __builtin_elementwise_abs(v), d = av * 0.2316418882f + 1.0f;
    f32x2 t; t.x = __builtin_amdgcn_rcpf(d.x); t.y = __builtin_amdgcn_rcpf(d.y);
    f32x2 q = t * 0.5307027145f + (-0.7265760135f); q = q * t + 0.7107068705f; q = q * t + (-0.142248368f); q = q * t + 0.127414796f; q = q * t;
    const f32x2 s = (v * v) * (-0.72134752044f);
    f32x2 e; e.x = __builtin_amdgcn_exp2f(s.x); e.y = __builtin_amdgcn_exp2f(s.y);
    const f32x2 m = v * (q * e), r = v - m;
    f32x2 o; o.x = v.x < 0.f ? m.x : r.x; o.y = v.y < 0.f ? m.y : r.y; return o;
}

template <int ACT  > struct EpiBf16 {
    static constexpr bool PERM = true, AFTER_DRAIN = false; static_assert(ACT == 0 || ACT == 1, "EpiBf16: ACT is 0 (none) or 1 (gelu_pk)");
    bf16_t* O; int ldc; const float* bias; int split_cols; size_t split_stride; float scale0;
    __device__ __forceinline__ void operator()(const f32x4 (&acc)[2][2][4][2], const Unit& u, int wr, int wc, int fr, int fq) const {
        const int row0 = u.pm * BM + wr * 64 + fr; int colt = u.pn * BM; bf16_t* base = O;
        float sc = 1.f; if (split_cols) { const int t = colt / split_cols; base += (size_t)t * split_stride; colt -= t * split_cols; if (t == 0) sc = scale0; }
        const int col0 = colt + wc * 32 + 8 * fq, bcol0 = u.pn * BM + wc * 32 + 8 * fq;
        f32x4 bv[2][2];
#pragma unroll
        for (int bj = 0; bj < 2; ++bj)
#pragma unroll
            for (int n = 0; n < 2; ++n) bv[bj][n] = bias ? *(const f32x4*)(bias + bcol0 + bj * HALF + 4 * n) : (f32x4){0.f, 0.f, 0.f, 0.f};
#pragma unroll
        for (int ai = 0; ai < 2; ++ai)
#pragma unroll
            for (int m = 0; m < 4; ++m) { bf16_t* rowp = base + (size_t)(row0 + ai * HALF + m * 16) * ldc + col0;
#pragma unroll
                for (int bj = 0; bj < 2; ++bj) { f32x4 v0 = acc[ai][bj][m][0] + bv[bj][0], v1 = acc[ai][bj][m][1] + bv[bj][1];
                    if (ACT == 1) { f32x2 a = gelu_pk((f32x2){v0[0], v0[1]}), b = gelu_pk((f32x2){v0[2], v0[3]}), c = gelu_pk((f32x2){v1[0], v1[1]}), d = gelu_pk((f32x2){v1[2], v1[3]});
                        v0 = (f32x4){a.x, a.y, b.x, b.y}; v1 = (f32x4){c.x, c.y, d.x, d.y}; }
                    v0 = v0 * sc; v1 = v1 * sc; u32x4 w; w.x = cvt_pk_bf16(v0[0], v0[1]); w.y = cvt_pk_bf16(v0[2], v0[3]); w.z = cvt_pk_bf16(v1[0], v1[1]); w.w = cvt_pk_bf16(v1[2], v1[3]);
                    *(u32x4*)(rowp + bj * HALF) = w; } }
    }
};


template <class Epi, class Sched, bool ALIGN_EPI = false, bool SP2 = false>
__device__ __forceinline__ void gemm_phase(PG8_LAS unsigned char* lds, const Gemm g, const Sched& S, const Epi& E) {
    int tid_l = threadIdx.x; asm volatile("" : "+v"(tid_l));
    const int tid = tid_l, wid = __builtin_amdgcn_readfirstlane(tid >> 6), lane = tid & 63, wr = wid >> 2, wc = wid & 3, fr = lane & 15, fq = lane >> 4;
    const int K = g.K, nt = K / BK;
    unsigned voffA[2], voffB[2];
#pragma unroll
    for (int i = 0; i < 2; ++i) { int R, C; stage_rc(tid * 16 + i * 8192, R, C); const int Rb = Epi::PERM ? ((R & ~31) + perm32(R & 31)) : R;
        voffA[i] = (unsigned)(R * K + C) * 2u; voffB[i] = (unsigned)(Rb * K + C) * 2u; }
    const size_t kstep = (size_t)(BK * 2);
    const size_t hstep = (size_t)HALF * K * 2;
    const size_t tstep = 2 * hstep;
    const unsigned ldsw = (unsigned)wid * 1024u;
    const int aoff = lds_byte(wr * 64 + fr, fq * 8), boff = lds_byte(wc * 32 + fr, fq * 8);
#define PG8_SA(b, h) (((b) * 2 + (h)) * HTB)
#define PG8_SB(b, h) ((4 + (b) * 2 + (h)) * HTB)
#define PG8_STAGE(bufoff, gbase, voff) do { _Pragma("unroll") for (int _i = 0; _i < 2; ++_i) \
        __builtin_amdgcn_global_load_lds((const unsigned*)((const char*)(gbase) + (voff)[_i]), (PG8_LAS unsigned*)(lds + (bufoff) + ldsw + _i * 8192), 16, 0, 0); } while (0)
#define PG8_LDA(dst, b, h) do { _Pragma("unroll") for (int m = 0; m < 4; ++m) _Pragma("unroll") for (int k = 0; k < 2; ++k) dst[m][k] = *(const PG8_LAS bf16x8*)(lds + PG8_SA(b, h) + aoff + m * 2048 + k * 1024); } while (0)
#define PG8_LDB(dst, b, h) do { _Pragma("unroll") for (int n = 0; n < 2; ++n) _Pragma("unroll") for (int k = 0; k < 2; ++k) dst[n][k] = *(const PG8_LAS bf16x8*)(lds + PG8_SB(b, h) + boff + n * 2048 + k * 1024); } while (0)
#define PG8_MMA(ai, bj, At, Bt) do { __builtin_amdgcn_s_setprio(1); _Pragma("unroll") for (int m = 0; m < 4; ++m) _Pragma("unroll") for (int n = 0; n < 2; ++n) _Pragma("unroll") for (int k = 0; k < 2; ++k) \
        acc[ai][bj][m][n] = __builtin_amdgcn_mfma_f32_16x16x32_bf16(Bt[n][k], At[m][k], acc[ai][bj][m][n], 0, 0, 0); __builtin_amdgcn_s_setprio(0); } while (0)
#define PG8_WAIT_V(n) asm volatile("s_waitcnt vmcnt(" #n ")" ::: "memory")
#define PG8_WAIT_L(n) asm volatile("s_waitcnt lgkmcnt(" #n ")" ::: "memory")
#define PG8_BAR __builtin_amdgcn_s_barrier()
#define PG8_SCHED __builtin_amdgcn_sched_barrier(0)
    Unit cur, nxt; int ui = 0;
    if (!S.next(0, cur)) return;
    f32x4 acc[2][2][4][2];
#pragma unroll
    for (int a = 0; a < 2; ++a)
#pragma unroll
        for (int b = 0; b < 2; ++b)
#pragma unroll
            for (int m = 0; m < 4; ++m)
#pragma unroll
                for (int n = 0; n < 2; ++n) acc[a][b][m][n] = (f32x4){0.f, 0.f, 0.f, 0.f};
    bf16x8 At[4][2], B0[2][2], B1[2][2];
    const char* cA = (const char*)g.A + (size_t)cur.pm * tstep; const char* cB = (const char*)g.Bt + (size_t)cur.pn * tstep;
    S.a_ready(cur);
    if constexpr (SP2) {
        PG8_STAGE(PG8_SB(0, 0), cB, voffB); PG8_STAGE(PG8_SB(0, 1), cB + hstep, voffB); PG8_STAGE(PG8_SA(0, 0), cA, voffA); PG8_STAGE(PG8_SA(0, 1), cA + hstep, voffA);
        if (wr == 1) PG8_BAR;
        PG8_WAIT_V(2); PG8_BAR;
        PG8_STAGE(PG8_SB(1, 0), cB + kstep, voffB); PG8_STAGE(PG8_SA(1, 0), cA + kstep, voffA); PG8_STAGE(PG8_SB(1, 1), cB + hstep + kstep, voffB);
        PG8_WAIT_V(6); PG8_BAR;
    } else {
        PG8_STAGE(PG8_SB(0, 0), cB, voffB); PG8_STAGE(PG8_SA(0, 0), cA, voffA); PG8_STAGE(PG8_SB(0, 1), cB + hstep, voffB); PG8_STAGE(PG8_SA(0, 1), cA + hstep, voffA);
        if (wr == 1) PG8_BAR;
        PG8_WAIT_V(4); PG8_BAR;
        PG8_STAGE(PG8_SB(1, 0), cB + kstep, voffB); PG8_STAGE(PG8_SA(1, 0), cA + kstep, voffA); PG8_STAGE(PG8_SB(1, 1), cB + hstep + kstep, voffB);
        PG8_WAIT_V(6); PG8_BAR;
    }
    for (;;) {
        const bool has_next = S.next(ui + 1, nxt);
        const char* nA = has_next ? (const char*)g.A + (size_t)nxt.pm * tstep : cA; const char* nB = has_next ? (const char*)g.Bt + (size_t)nxt.pn * tstep : cB;
        for (int t = 0; t < nt; t += 2) {
            const bool last = (t == nt - 2);
            const char* a1 = cA + (size_t)(t + 1) * kstep;
            const char* a2 = last ? nA : cA + (size_t)(t + 2) * kstep; const char* b2 = last ? nB : cB + (size_t)(t + 2) * kstep;
            const char* a3 = a2 + kstep; const char* b3 = b2 + kstep;
            if (last && has_next) S.a_ready(nxt);
            if constexpr (SP2) {
            PG8_LDB(B0, 0, 0); PG8_LDB(B1, 0, 1); PG8_SCHED; PG8_LDA(At, 0, 0); PG8_STAGE(PG8_SA(1, 1), a1 + hstep, voffA);
            PG8_WAIT_V(8); PG8_WAIT_L(0); PG8_BAR; PG8_MMA(0, 0, At, B0); PG8_MMA(0, 1, At, B1); PG8_BAR; PG8_SCHED;
            PG8_LDA(At, 0, 1); PG8_STAGE(PG8_SB(0, 0), b2, voffB); PG8_STAGE(PG8_SB(0, 1), b2 + hstep, voffB); PG8_STAGE(PG8_SA(0, 0), a2, voffA);
            PG8_WAIT_V(8); PG8_WAIT_L(0); PG8_BAR; PG8_MMA(1, 0, At, B0); PG8_MMA(1, 1, At, B1); PG8_BAR; PG8_SCHED;
            PG8_LDB(B0, 1, 0); PG8_LDB(B1, 1, 1); PG8_SCHED; PG8_LDA(At, 1, 0); PG8_STAGE(PG8_SA(0, 1), a2 + hstep, voffA);
            PG8_WAIT_V(8); PG8_WAIT_L(0); PG8_BAR; PG8_MMA(0, 0, At, B0); PG8_MMA(0, 1, At, B1); PG8_BAR; PG8_SCHED;
            PG8_LDA(At, 1, 1); PG8_STAGE(PG8_SB(1, 0), b3, voffB); PG8_STAGE(PG8_SB(1, 1), b3 + hstep, voffB); PG8_STAGE(PG8_SA(1, 0), a3, voffA);
            PG8_WAIT_V(8); PG8_WAIT_L(0); PG8_BAR; PG8_MMA(1, 0, At, B0); PG8_MMA(1, 1, At, B1); PG8_BAR; PG8_SCHED;
            } else {
            PG8_LDB(B0, 0, 0); PG8_SCHED; PG8_LDA(At, 0, 0); PG8_STAGE(PG8_SA(1, 1), a1 + hstep, voffA);
            PG8_WAIT_L(8); PG8_BAR; PG8_WAIT_L(0); PG8_MMA(0, 0, At, B0); PG8_BAR; PG8_SCHED;
            PG8_LDB(B1, 0, 1); PG8_STAGE(PG8_SB(0, 0), b2, voffB);
            PG8_BAR; PG8_WAIT_L(0); PG8_MMA(0, 1, At, B1); PG8_BAR;
            PG8_LDA(At, 0, 1); PG8_STAGE(PG8_SA(0, 0), a2, voffA);
            PG8_BAR; PG8_WAIT_L(0); PG8_MMA(1, 0, At, B0); PG8_BAR; PG8_SCHED;
            PG8_STAGE(PG8_SB(0, 1), b2 + hstep, voffB);
            PG8_WAIT_V(6); PG8_BAR; PG8_MMA(1, 1, At, B1); PG8_BAR;
            PG8_LDB(B0, 1, 0); PG8_SCHED; PG8_LDA(At, 1, 0); PG8_STAGE(PG8_SA(0, 1), a2 + hstep, voffA);
            PG8_WAIT_L(8); PG8_BAR; PG8_WAIT_L(0); PG8_MMA(0, 0, At, B0); PG8_BAR; PG8_SCHED;
            PG8_LDB(B1, 1, 1); PG8_STAGE(PG8_SB(1, 0), b3, voffB);
            PG8_BAR; PG8_WAIT_L(0); PG8_MMA(0, 1, At, B1); PG8_BAR;
            PG8_LDA(At, 1, 1); PG8_STAGE(PG8_SA(1, 0), a3, voffA);
            PG8_BAR; PG8_WAIT_L(0); PG8_MMA(1, 0, At, B0); PG8_BAR; PG8_SCHED;
            PG8_STAGE(PG8_SB(1, 1), b3 + hstep, voffB);
            PG8_WAIT_V(6); PG8_BAR; PG8_MMA(1, 1, At, B1); PG8_BAR;
            }
        }
        if constexpr (ALIGN_EPI) { if (wr == 0) PG8_BAR; }
        if constexpr (!Epi::AFTER_DRAIN) { E(acc, cur, wr, wc, fr, fq); S.done(cur); }
        if (!has_next) break;
#pragma unroll
        for (int a = 0; a < 2; ++a)
#pragma unroll
            for (int b = 0; b < 2; ++b)
#pragma unroll
                for (int m = 0; m < 4; ++m)
#pragma unroll
                    for (int n = 0; n < 2; ++n) acc[a][b][m][n] = (f32x4){0.f, 0.f, 0.f, 0.f};
        cur = nxt; cA = nA; cB = nB; ++ui;
        if constexpr (ALIGN_EPI) { if (wr == 1) PG8_BAR; }
    }
    PG8_WAIT_V(0);
    if constexpr (!ALIGN_EPI) { if (wr == 0) PG8_BAR; }
    PG8_BAR;
    if constexpr (Epi::AFTER_DRAIN) { E.fused(acc, cur, wr, wc, fr, fq, lds, wid, lane); S.done(cur); }
#undef PG8_SA
#undef PG8_SB
#undef PG8_STAGE
#undef PG8_LDA
#undef PG8_LDB
#undef PG8_MMA
#undef PG8_WAIT_V
#undef PG8_WAIT_L
#undef PG8_BAR
#undef PG8_SCHED
}
}

namespace pg8 {
__device__ __forceinline__ float bf_lo(unsigned w) { return __builtin_bit_cast(float, w << 16); }
__device__ __forceinline__ float bf_hi(unsigned w) { return __builtin_bit_cast(float, w & 0xffff0000u); }
__device__ __forceinline__ float fsigmoid(float x) { return __builtin_amdgcn_rcpf(1.f + __expf(-x)); }

struct EpiInProj {
    static constexpr bool PERM = true, AFTER_DRAIN = false;
    bf16_t* T0; float* SMALL; size_t tstride;
    __device__ __forceinline__ void operator()(const f32x4 (&acc)[2][2][4][2], const Unit& u, int wr, int wc, int fr, int fq) const {
        const int t = u.pn >> 3; const int row0 = u.pm * BM + wr * 64 + fr;
        if (t < 13) {
            bf16_t* base = T0 + (size_t)t * tstride; const int col0 = (u.pn & 7) * BM + wc * 32 + 8 * fq; const bool sg = t >= 10;
#pragma unroll
            for (int ai = 0; ai < 2; ++ai)
#pragma unroll
                for (int m = 0; m < 4; ++m) { bf16_t* rowp = base + (size_t)(row0 + ai * HALF + m * 16) * 2048 + col0;
#pragma unroll
                    for (int bj = 0; bj < 2; ++bj) { f32x4 v0 = acc[ai][bj][m][0], v1 = acc[ai][bj][m][1];
                        if (sg) { v0 = (f32x4){fsigmoid(v0[0]), fsigmoid(v0[1]), fsigmoid(v0[2]), fsigmoid(v0[3])}; v1 = (f32x4){fsigmoid(v1[0]), fsigmoid(v1[1]), fsigmoid(v1[2]), fsigmoid(v1[3])}; }
                        u32x4 w; w.x = cvt_pk_bf16(v0[0], v0[1]); w.y = cvt_pk_bf16(v0[2], v0[3]); w.z = cvt_pk_bf16(v1[0], v1[1]); w.w = cvt_pk_bf16(v1[2], v1[3]);
                        *(u32x4*)(rowp + bj * HALF) = w; } }
        } else {
            const int col0 = wc * 32 + 8 * fq;
#pragma unroll
            for (int ai = 0; ai < 2; ++ai)
#pragma unroll
                for (int m = 0; m < 4; ++m) { float* rowp = SMALL + (size_t)(row0 + ai * HALF + m * 16) * 256 + col0;
#pragma unroll
                    for (int bj = 0; bj < 2; ++bj) { *(f32x4*)(rowp + bj * HALF) = acc[ai][bj][m][0]; *(f32x4*)(rowp + bj * HALF + 4) = acc[ai][bj][m][1]; } }
        }
    }
};

template <int STEP> struct EpiMerge {
    static constexpr bool PERM = true, AFTER_DRAIN = false;
    const bf16_t* G; float* MACC; bf16_t* OUT;
    __device__ __forceinline__ void operator()(const f32x4 (&acc)[2][2][4][2], const Unit& u, int wr, int wc, int fr, int fq) const {
        const int row0 = u.pm * BM + wr * 64 + fr, col0 = u.pn * BM + wc * 32 + 8 * fq;
#pragma unroll
        for (int ai = 0; ai < 2; ++ai)
#pragma unroll
            for (int m = 0; m < 4; ++m) { const size_t ro = (size_t)(row0 + ai * HALF + m * 16) * 2048 + col0;
#pragma unroll
                for (int bj = 0; bj < 2; ++bj) { const size_t o = ro + bj * HALF;
                    const u32x4 g = *(const u32x4*)(G + o);
                    f32x4 r0 = acc[ai][bj][m][0] * (f32x4){bf_lo(g.x), bf_hi(g.x), bf_lo(g.y), bf_hi(g.y)};
                    f32x4 r1 = acc[ai][bj][m][1] * (f32x4){bf_lo(g.z), bf_hi(g.z), bf_lo(g.w), bf_hi(g.w)};
                    if (STEP > 0) { r0 += *(const f32x4*)(MACC + o); r1 += *(const f32x4*)(MACC + o + 4); }
                    if (STEP < 2) { *(f32x4*)(MACC + o) = r0; *(f32x4*)(MACC + o + 4) = r1; }
                    else { u32x4 w; w.x = cvt_pk_bf16(r0[0], r0[1]); w.y = cvt_pk_bf16(r0[2], r0[3]); w.z = cvt_pk_bf16(r1[0], r1[1]); w.w = cvt_pk_bf16(r1[2], r1[3]); *(u32x4*)(OUT + o) = w; } } }
    }
};

struct EpiResid {
    static constexpr bool PERM = false, AFTER_DRAIN = false;
    const float* Xin; const float* gate; float* PRE; float alpha;
    __device__ __forceinline__ void operator()(const f32x4 (&acc)[2][2][4][2], const Unit& u, int wr, int wc, int fr, int fq) const {
        const int row0 = u.pm * BM + wr * 64 + fr, col0 = u.pn * BM + wc * 32 + 4 * fq; const float* gp = gate + (size_t)(u.pm >> 3) * 12288 + col0;
        f32x4 gv[2][2];
#pragma unroll
        for (int bj = 0; bj < 2; ++bj)
#pragma unroll
            for (int n = 0; n < 2; ++n) gv[bj][n] = *(const f32x4*)(gp + bj * HALF + n * 16);
#pragma unroll
        for (int ai = 0; ai < 2; ++ai)
#pragma unroll
            for (int m = 0; m < 4; ++m) { const size_t ro = (size_t)(row0 + ai * HALF + m * 16) * 2048 + col0;
#pragma unroll
                for (int bj = 0; bj < 2; ++bj)
#pragma unroll
                    for (int n = 0; n < 2; ++n) { const size_t o = ro + bj * HALF + n * 16; const f32x4 xv = *(const f32x4*)(Xin + o);
                        *(f32x4*)(PRE + o) = xv * alpha + gv[bj][n] * acc[ai][bj][m][n]; } }
    }
};

struct EpiRelu2 {
    static constexpr bool PERM = true, AFTER_DRAIN = false;
    bf16_t* O; int ldc;
    __device__ __forceinline__ void operator()(const f32x4 (&acc)[2][2][4][2], const Unit& u, int wr, int wc, int fr, int fq) const {
        const int row0 = u.pm * BM + wr * 64 + fr, col0 = u.pn * BM + wc * 32 + 8 * fq;
#pragma unroll
        for (int ai = 0; ai < 2; ++ai)
#pragma unroll
            for (int m = 0; m < 4; ++m) { bf16_t* rowp = O + (size_t)(row0 + ai * HALF + m * 16) * ldc + col0;
#pragma unroll
                for (int bj = 0; bj < 2; ++bj) { f32x4 v0 = acc[ai][bj][m][0], v1 = acc[ai][bj][m][1];
                    v0 = __builtin_elementwise_max(v0, (f32x4){0.f, 0.f, 0.f, 0.f}); v1 = __builtin_elementwise_max(v1, (f32x4){0.f, 0.f, 0.f, 0.f}); v0 = v0 * v0; v1 = v1 * v1;
                    u32x4 w; w.x = cvt_pk_bf16(v0[0], v0[1]); w.y = cvt_pk_bf16(v0[2], v0[3]); w.z = cvt_pk_bf16(v1[0], v1[1]); w.w = cvt_pk_bf16(v1[2], v1[3]);
                    *(u32x4*)(rowp + bj * HALF) = w; } }
    }
};
}

#define GAS __attribute__((address_space(1)))
#define LAS __attribute__((address_space(3)))
typedef unsigned short bf16;
typedef unsigned v4u __attribute__((ext_vector_type(4)));
typedef float f32x4 __attribute__((ext_vector_type(4)));
typedef short bf16x8 __attribute__((ext_vector_type(8)));
typedef GAS unsigned gu32;
typedef GAS unsigned long long gu64;
#define RLX_AGENT __ATOMIC_RELAXED, __HIP_MEMORY_SCOPE_AGENT
#define LDS_WAIT() asm volatile("s_waitcnt lgkmcnt(0)" ::: "memory")
#define VM_WAIT() asm volatile("s_waitcnt vmcnt(0)" ::: "memory")
__device__ __forceinline__ unsigned long long rt() { return __builtin_amdgcn_s_memrealtime(); }
__device__ __forceinline__ unsigned f2bf(float f) { unsigned u = __builtin_bit_cast(unsigned, f); return (u + 0x7fffu + ((u >> 16) & 1u)) >> 16; }
__device__ __forceinline__ unsigned pk2(float lo, float hi) { return f2bf(lo) | (f2bf(hi) << 16); }

#define XB_TMO      128
#define XB_XCNT(j)  (256  + 64 * (j))
#define XB_XSUB(j)  (1280 + 64 * (j))
#define XB_XGEN(j)  (2304 + 64 * (j))
#define XB_TOP      3328
#define XB_TOPGEN   3392
#define XCD_BAR_WORDS 3456
#define XB_SPIN_CAP (1u << 18)

__device__ __forceinline__ unsigned xb_ld(unsigned* p)              { return __hip_atomic_load(p, __ATOMIC_RELAXED, __HIP_MEMORY_SCOPE_AGENT); }
__device__ __forceinline__ unsigned xb_add(unsigned* p, unsigned v) { return __hip_atomic_fetch_add(p, v, __ATOMIC_RELAXED, __HIP_MEMORY_SCOPE_AGENT); }
__device__ __forceinline__ unsigned xb_xcc_id() { return (unsigned)__builtin_amdgcn_s_getreg((3 << 11) | 20) & 0xFu; }
#define XB_SPIN(cond, bar) do { unsigned _sp = 0; while (cond) { __builtin_amdgcn_s_sleep(1); \
    if ((++_sp & 255u) == 0u) { if (xb_ld(&(bar)[XB_TMO])) break; if (_sp > XB_SPIN_CAP) { atomicAdd(&(bar)[XB_TMO], 1u); break; } } } } while (0)

struct XcdBarrier {
    unsigned* bar; unsigned x;
    volatile LAS unsigned* st;
};

__device__ __forceinline__ XcdBarrier xcd_barrier_post(unsigned* bar, volatile LAS unsigned* st) {
    XcdBarrier b; b.bar = bar; b.x = xb_xcc_id(); b.st = st;
    if (threadIdx.x == 0) (void)xb_add(&bar[XB_XCNT(b.x)], 1u);
    return b;
}
__device__ __forceinline__ void xcd_barrier_complete(unsigned* bar, unsigned x, unsigned& nloc, unsigned& nx) {
    const unsigned G = gridDim.x * gridDim.y * gridDim.z;
    unsigned sum, cnt, mine, sp = 0u;
    for (;;) {
        sum = 0u; cnt = 0u; mine = 0u;
#pragma unroll
        for (unsigned j = 0; j < 16; ++j) { const unsigned c = xb_ld(&bar[XB_XCNT(j)]); sum += c; cnt += (c > 0u) ? 1u : 0u; mine = (j == x) ? c : mine; }
        if (sum == G) break;
        __builtin_amdgcn_s_sleep(1);
        if ((++sp & 255u) == 0u) { if (xb_ld(&bar[XB_TMO])) break; if (sp > XB_SPIN_CAP) { atomicAdd(&bar[XB_TMO], 1u); break; } }
    }
    nloc = mine > 0u ? mine : 1u; nx = cnt > 0u ? cnt : 1u;
}

__device__ __forceinline__ void xcd_barrier(const XcdBarrier& b) {
    asm volatile("s_waitcnt vmcnt(0)" ::: "memory");
    __syncthreads();
    if (threadIdx.x == 0) {
        unsigned* bar = b.bar;
        __builtin_amdgcn_s_waitcnt(0);
        unsigned nloc = b.st[0], nx = b.st[1];
        if (nloc == 0u) { xcd_barrier_complete(bar, b.x, nloc, nx); b.st[0] = nloc; b.st[1] = nx; }
        const unsigned old = xb_add(&bar[XB_XSUB(b.x)], 1u);
        const unsigned gen = old / nloc;
        if (old + 1u == (gen + 1u) * nloc) {
            __builtin_amdgcn_fence(__ATOMIC_RELEASE, "agent");
            asm volatile("s_waitcnt vmcnt(0)" ::: "memory");
            const unsigned og = xb_add(&bar[XB_TOP], 1u);
            const unsigned tg = og / nx;
            if (og + 1u == (tg + 1u) * nx) xb_add(&bar[XB_TOPGEN], 1u);
            else XB_SPIN(xb_ld(&bar[XB_TOPGEN]) == tg, bar);
            __builtin_amdgcn_fence(__ATOMIC_ACQUIRE, "agent");
            xb_add(&bar[XB_XGEN(b.x)], 1u);
            asm volatile("s_waitcnt vmcnt(0)" ::: "memory");
        } else {
            XB_SPIN(xb_ld(&bar[XB_XGEN(b.x)]) == gen, bar);
            __builtin_amdgcn_fence(__ATOMIC_ACQUIRE, "agent");
            asm volatile("s_waitcnt vmcnt(0)" ::: "memory");
        }
    }
    __syncthreads();
}

constexpr int NWAVES = 8, NT = NWAVES * 64;
constexpr int BATCH = 4, SEQ = 2048, D = 2048, M = BATCH * SEQ, FF = 8192, DEPTH = 2;
constexpr int INW = 26704, NPAD = 26880;
constexpr int MODW = 6 * D;
constexpr float LN_EPS = 1e-5f, NORM_EPS = 1e-6f, ALPHA = 1.4142135623730951f;
constexpr size_t MiB = 1u << 20;
constexpr size_t ACT_E = (size_t)M * D;
constexpr size_t WS_CTL = 0, CTL_ZERO_BYTES = 1 * MiB;
constexpr size_t WS_MODP = 2 * MiB;
constexpr size_t WS_MOD = 8 * MiB;
constexpr size_t WS_SMALL = 10 * MiB;
constexpr size_t WS_CUM = 18 * MiB;
constexpr size_t WS_BETA = 19 * MiB, WS_GG = 20 * MiB;
constexpr size_t WS_W = 32 * MiB;
constexpr size_t W_LAYER = 201 * MiB, W_IN = 0, W_A = 105 * MiB, W_B = 113 * MiB, W_C = 121 * MiB, W_O = 129 * MiB, W_1 = 137 * MiB, W_2 = 169 * MiB;
constexpr size_t WS_U = 448 * MiB;
constexpr size_t WS_X = 480 * MiB;
constexpr size_t WS_PRE = 544 * MiB;
constexpr size_t WS_T = 608 * MiB;
constexpr size_t WS_H = 608 * MiB;
constexpr size_t WS_YA = 1024 * MiB, WS_YB = 1056 * MiB, WS_YC = 1088 * MiB, WS_MG = 1120 * MiB;
constexpr size_t WS_MACC = 1152 * MiB;
constexpr size_t WS_QN = 1216 * MiB, WS_KN = 1280 * MiB, WS_VN = 1344 * MiB, WS_ORAW = 1408 * MiB;
constexpr size_t WS_END = 1472 * MiB;
constexpr int CW_BAR = 4096;
constexpr int LDS_BYTES = 147456, MISC_OFF = 131072 + 320;
enum { TI_CB = 0, TI_CC, TI_CH, TI_GQ, TI_GK, TI_GV, TI_GZ, TI_FQ, TI_FK, TI_FV, TI_MA, TI_MB, TI_MC };
__host__ __device__ constexpr int src_off(int t) { return t < 7 ? 2048 * t : (t < 10 ? 14400 + 2048 * (t - 7) : 20560 + 2048 * (t - 10)); }
constexpr int SRC_GB = 14336, SRC_FF = 20544;
enum { I_X = 0, I_C, I_WADA, I_BADA, I_WIN, I_CONVW, I_GCONVW, I_ALOG, I_DTB, I_GNORMW, I_FBIAS, I_WA, I_WB, I_WC, I_WO, I_LN1G, I_LN1B, I_W1, I_W2, I_LN2G, I_LN2B, N_IN };

typedef unsigned u32x4 __attribute__((ext_vector_type(4)));
typedef unsigned u32x2 __attribute__((ext_vector_type(2)));
__device__ __forceinline__ float wave_sum(float v) {
#pragma unroll
    for (int o = 1; o < 64; o <<= 1) v += __shfl_xor(v, o);
    return v;
}
__device__ __forceinline__ float wave_max(float v) {
#pragma unroll
    for (int o = 1; o < 64; o <<= 1) v = fmaxf(v, __shfl_xor(v, o));
    return v;
}
__device__ __forceinline__ float bflo(unsigned w) { return __builtin_bit_cast(float, w << 16); }
__device__ __forceinline__ float bfhi(unsigned w) { return __builtin_bit_cast(float, w & 0xffff0000u); }
__device__ __forceinline__ void unpack8(const u32x4 w, float (&f)[8]) { f[0] = bflo(w.x); f[1] = bfhi(w.x); f[2] = bflo(w.y); f[3] = bfhi(w.y); f[4] = bflo(w.z); f[5] = bfhi(w.z); f[6] = bflo(w.w); f[7] = bfhi(w.w); }
__device__ __forceinline__ u32x4 pack8(const float (&f)[8]) { u32x4 w; w.x = pg8::cvt_pk_bf16(f[0], f[1]); w.y = pg8::cvt_pk_bf16(f[2], f[3]); w.z = pg8::cvt_pk_bf16(f[4], f[5]); w.w = pg8::cvt_pk_bf16(f[6], f[7]); return w; }
__device__ __forceinline__ float fsilu(float x) { return x / (1.f + __expf(-x)); }

__device__ __forceinline__ void tr_item(const float* __restrict__ W, size_t ldw, bf16* __restrict__ WT, size_t K, int kb, int nb, int lane) {
    const int kq = lane & 7, nq = lane >> 3;
    const float* src = W + (size_t)(kb * 64 + kq * 8) * ldw + nb * 32 + nq * 4;
    f32x4 v[8];
#pragma unroll
    for (int i = 0; i < 8; ++i) v[i] = *(const f32x4*)(src + (size_t)i * ldw);
    bf16* dst = WT + (size_t)(nb * 32 + nq * 4) * K + kb * 64 + kq * 8;
#pragma unroll
    for (int j = 0; j < 4; ++j) { u32x4 o; o.x = pg8::cvt_pk_bf16(v[0][j], v[1][j]); o.y = pg8::cvt_pk_bf16(v[2][j], v[3][j]); o.z = pg8::cvt_pk_bf16(v[4][j], v[5][j]); o.w = pg8::cvt_pk_bf16(v[6][j], v[7][j]);
        *(u32x4*)(dst + (size_t)j * K) = o; }
}

__device__ __forceinline__ void modulate_row(const float* __restrict__ xr, bf16* __restrict__ ur, const float* __restrict__ shift, const float* __restrict__ scale, int lane) {
#pragma unroll
    for (int j = 0; j < 8; ++j) { const int c = 4 * lane + 256 * j; const f32x4 v = *(const f32x4*)(xr + c), sc = *(const f32x4*)(scale + c), sh = *(const f32x4*)(shift + c);
        const f32x4 y = v * (sc + 1.f) + sh; u32x2 o; o.x = pg8::cvt_pk_bf16(y[0], y[1]); o.y = pg8::cvt_pk_bf16(y[2], y[3]); *(u32x2*)(ur + c) = o; }
}
__device__ __forceinline__ void ln_mod_row(const float* __restrict__ pre, const float* __restrict__ g, const float* __restrict__ bt, float* __restrict__ xo, bf16* __restrict__ uo,
                                           const float* __restrict__ shift, const float* __restrict__ scale, int lane) {
    f32x4 v[8]; float s = 0.f;
#pragma unroll
    for (int j = 0; j < 8; ++j) { v[j] = *(const f32x4*)(pre + 4 * lane + 256 * j); s += (v[j][0] + v[j][1]) + (v[j][2] + v[j][3]); }
    const float mean = wave_sum(s) * (1.f / D); float s2 = 0.f;
#pragma unroll
    for (int j = 0; j < 8; ++j) { v[j] = v[j] - mean; s2 += (v[j][0] * v[j][0] + v[j][1] * v[j][1]) + (v[j][2] * v[j][2] + v[j][3] * v[j][3]); }
    const float rstd = 1.f / sqrtf(wave_sum(s2) * (1.f / D) + LN_EPS);
#pragma unroll
    for (int j = 0; j < 8; ++j) { const int c = 4 * lane + 256 * j; const f32x4 y = v[j] * rstd * *(const f32x4*)(g + c) + *(const f32x4*)(bt + c);
        *(f32x4*)(xo + c) = y;
        if (uo) { const f32x4 u = y * (*(const f32x4*)(scale + c) + 1.f) + *(const f32x4*)(shift + c); u32x2 o; o.x = pg8::cvt_pk_bf16(u[0], u[1]); o.y = pg8::cvt_pk_bf16(u[2], u[3]); *(u32x2*)(uo + c) = o; } }
}

struct Args { const float* in[N_IN]; float* out; unsigned char* ws; int ph_lo, ph_hi; };
constexpr int NPL = 10, NPH = 3 + DEPTH * NPL;

__global__ void __launch_bounds__(NT, 2) fwd_kernel(Args args) {
    extern __shared__ __attribute__((aligned(16))) unsigned char lds_raw[];
    LAS unsigned char* lds = (LAS unsigned char*)lds_raw;
    const int G = gridDim.x, blk = blockIdx.x, NGW = G * NWAVES, NGT = G * NT;
    volatile LAS unsigned* MISC = (volatile LAS unsigned*)(lds + MISC_OFF);
    for (int u = threadIdx.x; u < (LDS_BYTES - 131072) / 4; u += NT) ((LAS unsigned*)(lds + 131072))[u] = 0u;
    __syncthreads();
    XcdBarrier bar = xcd_barrier_post((unsigned*)((gu32*)(args.ws + WS_CTL) + CW_BAR), MISC + 8);
    const int lo = args.ph_lo, hi = args.ph_hi;
#define IN(k) (lo <= (k) && (k) < hi)
#define SEAM(k) do { if (IN(k) && IN((k) + 1)) xcd_barrier(bar); } while (0)
#define PH_BEGIN \
    int tid = threadIdx.x; asm volatile("" : "+v"(tid)); const int lane = tid & 63, wave = __builtin_amdgcn_readfirstlane(tid >> 6); \
    const int gw = blk * NWAVES + wave, gtid = blk * NT + tid; (void)gw; (void)gtid; (void)lane; \
    unsigned char* ws = args.ws; asm volatile("" : "+s"(ws)); \
    const float* x_in = args.in[I_X]; (void)x_in; \
    float* modp = (float*)(ws + WS_MODP); float* mod = (float*)(ws + WS_MOD); float* SMALL = (float*)(ws + WS_SMALL); (void)modp; (void)mod; (void)SMALL; \
    float* CUM = (float*)(ws + WS_CUM); float* BETA = (float*)(ws + WS_BETA); float* GG = (float*)(ws + WS_GG); (void)CUM; (void)BETA; (void)GG; \
    bf16* U = (bf16*)(ws + WS_U); float* X = (float*)(ws + WS_X); float* PRE = (float*)(ws + WS_PRE); (void)U; (void)X; (void)PRE; \
    bf16* T = (bf16*)(ws + WS_T); bf16* H = (bf16*)(ws + WS_H); (void)T; (void)H; \
    bf16* YA = (bf16*)(ws + WS_YA); bf16* YB = (bf16*)(ws + WS_YB); bf16* YC = (bf16*)(ws + WS_YC); bf16* MG = (bf16*)(ws + WS_MG); (void)YA; (void)YB; (void)YC; (void)MG; \
    float* MACC = (float*)(ws + WS_MACC); float* QN = (float*)(ws + WS_QN); float* KN = (float*)(ws + WS_KN); float* VN = (float*)(ws + WS_VN); float* ORAW = (float*)(ws + WS_ORAW); \
    (void)MACC; (void)QN; (void)KN; (void)VN; (void)ORAW;

    if (IN(0)) { PH_BEGIN
        LAS f32x4* ca = (LAS f32x4*)lds;
        const float* c = args.in[I_C];
        for (int k = tid; k < D; k += NT) { f32x4 v; for (int b = 0; b < 4; ++b) { const float cv = c[b * D + k]; v[b] = cv / (1.f + expf(-cv)); } ca[k] = v; }
        __syncthreads();
        const float* w_ada = args.in[I_WADA];
        for (int it = gw; it < 1536; it += NGW) {
            const int l = it / 768, r = it % 768, jblk = r >> 4, kc = r & 15;
            const float* W = w_ada + ((size_t)(l * D + kc * 128)) * MODW + jblk * 256 + lane * 4;
            f32x4 a0 = {0.f, 0.f, 0.f, 0.f}, a1 = a0, a2 = a0, a3 = a0;
#pragma unroll 8
            for (int k = 0; k < 128; ++k) { const f32x4 w = *(const f32x4*)(W + (size_t)k * MODW); const f32x4 cv = ca[kc * 128 + k]; a0 += w * cv[0]; a1 += w * cv[1]; a2 += w * cv[2]; a3 += w * cv[3]; }
            float* P = modp + ((size_t)((l * 16 + kc) * 4)) * MODW + jblk * 256 + lane * 4;
            *(f32x4*)(P) = a0; *(f32x4*)(P + MODW) = a1; *(f32x4*)(P + 2 * MODW) = a2; *(f32x4*)(P + 3 * MODW) = a3;
        }
    }
    SEAM(0);
    if (IN(1)) { PH_BEGIN
        const float* b_ada = args.in[I_BADA];
        for (int i = gtid; i < DEPTH * 4 * MODW; i += NGT) { const int l = i / (4 * MODW), r = i % (4 * MODW), b = r / MODW, j = r % MODW; float s = b_ada[l * MODW + j];
            for (int kc = 0; kc < 16; ++kc) s += modp[((size_t)((l * 16 + kc) * 4 + b)) * MODW + j];
            mod[i] = s; }
        constexpr int I_IN = 13 * 32 * 64, I_TAIL = 96, I_SQ = 4 * 32 * 64, I_F1 = 32 * 256, I_F2 = 128 * 64, I_L = I_IN + I_TAIL + I_SQ + I_F1 + I_F2;
        for (int it = gw; it < DEPTH * I_L; it += NGW) {
            const int l = it / I_L; int r = it % I_L; unsigned char* wl = ws + WS_W + (size_t)l * W_LAYER;
            if (r < I_IN) { const int t = r >> 11, q = r & 2047; tr_item(args.in[I_WIN] + (size_t)l * D * INW + src_off(t), INW, (bf16*)(wl + W_IN) + (size_t)t * D * D, D, q >> 6, q & 63, lane); continue; } r -= I_IN;
            if (r < I_TAIL) { const int nb = r >> 5, kb = r & 31; tr_item(args.in[I_WIN] + (size_t)l * D * INW + (nb < 2 ? SRC_GB + 32 * nb : SRC_FF), INW, (bf16*)(wl + W_IN) + (size_t)(13 * D + 32 * nb) * D, D, kb, 0, lane); continue; } r -= I_TAIL;
            if (r < I_SQ) { const int t = r >> 11, q = r & 2047; tr_item((t == 0 ? args.in[I_WA] : t == 1 ? args.in[I_WB] : t == 2 ? args.in[I_WC] : args.in[I_WO]) + (size_t)l * D * D, D, (bf16*)(wl + W_A + (size_t)t * 8 * MiB), D, q >> 6, q & 63, lane); continue; } r -= I_SQ;
            if (r < I_F1) { tr_item(args.in[I_W1] + (size_t)l * D * FF, FF, (bf16*)(wl + W_1), D, r >> 8, r & 255, lane); continue; } r -= I_F1;
            tr_item(args.in[I_W2] + (size_t)l * FF * D, D, (bf16*)(wl + W_2), FF, r >> 6, r & 63, lane);
        }
        for (int i = gtid; i < DEPTH * 160 * (D / 8); i += NGT) { const int l = i / (160 * 256), r = i % (160 * 256); bf16* p = (bf16*)(ws + WS_W + (size_t)l * W_LAYER + W_IN) + (size_t)(13 * D + 96 + (r >> 8)) * D + (r & 255) * 8;
            *(u32x4*)p = (u32x4){0u, 0u, 0u, 0u}; }
    }
    SEAM(1);
    if (IN(2)) { PH_BEGIN
        for (int m = gw; m < M; m += NGW) { const float* mb = mod + (size_t)(m >> 11) * MODW; modulate_row(x_in + (size_t)m * D, U + (size_t)m * D, mb, mb + D, lane); }
    }
    SEAM(2);

    for (int l = 0; l < DEPTH; ++l) {
        const int pb = 3 + l * NPL;
#define LAYER_PTRS unsigned char* wl = ws + WS_W + (size_t)l * W_LAYER; const float* modl = mod + (size_t)l * 4 * MODW; const float* Xin = (l == 0) ? x_in : X; (void)wl; (void)modl; (void)Xin;
        if (IN(pb + 0)) { PH_BEGIN LAYER_PTRS
            pg8::Gemm g{U, (const bf16*)(wl + W_IN), M, NPAD, D}; pg8::StaticOrder S; S.init(M, NPAD, G, blk);
            pg8::EpiInProj E{T, SMALL, ACT_E};
            pg8::gemm_phase<pg8::EpiInProj, pg8::StaticOrder, true, true>(lds, g, S, E);
        }
        SEAM(pb + 0);
        if (IN(pb + 1)) { PH_BEGIN LAYER_PTRS
            { const float* cw = args.in[I_CONVW] + (size_t)l * 3 * D; const bf16 *CB = T + TI_CB * ACT_E, *CC = T + TI_CC * ACT_E, *CH = T + TI_CH * ACT_E;
              for (int it = gtid; it < (M / 8) * 256; it += NGT) {
                const int col = (it & 255) * 8, m0 = (it >> 8) * 8; const bool first = (m0 & (SEQ - 1)) == 0;
                float w0[8], w1[8], w2[8], p2[8], p1[8];
#pragma unroll
                for (int i = 0; i < 8; ++i) { w0[i] = cw[col + i]; w1[i] = cw[D + col + i]; w2[i] = cw[2 * D + col + i]; p2[i] = 0.f; p1[i] = 0.f; }
                if (!first) { float a[8], b[8];
                    unpack8(*(const u32x4*)(CC + (size_t)(m0 - 2) * D + col), a); unpack8(*(const u32x4*)(CH + (size_t)(m0 - 2) * D + col), b);
#pragma unroll
                    for (int i = 0; i < 8; ++i) p2[i] = a[i] * b[i];
                    unpack8(*(const u32x4*)(CC + (size_t)(m0 - 1) * D + col), a); unpack8(*(const u32x4*)(CH + (size_t)(m0 - 1) * D + col), b);
#pragma unroll
                    for (int i = 0; i < 8; ++i) p1[i] = a[i] * b[i]; }
                for (int r = 0; r < 8; ++r) { const size_t o = (size_t)(m0 + r) * D + col; float a[8], b[8], g[8], y[8];
                    unpack8(*(const u32x4*)(CC + o), a); unpack8(*(const u32x4*)(CH + o), b); unpack8(*(const u32x4*)(CB + o), g);
#pragma unroll
                    for (int i = 0; i < 8; ++i) { const float p0 = a[i] * b[i]; y[i] = g[i] * (w0[i] * p2[i] + w1[i] * p1[i] + w2[i] * p0); p2[i] = p1[i]; p1[i] = p0; }
                    *(u32x4*)(YA + o) = pack8(y); }
              } }
            { const float* gcw = args.in[I_GCONVW] + (size_t)l * 4 * 6144;
              for (int it = gw; it < 6144; it += NGW) {
                const int cgp = it & 3, ten = (it >> 2) % 3, rb = it / 12; const int ch = cgp * 512 + lane * 8; const int m0 = rb * 16; const bool first = (m0 & (SEQ - 1)) == 0;
                const bf16* src = T + (size_t)(TI_GQ + ten) * ACT_E; float* dst = (ten == 0) ? QN : (ten == 1 ? KN : VN);
                float w[4][8], h3[8], h2[8], h1[8];
#pragma unroll
                for (int i = 0; i < 8; ++i) { w[0][i] = gcw[ten * D + ch + i]; w[1][i] = gcw[6144 + ten * D + ch + i]; w[2][i] = gcw[2 * 6144 + ten * D + ch + i]; w[3][i] = gcw[3 * 6144 + ten * D + ch + i]; h3[i] = 0.f; h2[i] = 0.f; h1[i] = 0.f; }
                if (!first) { unpack8(*(const u32x4*)(src + (size_t)(m0 - 3) * D + ch), h3); unpack8(*(const u32x4*)(src + (size_t)(m0 - 2) * D + ch), h2); unpack8(*(const u32x4*)(src + (size_t)(m0 - 1) * D + ch), h1); }
                for (int r = 0; r < 16; ++r) { const size_t o = (size_t)(m0 + r) * D + ch; float h0[8], y[8]; unpack8(*(const u32x4*)(src + o), h0); float ss = 0.f;
#pragma unroll
                    for (int i = 0; i < 8; ++i) { const float a = w[0][i] * h3[i] + w[1][i] * h2[i] + w[2][i] * h1[i] + w[3][i] * h0[i]; y[i] = a / (1.f + expf(-a)); ss += y[i] * y[i]; h3[i] = h2[i]; h2[i] = h1[i]; h1[i] = h0[i]; }
                    if (ten < 2) { ss += __shfl_xor(ss, 1); ss += __shfl_xor(ss, 2); ss += __shfl_xor(ss, 4); ss += __shfl_xor(ss, 8); const float rn = 1.f / sqrtf(ss + NORM_EPS);
#pragma unroll
                        for (int i = 0; i < 8; ++i) y[i] *= rn; }
                    *(f32x4*)(dst + o) = (f32x4){y[0], y[1], y[2], y[3]}; *(f32x4*)(dst + o + 4) = (f32x4){y[4], y[5], y[6], y[7]}; }
              } }
            { const float* alog = args.in[I_ALOG] + l * 32; const float* dtb = args.in[I_DTB] + l * 32;
              for (int i = gtid; i < M * 32; i += NGT) { const int m = i >> 5, hv = i & 31; const float bl = SMALL[(size_t)m * 256 + hv], al = SMALL[(size_t)m * 256 + 32 + hv];
                BETA[i] = 1.f / (1.f + expf(-bl)); const float xx = al + dtb[hv]; const float sp = fmaxf(xx, 0.f) + log1pf(expf(-fabsf(xx))); GG[i] = -expf(alog[hv]) * sp; } }
            { const float* fbias = args.in[I_FBIAS] + l * 16;
              for (int it = gw; it < 64; it += NGW) { const int b = it >> 4, h = it & 15; const float fb = fbias[h]; const size_t mbase = (size_t)b * SEQ + lane * 32; float tot = 0.f;
                for (int i = 0; i < 32; ++i) { const float xx = SMALL[(mbase + i) * 256 + 64 + h] + fb; tot += fminf(xx, 0.f) - log1pf(expf(-fabsf(xx))); }
                float inc = tot;
#pragma unroll
                for (int o = 1; o < 64; o <<= 1) { const float n = __shfl_up(inc, o); if (lane >= o) inc += n; }
                float run = inc - tot;
                for (int i = 0; i < 32; ++i) { const float xx = SMALL[(mbase + i) * 256 + 64 + h] + fb; run += fminf(xx, 0.f) - log1pf(expf(-fabsf(xx))); CUM[(size_t)it * SEQ + lane * 32 + i] = run; }
              } }
        }
        SEAM(pb + 1);
        if (IN(pb + 2)) { PH_BEGIN LAYER_PTRS
            if (wave < 4) {
                const int it = blk * 4 + wave;
                if (it < 1024) {
                    const int b = it >> 8, hv = (it >> 3) & 31, dvc = it & 7, hk = hv >> 1, kq = lane >> 3, col = lane & 7;
                    float S[16];
#pragma unroll
                    for (int i = 0; i < 16; ++i) S[i] = 0.f;
                    const float* kp = KN + (size_t)b * SEQ * D + hk * 128 + kq * 16; const float* qp = QN + (size_t)b * SEQ * D + hk * 128 + kq * 16;
                    const float* vp = VN + (size_t)b * SEQ * D + hv * 64 + dvc * 8 + col; const float* bp = BETA + (size_t)b * SEQ * 32 + hv; const float* gp = GG + (size_t)b * SEQ * 32 + hv;
                    float* op = ORAW + (size_t)b * SEQ * D + hv * 64 + dvc * 8 + col;
                    f32x4 kn[4], qn[4]; float vn, bn, gn;
#pragma unroll
                    for (int i = 0; i < 4; ++i) { kn[i] = *(const f32x4*)(kp + 4 * i); qn[i] = *(const f32x4*)(qp + 4 * i); }
                    vn = vp[0]; bn = bp[0]; gn = gp[0];
                    for (int t = 0; t < SEQ; ++t) {
                        f32x4 kc[4], qc[4]; const float vc = vn, bc = bn, gc = gn;
#pragma unroll
                        for (int i = 0; i < 4; ++i) { kc[i] = kn[i]; qc[i] = qn[i]; }
                        if (t + 1 < SEQ) { const size_t o = (size_t)(t + 1) * D;
#pragma unroll
                            for (int i = 0; i < 4; ++i) { kn[i] = *(const f32x4*)(kp + o + 4 * i); qn[i] = *(const f32x4*)(qp + o + 4 * i); }
                            vn = vp[o]; bn = bp[(size_t)(t + 1) * 32]; gn = gp[(size_t)(t + 1) * 32]; }
                        const float eg = expf(gc); float p = 0.f;
#pragma unroll
                        for (int i = 0; i < 16; ++i) { S[i] *= eg; p += kc[i >> 2][i & 3] * S[i]; }
                        p += __shfl_xor(p, 8); p += __shfl_xor(p, 16); p += __shfl_xor(p, 32);
                        const float dlt = bc * (vc - p); float o = 0.f;
#pragma unroll
                        for (int i = 0; i < 16; ++i) { S[i] += kc[i >> 2][i & 3] * dlt; o += qc[i >> 2][i & 3] * S[i]; }
                        o += __shfl_xor(o, 8); o += __shfl_xor(o, 16); o += __shfl_xor(o, 32);
                        if (kq == 0) op[(size_t)t * D] = o * 0.08838834764831845f;
                    }
                }
            }
            __syncthreads();
            {
                LAS float* Qs = (LAS float*)lds;
                LAS float* Kt = Qs + 128 * 64;
                LAS float* Vs = Kt + 128 * 64;
                LAS float* Ps = Vs + 64 * 128;
                const bf16 *FQ = T + TI_FQ * ACT_E, *FK = T + TI_FK * ACT_E, *FV = T + TI_FV * ACT_E;
                const int bh = blk >> 2, b = bh >> 4, h = bh & 15, rq = blk & 3;
                if (blk < 256)
                for (int i = 0; i < 8; ++i) {
                    const int a = 4 * (i >> 1) + rq, qi = (i & 1) ? 31 - a : a, q0 = qi * 64; const size_t mb = (size_t)b * SEQ;
                    __syncthreads();
                    { const int r = tid & 63, dc = tid >> 6; const bf16* p = FQ + (mb + q0 + r) * D + h * 128 + dc * 16; float f0[8], f1[8]; unpack8(*(const u32x4*)p, f0); unpack8(*(const u32x4*)(p + 8), f1);
#pragma unroll
                      for (int e = 0; e < 8; ++e) { Qs[(dc * 16 + e) * 64 + r] = f0[e]; Qs[(dc * 16 + 8 + e) * 64 + r] = f1[e]; } }
                    float m_run[8], l_run[8], o0[8], o1[8], cq[8];
#pragma unroll
                    for (int rr = 0; rr < 8; ++rr) { m_run[rr] = -1e30f; l_run[rr] = 0.f; o0[rr] = 0.f; o1[rr] = 0.f; cq[rr] = CUM[(size_t)bh * SEQ + q0 + wave * 8 + rr]; }
                    for (int kt = 0; kt <= qi; ++kt) {
                        const int k0 = kt * 64;
                        __syncthreads();
                        { const int j = tid & 63, dc = tid >> 6; const bf16* p = FK + (mb + k0 + j) * D + h * 128 + dc * 16; float f0[8], f1[8]; unpack8(*(const u32x4*)p, f0); unpack8(*(const u32x4*)(p + 8), f1);
#pragma unroll
                          for (int e = 0; e < 8; ++e) { Kt[(dc * 16 + e) * 64 + j] = f0[e]; Kt[(dc * 16 + 8 + e) * 64 + j] = f1[e]; } }
                        { const int j = tid >> 3, dc = tid & 7; const bf16* p = FV + (mb + k0 + j) * D + h * 128 + dc * 16; float f0[8], f1[8]; unpack8(*(const u32x4*)p, f0); unpack8(*(const u32x4*)(p + 8), f1);
                          LAS f32x4* d4 = (LAS f32x4*)(Vs + j * 128 + dc * 16); d4[0] = (f32x4){f0[0], f0[1], f0[2], f0[3]}; d4[1] = (f32x4){f0[4], f0[5], f0[6], f0[7]}; d4[2] = (f32x4){f1[0], f1[1], f1[2], f1[3]}; d4[3] = (f32x4){f1[4], f1[5], f1[6], f1[7]}; }
                        __syncthreads();
                        float s[8];
#pragma unroll
                        for (int rr = 0; rr < 8; ++rr) s[rr] = 0.f;
#pragma unroll 4
                        for (int d = 0; d < 128; ++d) { const float kv = Kt[d * 64 + lane]; const f32x4 qa = *(const LAS f32x4*)(Qs + d * 64 + wave * 8), qb = *(const LAS f32x4*)(Qs + d * 64 + wave * 8 + 4);
                            s[0] += qa[0] * kv; s[1] += qa[1] * kv; s[2] += qa[2] * kv; s[3] += qa[3] * kv; s[4] += qb[0] * kv; s[5] += qb[1] * kv; s[6] += qb[2] * kv; s[7] += qb[3] * kv; }
                        const float ck = CUM[(size_t)bh * SEQ + k0 + lane];
#pragma unroll
                        for (int rr = 0; rr < 8; ++rr) { float sc = s[rr] * 0.08838834764831845f + cq[rr] - ck; if (k0 + lane > q0 + wave * 8 + rr) sc = -__builtin_inff();
                            const float mx = wave_max(sc), mn = fmaxf(m_run[rr], mx), al = expf(m_run[rr] - mn), p = expf(sc - mn);
                            l_run[rr] = l_run[rr] * al + wave_sum(p); m_run[rr] = mn; o0[rr] *= al; o1[rr] *= al; Ps[(wave * 8 + rr) * 64 + lane] = p; }
                        LDS_WAIT();
#pragma unroll 2
                        for (int j4 = 0; j4 < 16; ++j4) { float v0[4], v1[4];
#pragma unroll
                            for (int jj = 0; jj < 4; ++jj) { v0[jj] = Vs[(j4 * 4 + jj) * 128 + lane]; v1[jj] = Vs[(j4 * 4 + jj) * 128 + 64 + lane]; }
#pragma unroll
                            for (int rr = 0; rr < 8; ++rr) { const f32x4 pv = *(const LAS f32x4*)(Ps + (wave * 8 + rr) * 64 + j4 * 4);
#pragma unroll
                                for (int jj = 0; jj < 4; ++jj) { o0[rr] += pv[jj] * v0[jj]; o1[rr] += pv[jj] * v1[jj]; } } }
                    }
#pragma unroll
                    for (int rr = 0; rr < 8; ++rr) { const float inv = 1.f / l_run[rr]; bf16* op = YC + (mb + q0 + wave * 8 + rr) * D + h * 128;
                        op[lane] = (bf16)f2bf(o0[rr] * inv); op[64 + lane] = (bf16)f2bf(o1[rr] * inv); }
                }
            }
        }
        SEAM(pb + 2);
        if (IN(pb + 3)) { PH_BEGIN LAYER_PTRS
            const float* nw = args.in[I_GNORMW] + l * 64; const bf16* GZ = T + TI_GZ * ACT_E;
            float nwv[8];
#pragma unroll
            for (int i = 0; i < 8; ++i) nwv[i] = nw[(lane & 7) * 8 + i];
            for (int it = gw; it < M * 4; it += NGW) { const size_t o = (size_t)(it >> 2) * D + (it & 3) * 512 + lane * 8;
                const f32x4 a = *(const f32x4*)(ORAW + o), b = *(const f32x4*)(ORAW + o + 4); float ov[8] = {a[0], a[1], a[2], a[3], b[0], b[1], b[2], b[3]}, z[8], y[8]; float ss = 0.f;
#pragma unroll
                for (int i = 0; i < 8; ++i) ss += ov[i] * ov[i];
                ss += __shfl_xor(ss, 1); ss += __shfl_xor(ss, 2); ss += __shfl_xor(ss, 4);
                const float rn = 1.f / sqrtf(ss * (1.f / 64.f) + NORM_EPS); unpack8(*(const u32x4*)(GZ + o), z);
#pragma unroll
                for (int i = 0; i < 8; ++i) y[i] = ov[i] * rn * nwv[i] * (z[i] / (1.f + expf(-z[i])));
                *(u32x4*)(YB + o) = pack8(y); }
        }
        SEAM(pb + 3);
        if (IN(pb + 4)) { PH_BEGIN LAYER_PTRS
            pg8::StaticOrder S; S.init(M, D, G, blk);
            { pg8::Gemm g{YA, (const bf16*)(wl + W_A), M, D, D}; pg8::EpiMerge<0> E{T + TI_MA * ACT_E, MACC, MG}; pg8::gemm_phase<pg8::EpiMerge<0>, pg8::StaticOrder, true, true>(lds, g, S, E); }
            { pg8::Gemm g{YB, (const bf16*)(wl + W_B), M, D, D}; pg8::EpiMerge<1> E{T + TI_MB * ACT_E, MACC, MG}; pg8::gemm_phase<pg8::EpiMerge<1>, pg8::StaticOrder, true, true>(lds, g, S, E); }
            { pg8::Gemm g{YC, (const bf16*)(wl + W_C), M, D, D}; pg8::EpiMerge<2> E{T + TI_MC * ACT_E, MACC, MG}; pg8::gemm_phase<pg8::EpiMerge<2>, pg8::StaticOrder, true, true>(lds, g, S, E); }
        }
        SEAM(pb + 4);
        if (IN(pb + 5)) { PH_BEGIN LAYER_PTRS
            pg8::Gemm g{MG, (const bf16*)(wl + W_O), M, D, D}; pg8::StaticOrder S; S.init(M, D, G, blk);
            pg8::EpiResid E{Xin, modl + 2 * D, PRE, ALPHA};
            pg8::gemm_phase<pg8::EpiResid, pg8::StaticOrder, true, true>(lds, g, S, E);
        }
        SEAM(pb + 5);
        if (IN(pb + 6)) { PH_BEGIN LAYER_PTRS
            const float* g1 = args.in[I_LN1G] + (size_t)l * D; const float* b1 = args.in[I_LN1B] + (size_t)l * D;
            for (int m = gw; m < M; m += NGW) { const float* mb = modl + (size_t)(m >> 11) * MODW; ln_mod_row(PRE + (size_t)m * D, g1, b1, X + (size_t)m * D, U + (size_t)m * D, mb + 3 * D, mb + 4 * D, lane); }
        }
        SEAM(pb + 6);
        if (IN(pb + 7)) { PH_BEGIN LAYER_PTRS
            pg8::Gemm g{U, (const bf16*)(wl + W_1), M, FF, D}; pg8::StaticOrder S; S.init(M, FF, G, blk);
            pg8::EpiRelu2 E{H, FF};
            pg8::gemm_phase<pg8::EpiRelu2, pg8::StaticOrder, true, true>(lds, g, S, E);
        }
        SEAM(pb + 7);
        if (IN(pb + 8)) { PH_BEGIN LAYER_PTRS
            pg8::Gemm g{H, (const bf16*)(wl + W_2), M, D, FF}; pg8::StaticOrder S; S.init(M, D, G, blk);
            pg8::EpiResid E{X, modl + 5 * D, PRE, ALPHA};
            pg8::gemm_phase<pg8::EpiResid, pg8::StaticOrder, true, true>(lds, g, S, E);
        }
        SEAM(pb + 8);
        if (IN(pb + 9)) { PH_BEGIN LAYER_PTRS
            const float* g2 = args.in[I_LN2G] + (size_t)l * D; const float* b2 = args.in[I_LN2B] + (size_t)l * D; const bool last = (l == DEPTH - 1);
            float* xo = last ? args.out : X; const float* modn = mod + (size_t)(last ? l : l + 1) * 4 * MODW;
            for (int m = gw; m < M; m += NGW) { const float* mb = modn + (size_t)(m >> 11) * MODW; ln_mod_row(PRE + (size_t)m * D, g2, b2, xo + (size_t)m * D, last ? (bf16*)nullptr : U + (size_t)m * D, mb, mb + D, lane); }
        }
        SEAM(pb + 9);
    }
#undef IN
#undef SEAM
}

#ifndef MK_ONE_LAUNCH
#define MK_ONE_LAUNCH 0
#endif
extern "C" void kernel_launch(void* const* d_in, const int* in_sizes, int n_in, void* d_out, int out_size, void* d_ws, size_t ws_size, hipStream_t stream) {
    static int grid = 0;
    if (grid == 0) {
        if (n_in != N_IN || out_size != M * D || ws_size < WS_END) { fprintf(stderr, "kernel_launch: unexpected shapes: n_in %d out %d ws %zu (need %zu)\n", n_in, out_size, ws_size, (size_t)WS_END); grid = -1; return; }
        int dev = 0, cus = 0, per_cu = 0;
        if (hipGetDevice(&dev) != hipSuccess || hipDeviceGetAttribute(&cus, hipDeviceAttributeMultiprocessorCount, dev) != hipSuccess) { grid = -1; return; }
        if (hipFuncSetAttribute((const void*)fwd_kernel, hipFuncAttributeMaxDynamicSharedMemorySize, LDS_BYTES) != hipSuccess) { fprintf(stderr, "kernel_launch: hipFuncSetAttribute failed\n"); grid = -1; return; }
        if (hipOccupancyMaxActiveBlocksPerMultiprocessor(&per_cu, (const void*)fwd_kernel, NT, LDS_BYTES) != hipSuccess || per_cu < 1) fprintf(stderr, "kernel_launch: occupancy query says %d\n", per_cu);
        (void)hipGetLastError();
        grid = cus;
        if (grid != 256) fprintf(stderr, "kernel_launch: %d CUs (built for 256)\n", grid);
    }
    if (grid < 0) return;
    (void)hipMemsetAsync((char*)d_ws + WS_CTL, 0, CTL_ZERO_BYTES, stream);
    Args a{};
    for (int i = 0; i < N_IN; ++i) a.in[i] = (const float*)d_in[i];
    a.out = (float*)d_out; a.ws = (unsigned char*)d_ws;
#if MK_ONE_LAUNCH
    a.ph_lo = 0; a.ph_hi = NPH;
    hipLaunchKernelGGL(fwd_kernel, dim3(grid), dim3(NT), LDS_BYTES, stream, a);
#else
    for (int p = 0; p < NPH; ++p) { a.ph_lo = p; a.ph_hi = p + 1; hipLaunchKernelGGL(fwd_kernel, dim3(grid), dim3(NT), LDS_BYTES, stream, a); }
#endif
}
```

```cpp
#include <hip/hip_runtime.h>
#include <cstdio>
#include <cstdint>
#define MK_ONE_LAUNCH 1
namespace pg8 {
#define PG8_LAS __attribute__((address_space(3)))
typedef unsigned short bf16_t;
typedef short bf16x8 __attribute__((ext_vector_type(8)));
typedef float f32x4 __attribute__((ext_vector_type(4)));
typedef unsigned u32x4 __attribute__((ext_vector_type(4)));
constexpr int BM = 256, BK = 64, HALF = 128, HTB = HALF * BK * 2  , STAGE_BYTES = 8 * HTB, NXCD = 8, WGM = 8;

__host__ __device__ __forceinline__ int lds_byte(int r, int c) { const int st = (r >> 4) * 2 + (c >> 5), rr = r & 15, cc = c & 31, ob = rr * 64 + cc * 2; return st * 1024 + (ob ^ (((ob >> 9) & 1) << 5)); }
__host__ __device__ __forceinline__ void stage_rc(int b, int& R, int& C) { const int st = b / 1024, sb = b % 1024, swz = sb ^ (((sb >> 9) & 1) << 5); R = (st >> 1) * 16 + swz / 64; C = (st & 1) * 32 + (swz % 64) / 2; }
__host__ __device__ __forceinline__ int perm32(int rho) { const int n = rho >> 4, i = rho & 15; return 8 * (i >> 2) + 4 * n + (i & 3); }

struct Unit { int pm, pn; };
struct Gemm { const bf16_t* A; const bf16_t* Bt; int M, N, K; };

struct StaticOrder {
    int nM, nN, nwg, G, c;
    __host__ __device__ void init(int M, int N, int G_, int c_) { nM = M / BM; nN = N / BM; nwg = nM * nN; G = G_; c = c_; }
    __host__ __device__ bool next(int i, Unit& u) const {
        const long L = (long)i * G + c; if (L >= nwg) return false;
        int wgid = (int)L; { const int q = nwg / NXCD, r = nwg % NXCD, xcd = wgid % NXCD, off = wgid / NXCD; wgid = (xcd < r ? xcd * (q + 1) : r * (q + 1) + (xcd - r) * q) + off; }
        const int nig = WGM * nN, gid = wgid / nig, fm = gid * WGM, gsz = (nM - fm) < WGM ? (nM - fm) : WGM;
        u.pm = fm + ((wgid % nig) % gsz); u.pn = (wgid % nig) / gsz; return true;
    }
    __device__ __forceinline__ void a_ready(const Unit&) const {}
    __device__ __forceinline__ void done(const Unit&) const {}
};

__device__ __forceinline__ unsigned cvt_pk_bf16(float lo, float hi) { unsigned r; asm volatile("v_cvt_pk_bf16_f32 %0, %1, %2" : "=v"(r) : "v"(lo), "v"(hi)); return r; }
typedef float f32x2 __attribute__((ext_vector_type(2)));
__device__ __forceinline__ f32x2 gelu_pk(f32x2 v) {
    const f32x2 av = __builtin_elementwise_abs(v), d = av * 0.2316418882f + 1.0f;
    f32x2 t; t.x = __builtin_amdgcn_rcpf(d.x); t.y = __builtin_amdgcn_rcpf(d.y);
    f32x2 q = t * 0.5307027145f + (-0.7265760135f); q = q * t + 0.7107068705f; q = q * t + (-0.142248368f); q = q * t + 0.127414796f; q = q * t;
    const f32x2 s = (v * v) * (-0.72134752044f);
    f32x2 e; e.x = __builtin_amdgcn_exp2f(s.x); e.y = __builtin_amdgcn_exp2f(s.y);
    const f32x2 m = v * (q * e), r = v - m;
    f32x2 o; o.x = v.x < 0.f ? m.x : r.x; o.y = v.y < 0.f ? m.y : r.y; return o;
}

template <int ACT  > struct EpiBf16 {
    static constexpr bool PERM = true, AFTER_DRAIN = false; static_assert(ACT == 0 || ACT == 1, "EpiBf16: ACT is 0 (none) or 1 (gelu_pk)");
    bf16_t* O; int ldc; const float* bias; int split_cols; size_t split_stride; float scale0;
    __device__ __forceinline__ void operator()(const f32x4 (&acc)[2][2][4][2], const Unit& u, int wr, int wc, int fr, int fq) const {
        const int row0 = u.pm * BM + wr * 64 + fr; int colt = u.pn * BM; bf16_t* base = O;
        float sc = 1.f; if (split_cols) { const int t = colt / split_cols; base += (size_t)t * split_stride; colt -= t * split_cols; if (t == 0) sc = scale0; }
        const int col0 = colt + wc * 32 + 8 * fq, bcol0 = u.pn * BM + wc * 32 + 8 * fq;
        f32x4 bv[2][2];
#pragma unroll
        for (int bj = 0; bj < 2; ++bj)
#pragma unroll
            for (int n = 0; n < 2; ++n) bv[bj][n] = bias ? *(const f32x4*)(bias + bcol0 + bj * HALF + 4 * n) : (f32x4){0.f, 0.f, 0.f, 0.f};
#pragma unroll
        for (int ai = 0; ai < 2; ++ai)
#pragma unroll
            for (int m = 0; m < 4; ++m) { bf16_t* rowp = base + (size_t)(row0 + ai * HALF + m * 16) * ldc + col0;
#pragma unroll
                for (int bj = 0; bj < 2; ++bj) { f32x4 v0 = acc[ai][bj][m][0] + bv[bj][0], v1 = acc[ai][bj][m][1] + bv[bj][1];
                    if (ACT == 1) { f32x2 a = gelu_pk((f32x2){v0[0], v0[1]}), b = gelu_pk((f32x2){v0[2], v0[3]}), c = gelu_pk((f32x2){v1[0], v1[1]}), d = gelu_pk((f32x2){v1[2], v1[3]});
                        v0 = (f32x4){a.x, a.y, b.x, b.y}; v1 = (f32x4){c.x, c.y, d.x, d.y}; }
                    v0 = v0 * sc; v1 = v1 * sc; u32x4 w; w.x = cvt_pk_bf16(v0[0], v0[1]); w.y = cvt_pk_bf16(v0[2], v0[3]); w.z = cvt_pk_bf16(v1[0], v1[1]); w.w = cvt_pk_bf16(v1[2], v1[3]);
                    *(u32x4*)(rowp + bj * HALF) = w; } }
    }
};


template <class Epi, class Sched, bool ALIGN_EPI = false, bool SP2 = false>
__device__ __forceinline__ void gemm_phase(PG8_LAS unsigned char* lds, const Gemm g, const Sched& S, const Epi& E) {
    int tid_l = threadIdx.x; asm volatile("" : "+v"(tid_l));
    const int tid = tid_l, wid = __builtin_amdgcn_readfirstlane(tid >> 6), lane = tid & 63, wr = wid >> 2, wc = wid & 3, fr = lane & 15, fq = lane >> 4;
    const int K = g.K, nt = K / BK;
    unsigned voffA[2], voffB[2];
#pragma unroll
    for (int i = 0; i < 2; ++i) { int R, C; stage_rc(tid * 16 + i * 8192, R, C); const int Rb = Epi::PERM ? ((R & ~31) + perm32(R & 31)) : R;
        voffA[i] = (unsigned)(R * K + C) * 2u; voffB[i] = (unsigned)(Rb * K + C) * 2u; }
    const size_t kstep = (size_t)(BK * 2);
    const size_t hstep = (size_t)HALF * K * 2;
    const size_t tstep = 2 * hstep;
    const unsigned ldsw = (unsigned)wid * 1024u;
    const int aoff = lds_byte(wr * 64 + fr, fq * 8), boff = lds_byte(wc * 32 + fr, fq * 8);
#define PG8_SA(b, h) (((b) * 2 + (h)) * HTB)
#define PG8_SB(b, h) ((4 + (b) * 2 + (h)) * HTB)
#define PG8_STAGE(bufoff, gbase, voff) do { _Pragma("unroll") for (int _i = 0; _i < 2; ++_i) \
        __builtin_amdgcn_global_load_lds((const unsigned*)((const char*)(gbase) + (voff)[_i]), (PG8_LAS unsigned*)(lds + (bufoff) + ldsw + _i * 8192), 16, 0, 0); } while (0)
#define PG8_LDA(dst, b, h) do { _Pragma("unroll") for (int m = 0; m < 4; ++m) _Pragma("unroll") for (int k = 0; k < 2; ++k) dst[m][k] = *(const PG8_LAS bf16x8*)(lds + PG8_SA(b, h) + aoff + m * 2048 + k * 1024); } while (0)
#define PG8_LDB(dst, b, h) do { _Pragma("unroll") for (int n = 0; n < 2; ++n) _Pragma("unroll") for (int k = 0; k < 2; ++k) dst[n][k] = *(const PG8_LAS bf16x8*)(lds + PG8_SB(b, h) + boff + n * 2048 + k * 1024); } while (0)
#define PG8_MMA(ai, bj, At, Bt) do { __builtin_amdgcn_s_setprio(1); _Pragma("unroll") for (int m = 0; m < 4; ++m) _Pragma("unroll") for (int n = 0; n < 2; ++n) _Pragma("unroll") for (int k = 0; k < 2; ++k) \
        acc[ai][bj][m][n] = __builtin_amdgcn_mfma_f32_16x16x32_bf16(Bt[n][k], At[m][k], acc[ai][bj][m][n], 0, 0, 0); __builtin_amdgcn_s_setprio(0); } while (0)
#define PG8_WAIT_V(n) asm volatile("s_waitcnt vmcnt(" #n ")" ::: "memory")
#define PG8_WAIT_L(n) asm volatile("s_waitcnt lgkmcnt(" #n ")" ::: "memory")
#define PG8_BAR __builtin_amdgcn_s_barrier()
#define PG8_SCHED __builtin_amdgcn_sched_barrier(0)
    Unit cur, nxt; int ui = 0;
    if (!S.next(0, cur)) return;
    f32x4 acc[2][2][4][2];
#pragma unroll
    for (int a = 0; a < 2; ++a)
#pragma unroll
        for (int b = 0; b < 2; ++b)
#pragma unroll
            for (int m = 0; m < 4; ++m)
#pragma unroll
                for (int n = 0; n < 2; ++n) acc[a][b][m][n] = (f32x4){0.f, 0.f, 0.f, 0.f};
    bf16x8 At[4][2], B0[2][2], B1[2][2];
    const char* cA = (const char*)g.A + (size_t)cur.pm * tstep; const char* cB = (const char*)g.Bt + (size_t)cur.pn * tstep;
    S.a_ready(cur);
    if constexpr (SP2) {
        PG8_STAGE(PG8_SB(0, 0), cB, voffB); PG8_STAGE(PG8_SB(0, 1), cB + hstep, voffB); PG8_STAGE(PG8_SA(0, 0), cA, voffA); PG8_STAGE(PG8_SA(0, 1), cA + hstep, voffA);
        if (wr == 1) PG8_BAR;
        PG8_WAIT_V(2); PG8_BAR;
        PG8_STAGE(PG8_SB(1, 0), cB + kstep, voffB); PG8_STAGE(PG8_SA(1, 0), cA + kstep, voffA); PG8_STAGE(PG8_SB(1, 1), cB + hstep + kstep, voffB);
        PG8_WAIT_V(6); PG8_BAR;
    } else {
        PG8_STAGE(PG8_SB(0, 0), cB, voffB); PG8_STAGE(PG8_SA(0, 0), cA, voffA); PG8_STAGE(PG8_SB(0, 1), cB + hstep, voffB); PG8_STAGE(PG8_SA(0, 1), cA + hstep, voffA);
        if (wr == 1) PG8_BAR;
        PG8_WAIT_V(4); PG8_BAR;
        PG8_STAGE(PG8_SB(1, 0), cB + kstep, voffB); PG8_STAGE(PG8_SA(1, 0), cA + kstep, voffA); PG8_STAGE(PG8_SB(1, 1), cB + hstep + kstep, voffB);
        PG8_WAIT_V(6); PG8_BAR;
    }
    for (;;) {
        const bool has_next = S.next(ui + 1, nxt);
        const char* nA = has_next ? (const char*)g.A + (size_t)nxt.pm * tstep : cA; const char* nB = has_next ? (const char*)g.Bt + (size_t)nxt.pn * tstep : cB;
        for (int t = 0; t < nt; t += 2) {
            const bool last = (t == nt - 2);
            const char* a1 = cA + (size_t)(t + 1) * kstep;
            const char* a2 = last ? nA : cA + (size_t)(t + 2) * kstep; const char* b2 = last ? nB : cB + (size_t)(t + 2) * kstep;
            const char* a3 = a2 + kstep; const char* b3 = b2 + kstep;
            if (last && has_next) S.a_ready(nxt);
            if constexpr (SP2) {
            PG8_LDB(B0, 0, 0); PG8_LDB(B1, 0, 1); PG8_SCHED; PG8_LDA(At, 0, 0); PG8_STAGE(PG8_SA(1, 1), a1 + hstep, voffA);
            PG8_WAIT_V(8); PG8_WAIT_L(0); PG8_BAR; PG8_MMA(0, 0, At, B0); PG8_MMA(0, 1, At, B1); PG8_BAR; PG8_SCHED;
            PG8_LDA(At, 0, 1); PG8_STAGE(PG8_SB(0, 0), b2, voffB); PG8_STAGE(PG8_SB(0, 1), b2 + hstep, voffB); PG8_STAGE(PG8_SA(0, 0), a2, voffA);
            PG8_WAIT_V(8); PG8_WAIT_L(0); PG8_BAR; PG8_MMA(1, 0, At, B0); PG8_MMA(1, 1, At, B1); PG8_BAR; PG8_SCHED;
            PG8_LDB(B0, 1, 0); PG8_LDB(B1, 1, 1); PG8_SCHED; PG8_LDA(At, 1, 0); PG8_STAGE(PG8_SA(0, 1), a2 + hstep, voffA);
            PG8_WAIT_V(8); PG8_WAIT_L(0); PG8_BAR; PG8_MMA(0, 0, At, B0); PG8_MMA(0, 1, At, B1); PG8_BAR; PG8_SCHED;
            PG8_LDA(At, 1, 1); PG8_STAGE(PG8_SB(1, 0), b3, voffB); PG8_STAGE(PG8_SB(1, 1), b3 + hstep, voffB); PG8_STAGE(PG8_SA(1, 0), a3, voffA);
            PG8_WAIT_V(8); PG8_WAIT_L(0); PG8_BAR; PG8_MMA(1, 0, At, B0); PG8_MMA(1, 1, At, B1); PG8_BAR; PG8_SCHED;
            } else {
            PG8_LDB(B0, 0, 0); PG8_SCHED; PG8_LDA(At, 0, 0); PG8_STAGE(PG8_SA(1, 1), a1 + hstep, voffA);
            PG8_WAIT_L(8); PG8_BAR; PG8_WAIT_L(0); PG8_MMA(0, 0, At, B0); PG8_BAR; PG8_SCHED;
            PG8_LDB(B1, 0, 1); PG8_STAGE(PG8_SB(0, 0), b2, voffB);
            PG8_BAR; PG8_WAIT_L(0); PG8_MMA(0, 1, At, B1); PG8_BAR;
            PG8_LDA(At, 0, 1); PG8_STAGE(PG8_SA(0, 0), a2, voffA);
            PG8_BAR; PG8_WAIT_L(0); PG8_MMA(1, 0, At, B0); PG8_BAR; PG8_SCHED;
            PG8_STAGE(PG8_SB(0, 1), b2 + hstep, voffB);
            PG8_WAIT_V(6); PG8_BAR; PG8_MMA(1, 1, At, B1); PG8_BAR;
            PG8_LDB(B0, 1, 0); PG8_SCHED; PG8_LDA(At, 1, 0); PG8_STAGE(PG8_SA(0, 1), a2 + hstep, voffA);
            PG8_WAIT_L(8); PG8_BAR; PG8_WAIT_L(0); PG8_MMA(0, 0, At, B0); PG8_BAR; PG8_SCHED;
            PG8_LDB(B1, 1, 1); PG8_STAGE(PG8_SB(1, 0), b3, voffB);
            PG8_BAR; PG8_WAIT_L(0); PG8_MMA(0, 1, At, B1); PG8_BAR;
            PG8_LDA(At, 1, 1); PG8_STAGE(PG8_SA(1, 0), a3, voffA);
            PG8_BAR; PG8_WAIT_L(0); PG8_MMA(1, 0, At, B0); PG8_BAR; PG8_SCHED;
            PG8_STAGE(PG8_SB(1, 1), b3 + hstep, voffB);
            PG8_WAIT_V(6); PG8_BAR; PG8_MMA(1, 1, At, B1); PG8_BAR;
            }
        }
        if constexpr (ALIGN_EPI) { if (wr == 0) PG8_BAR; }
        if constexpr (!Epi::AFTER_DRAIN) { E(acc, cur, wr, wc, fr, fq); S.done(cur); }
        if (!has_next) break;
#pragma unroll
        for (int a = 0; a < 2; ++a)
#pragma unroll
            for (int b = 0; b < 2; ++b)
#pragma unroll
                for (int m = 0; m < 4; ++m)
#pragma unroll
                    for (int n = 0; n < 2; ++n) acc[a][b][m][n] = (f32x4){0.f, 0.f, 0.f, 0.f};
        cur = nxt; cA = nA; cB = nB; ++ui;
        if constexpr (ALIGN_EPI) { if (wr == 1) PG8_BAR; }
    }
    PG8_WAIT_V(0);
    if constexpr (!ALIGN_EPI) { if (wr == 0) PG8_BAR; }
    PG8_BAR;
    if constexpr (Epi::AFTER_DRAIN) { E.fused(acc, cur, wr, wc, fr, fq, lds, wid, lane); S.done(cur); }
#undef PG8_SA
#undef PG8_SB
#undef PG8_STAGE
#undef PG8_LDA
#undef PG8_LDB
#undef PG8_MMA
#undef PG8_WAIT_V
#undef PG8_WAIT_L
#undef PG8_BAR
#undef PG8_SCHED
}
}

namespace pg8 {
__device__ __forceinline__ float bf_lo(unsigned w) { return __builtin_bit_cast(float, w << 16); }
__device__ __forceinline__ float bf_hi(unsigned w) { return __builtin_bit_cast(float, w & 0xffff0000u); }
__device__ __forceinline__ float fsigmoid(float x) { return __builtin_amdgcn_rcpf(1.f + __expf(-x)); }

struct EpiInProj {
    static constexpr bool PERM = true, AFTER_DRAIN = false;
    bf16_t* T0; float* SMALL; size_t tstride;
    __device__ __forceinline__ void operator()(const f32x4 (&acc)[2][2][4][2], const Unit& u, int wr, int wc, int fr, int fq) const {
        const int t = u.pn >> 3; const int row0 = u.pm * BM + wr * 64 + fr;
        if (t < 13) {
            bf16_t* base = T0 + (size_t)t * tstride; const int col0 = (u.pn & 7) * BM + wc * 32 + 8 * fq; const bool sg = t >= 10;
#pragma unroll
            for (int ai = 0; ai < 2; ++ai)
#pragma unroll
                for (int m = 0; m < 4; ++m) { bf16_t* rowp = base + (size_t)(row0 + ai * HALF + m * 16) * 2048 + col0;
#pragma unroll
                    for (int bj = 0; bj < 2; ++bj) { f32x4 v0 = acc[ai][bj][m][0], v1 = acc[ai][bj][m][1];
                        if (sg) { v0 = (f32x4){fsigmoid(v0[0]), fsigmoid(v0[1]), fsigmoid(v0[2]), fsigmoid(v0[3])}; v1 = (f32x4){fsigmoid(v1[0]), fsigmoid(v1[1]), fsigmoid(v1[2]), fsigmoid(v1[3])}; }
                        u32x4 w; w.x = cvt_pk_bf16(v0[0], v0[1]); w.y = cvt_pk_bf16(v0[2], v0[3]); w.z = cvt_pk_bf16(v1[0], v1[1]); w.w = cvt_pk_bf16(v1[2], v1[3]);
                        *(u32x4*)(rowp + bj * HALF) = w; } }
        } else {
            const int col0 = wc * 32 + 8 * fq;
#pragma unroll
            for (int ai = 0; ai < 2; ++ai)
#pragma unroll
                for (int m = 0; m < 4; ++m) { float* rowp = SMALL + (size_t)(row0 + ai * HALF + m * 16) * 256 + col0;
#pragma unroll
                    for (int bj = 0; bj < 2; ++bj) { *(f32x4*)(rowp + bj * HALF) = acc[ai][bj][m][0]; *(f32x4*)(rowp + bj * HALF + 4) = acc[ai][bj][m][1]; } }
        }
    }
};

template <int STEP> struct EpiMerge {
    static constexpr bool PERM = true, AFTER_DRAIN = false;
    const bf16_t* G; float* MACC; bf16_t* OUT;
    __device__ __forceinline__ void operator()(const f32x4 (&acc)[2][2][4][2], const Unit& u, int wr, int wc, int fr, int fq) const {
        const int row0 = u.pm * BM + wr * 64 + fr, col0 = u.pn * BM + wc * 32 + 8 * fq;
#pragma unroll
        for (int ai = 0; ai < 2; ++ai)
#pragma unroll
            for (int m = 0; m < 4; ++m) { const size_t ro = (size_t)(row0 + ai * HALF + m * 16) * 2048 + col0;
#pragma unroll
                for (int bj = 0; bj < 2; ++bj) { const size_t o = ro + bj * HALF;
                    const u32x4 g = *(const u32x4*)(G + o);
                    f32x4 r0 = acc[ai][bj][m][0] * (f32x4){bf_lo(g.x), bf_hi(g.x), bf_lo(g.y), bf_hi(g.y)};
                    f32x4 r1 = acc[ai][bj][m][1] * (f32x4){bf_lo(g.z), bf_hi(g.z), bf_lo(g.w), bf_hi(g.w)};
                    if (STEP > 0) { r0 += *(const f32x4*)(MACC + o); r1 += *(const f32x4*)(MACC + o + 4); }
                    if (STEP < 2) { *(f32x4*)(MACC + o) = r0; *(f32x4*)(MACC + o + 4) = r1; }
                    else { u32x4 w; w.x = cvt_pk_bf16(r0[0], r0[1]); w.y = cvt_pk_bf16(r0[2], r0[3]); w.z = cvt_pk_bf16(r1[0], r1[1]); w.w = cvt_pk_bf16(r1[2], r1[3]); *(u32x4*)(OUT + o) = w; } } }
    }
};

struct EpiResid {
    static constexpr bool PERM = false, AFTER_DRAIN = false;
    const float* Xin; const float* gate; float* PRE; float alpha;
    __device__ __forceinline__ void operator()(const f32x4 (&acc)[2][2][4][2], const Unit& u, int wr, int wc, int fr, int fq) const {
        const int row0 = u.pm * BM + wr * 64 + fr, col0 = u.pn * BM + wc * 32 + 4 * fq; const float* gp = gate + (size_t)(u.pm >> 3) * 12288 + col0;
        f32x4 gv[2][2];
#pragma unroll
        for (int bj = 0; bj < 2; ++bj)
#pragma unroll
            for (int n = 0; n < 2; ++n) gv[bj][n] = *(const f32x4*)(gp + bj * HALF + n * 16);
#pragma unroll
        for (int ai = 0; ai < 2; ++ai)
#pragma unroll
            for (int m = 0; m < 4; ++m) { const size_t ro = (size_t)(row0 + ai * HALF + m * 16) * 2048 + col0;
#pragma unroll
                for (int bj = 0; bj < 2; ++bj)
#pragma unroll
                    for (int n = 0; n < 2; ++n) { const size_t o = ro + bj * HALF + n * 16; const f32x4 xv = *(const f32x4*)(Xin + o);
                        *(f32x4*)(PRE + o) = xv * alpha + gv[bj][n] * acc[ai][bj][m][n]; } }
    }
};

struct EpiRelu2 {
    static constexpr bool PERM = true, AFTER_DRAIN = false;
    bf16_t* O; int ldc;
    __device__ __forceinline__ void operator()(const f32x4 (&acc)[2][2][4][2], const Unit& u, int wr, int wc, int fr, int fq) const {
        const int row0 = u.pm * BM + wr * 64 + fr, col0 = u.pn * BM + wc * 32 + 8 * fq;
#pragma unroll
        for (int ai = 0; ai < 2; ++ai)
#pragma unroll
            for (int m = 0; m < 4; ++m) { bf16_t* rowp = O + (size_t)(row0 + ai * HALF + m * 16) * ldc + col0;
#pragma unroll
                for (int bj = 0; bj < 2; ++bj) { f32x4 v0 = acc[ai][bj][m][0], v1 = acc[ai][bj][m][1];
                    v0 = __builtin_elementwise_max(v0, (f32x4){0.f, 0.f, 0.f, 0.f}); v1 = __builtin_elementwise_max(v1, (f32x4){0.f, 0.f, 0.f, 0.f}); v0 = v0 * v0; v1 = v1 * v1;
                    u32x4 w; w.x = cvt_pk_bf16(v0[0], v0[1]); w.y = cvt_pk_bf16(v0[2], v0[3]); w.z = cvt_pk_bf16(v1[0], v1[1]); w.w = cvt_pk_bf16(v1[2], v1[3]);
                    *(u32x4*)(rowp + bj * HALF) = w; } }
    }
};
}

#define GAS __attribute__((address_space(1)))
#define LAS __attribute__((address_space(3)))
typedef unsigned short bf16;
typedef unsigned v4u __attribute__((ext_vector_type(4)));
typedef float f32x4 __attribute__((ext_vector_type(4)));
typedef short bf16x8 __attribute__((ext_vector_type(8)));
typedef GAS unsigned gu32;
typedef GAS unsigned long long gu64;
#define RLX_AGENT __ATOMIC_RELAXED, __HIP_MEMORY_SCOPE_AGENT
#define LDS_WAIT() asm volatile("s_waitcnt lgkmcnt(0)" ::: "memory")
#define VM_WAIT() asm volatile("s_waitcnt vmcnt(0)" ::: "memory")
__device__ __forceinline__ unsigned long long rt() { return __builtin_amdgcn_s_memrealtime(); }
__device__ __forceinline__ unsigned f2bf(float f) { unsigned u = __builtin_bit_cast(unsigned, f); return (u + 0x7fffu + ((u >> 16) & 1u)) >> 16; }
__device__ __forceinline__ unsigned pk2(float lo, float hi) { return f2bf(lo) | (f2bf(hi) << 16); }

#define XB_TMO      128
#define XB_XCNT(j)  (256  + 64 * (j))
#define XB_XSUB(j)  (1280 + 64 * (j))
#define XB_XGEN(j)  (2304 + 64 * (j))
#define XB_TOP      3328
#define XB_TOPGEN   3392
#define XCD_BAR_WORDS 3456
#define XB_SPIN_CAP (1u << 18)

__device__ __forceinline__ unsigned xb_ld(unsigned* p)              { return __hip_atomic_load(p, __ATOMIC_RELAXED, __HIP_MEMORY_SCOPE_AGENT); }
__device__ __forceinline__ unsigned xb_add(unsigned* p, unsigned v) { return __hip_atomic_fetch_add(p, v, __ATOMIC_RELAXED, __HIP_MEMORY_SCOPE_AGENT); }
__device__ __forceinline__ unsigned xb_xcc_id() { return (unsigned)__builtin_amdgcn_s_getreg((3 << 11) | 20) & 0xFu; }
#define XB_SPIN(cond, bar) do { unsigned _sp = 0; while (cond) { __builtin_amdgcn_s_sleep(1); \
    if ((++_sp & 255u) == 0u) { if (xb_ld(&(bar)[XB_TMO])) break; if (_sp > XB_SPIN_CAP) { atomicAdd(&(bar)[XB_TMO], 1u); break; } } } } while (0)

struct XcdBarrier {
    unsigned* bar; unsigned x;
    volatile LAS unsigned* st;
};

__device__ __forceinline__ XcdBarrier xcd_barrier_post(unsigned* bar, volatile LAS unsigned* st) {
    XcdBarrier b; b.bar = bar; b.x = xb_xcc_id(); b.st = st;
    if (threadIdx.x == 0) (void)xb_add(&bar[XB_XCNT(b.x)], 1u);
    return b;
}
__device__ __forceinline__ void xcd_barrier_complete(unsigned* bar, unsigned x, unsigned& nloc, unsigned& nx) {
    const unsigned G = gridDim.x * gridDim.y * gridDim.z;
    unsigned sum, cnt, mine, sp = 0u;
    for (;;) {
        sum = 0u; cnt = 0u; mine = 0u;
#pragma unroll
        for (unsigned j = 0; j < 16; ++j) { const unsigned c = xb_ld(&bar[XB_XCNT(j)]); sum += c; cnt += (c > 0u) ? 1u : 0u; mine = (j == x) ? c : mine; }
        if (sum == G) break;
        __builtin_amdgcn_s_sleep(1);
        if ((++sp & 255u) == 0u) { if (xb_ld(&bar[XB_TMO])) break; if (sp > XB_SPIN_CAP) { atomicAdd(&bar[XB_TMO], 1u); break; } }
    }
    nloc = mine > 0u ? mine : 1u; nx = cnt > 0u ? cnt : 1u;
}

__device__ __forceinline__ void xcd_barrier(const XcdBarrier& b) {
    asm volatile("s_waitcnt vmcnt(0)" ::: "memory");
    __syncthreads();
    if (threadIdx.x == 0) {
        unsigned* bar = b.bar;
        __builtin_amdgcn_s_waitcnt(0);
        unsigned nloc = b.st[0], nx = b.st[1];
        if (nloc == 0u) { xcd_barrier_complete(bar, b.x, nloc, nx); b.st[0] = nloc; b.st[1] = nx; }
        const unsigned old = xb_add(&bar[XB_XSUB(b.x)], 1u);
        const unsigned gen = old / nloc;
        if (old + 1u == (gen + 1u) * nloc) {
            __builtin_amdgcn_fence(__ATOMIC_RELEASE, "agent");
            asm volatile("s_waitcnt vmcnt(0)" ::: "memory");
            const unsigned og = xb_add(&bar[XB_TOP], 1u);
            const unsigned tg = og / nx;
            if (og + 1u == (tg + 1u) * nx) xb_add(&bar[XB_TOPGEN], 1u);
            else XB_SPIN(xb_ld(&bar[XB_TOPGEN]) == tg, bar);
            __builtin_amdgcn_fence(__ATOMIC_ACQUIRE, "agent");
            xb_add(&bar[XB_XGEN(b.x)], 1u);
            asm volatile("s_waitcnt vmcnt(0)" ::: "memory");
        } else {
            XB_SPIN(xb_ld(&bar[XB_XGEN(b.x)]) == gen, bar);
            __builtin_amdgcn_fence(__ATOMIC_ACQUIRE, "agent");
            asm volatile("s_waitcnt vmcnt(0)" ::: "memory");
        }
    }
    __syncthreads();
}

#include <hip/hip_bf16.h>
namespace fox {
using TIN = __hip_bfloat16; using TOUT = __hip_bfloat16;
constexpr int D = 128, PITCH = 2048;
constexpr float THR = 8.f;
constexpr bool WSKIP = false;
constexpr float SCALE = 0.08838834764831845f;
constexpr int NW = 8, QBLK = 32, KVBLK = 64, QB = NW * QBLK;
constexpr int SHM_V = KVBLK * D * 2, SHM_K = KVBLK * D * 2;
constexpr int ATT_LDS_BYTES = 2 * SHM_V + 2 * SHM_K + NW * 64 * 4;


using bf16 = __hip_bfloat16;
typedef short bf16x8 __attribute__((ext_vector_type(8)));
typedef short s16x4 __attribute__((ext_vector_type(4)));
typedef float f32x16 __attribute__((ext_vector_type(16)));
typedef float f32x4 __attribute__((ext_vector_type(4)));
typedef unsigned u32x4 __attribute__((ext_vector_type(4)));
template <class A, class Bt> struct same_t { static constexpr bool v = false; };
template <class A> struct same_t<A, A> { static constexpr bool v = true; };

__device__ __forceinline__ void glds16(const void* gsrc, unsigned lds_dst) { unsigned keep;
    asm volatile("s_mov_b32 %0, m0\n\ts_mov_b32 m0, %2\n\ts_nop 0\n\tglobal_load_lds_dwordx4 %1, off\n\ts_mov_b32 m0, %0" : "=&s"(keep) : "v"(gsrc), "s"(lds_dst) : "memory"); }
#define KSWZ(row, colB) ((row) * 256 + ((colB) ^ (((row) & 7) << 4)))
#define SBAR() __builtin_amdgcn_sched_barrier(0)
__device__ __forceinline__ int v_st(int k, int c) { const int kk = (k & ~0xC) | ((k & 4) << 1) | ((k & 8) >> 1); return ((kk >> 3) * 4 + (c >> 5)) * 512 + ((kk & 7) * 32 + (c & 31)) * 2; }
__device__ __forceinline__ int v_rd_base(int lane) { return ((lane & 3) << 3) | (((lane >> 2) & 3) << 6) | (((lane >> 4) & 1) << 5) | (((lane >> 5) & 1) << 8); }
constexpr int v_rd_off(int d0, int ks, int half) { return d0 * 512 + ks * 4096 + half * 2048; }
__device__ __forceinline__ int crow(int r, int hi) { return (r & 3) + 8 * (r >> 2) + 4 * hi; }
__device__ __forceinline__ unsigned cvtpk(float lo, float hi) {
    unsigned r; asm volatile("v_cvt_pk_bf16_f32 %0, %1, %2" : "=v"(r) : "v"(lo), "v"(hi)); return r;
}
__device__ __forceinline__ bf16x8 pack8(f32x4 a, f32x4 b) {
    u32x4 w = {cvtpk(a[0], a[1]), cvtpk(a[2], a[3]), cvtpk(b[0], b[1]), cvtpk(b[2], b[3])};
    return *reinterpret_cast<bf16x8*>(&w);
}
template <class T> __device__ __forceinline__ bf16x8 load8(const T* p) {
    if constexpr (same_t<T, float>::v) { return pack8(*(const f32x4*)p, *(const f32x4*)(p + 4)); }
    else { return *reinterpret_cast<const bf16x8*>(p); }
}
__device__ __forceinline__ void mask_tile(f32x16& p0, f32x16& p1, int dq, unsigned W) {
    const float NEG = -__builtin_inff();
#pragma unroll
    for (int r = 0; r < 16; ++r) {
        const int c = (r & 3) + 8 * (r >> 2);
        if ((unsigned)(dq - c) >= W) p0[r] = NEG;
        if ((unsigned)(dq - c - 32) >= W) p1[r] = NEG;
    }
}
__device__ __forceinline__ void partialSM(f32x16& p0, f32x16& p1, float& m_reg, float& mn, float& alpha) {
    float pmax = p0[0]; for (int r = 1; r < 16; ++r) pmax = fmaxf(pmax, p0[r]); for (int r = 0; r < 16; ++r) pmax = fmaxf(pmax, p1[r]);
    { auto rr = __builtin_amdgcn_permlane32_swap(__float_as_uint(pmax), __float_as_uint(pmax), false, false);
      pmax = fmaxf(__uint_as_float(rr[0]), __uint_as_float(rr[1])); }
    constexpr float C2 = 1.4426950408889634f * SCALE;
    if (__builtin_expect(__all((pmax - m_reg) * SCALE <= THR), 1)) { mn = m_reg; alpha = 1.f; }
    else { mn = fmaxf(m_reg, pmax); alpha = __builtin_amdgcn_exp2f((m_reg - mn) * C2); m_reg = mn; }
    const float mnL = -mn * C2;
    for (int r = 0; r < 16; ++r) p0[r] = fmaf(p0[r], C2, mnL); for (int r = 0; r < 16; ++r) p1[r] = fmaf(p1[r], C2, mnL);
    for (int r = 0; r < 16; ++r) p0[r] = __builtin_amdgcn_exp2f(p0[r]);
}
__device__ __forceinline__ void finishSM(f32x16& p0, f32x16& p1, float alpha, float& l_reg, bf16x8& pa0, bf16x8& pa1, bf16x8& pa2, bf16x8& pa3) {
    for (int r = 0; r < 16; ++r) p1[r] = __builtin_amdgcn_exp2f(p1[r]);
    float ps = 0; for (int r = 0; r < 16; ++r) ps += p0[r]; for (int r = 0; r < 16; ++r) ps += p1[r];
    { auto rr = __builtin_amdgcn_permlane32_swap(__float_as_uint(ps), __float_as_uint(ps), false, false);
      ps = __uint_as_float(rr[0]) + __uint_as_float(rr[1]); }
    l_reg = l_reg * alpha + ps;
#define PK4(P, B_, OUT) do { unsigned a0 = cvtpk(P[B_+0], P[B_+1]), a1 = cvtpk(P[B_+2], P[B_+3]);                          \
        unsigned b0 = cvtpk(P[B_+4], P[B_+5]), b1 = cvtpk(P[B_+6], P[B_+7]);                                             \
        auto r0 = __builtin_amdgcn_permlane32_swap(a0, b0, false, false); auto r1 = __builtin_amdgcn_permlane32_swap(a1, b1, false, false); \
        u32x4 w = {r0[0], r1[0], r0[1], r1[1]}; OUT = *reinterpret_cast<bf16x8*>(&w); } while (0)
    PK4(p0, 0, pa0); PK4(p0, 8, pa1); PK4(p1, 0, pa2); PK4(p1, 8, pa3);
#undef PK4
}
template <int KB, bool SK>
__device__ __forceinline__ void qkt(f32x16& p0, f32x16& p1, const char* K_lds, int r32, int hi, const char* qr, bool act, const char* B_lds, int lane) {
    if (SK && !act) { const float NEG = -__builtin_inff();
#pragma unroll
        for (int r = 0; r < 16; ++r) { p0[r] = NEG; p1[r] = NEG; } return; }
    p0 = f32x16{}; p1 = f32x16{};
    const char* kb[4];
#pragma unroll
    for (int dd = 0; dd < 4; ++dd) kb[dd] = K_lds + KB * SHM_K + KSWZ(r32, (dd * 16 + hi * 8) * 2);
#pragma unroll
    for (int d0 = 0; d0 < 8; ++d0) { const char* a = kb[d0 & 3] + (d0 >> 2) * 128;
        bf16x8 b0 = *reinterpret_cast<const bf16x8*>(a);
        bf16x8 b1 = *reinterpret_cast<const bf16x8*>(a + 32 * 256);
        const bf16x8 qf = *reinterpret_cast<const bf16x8*>(qr + d0 * 1024);
        p0 = __builtin_amdgcn_mfma_f32_32x32x16_bf16(b0, qf, p0, 0, 0, 0);
        p1 = __builtin_amdgcn_mfma_f32_32x32x16_bf16(b1, qf, p1, 0, 0, 0); }
    { const unsigned o1 = hi ? 0u : 0x3F803F80u, o2 = hi ? 0u : 0x3F80u; const u32x4 qw = {o1, o2, 0u, 0u}; const bf16x8 qo = *reinterpret_cast<const bf16x8*>(&qw);
      const bf16x8 bk0 = *reinterpret_cast<const bf16x8*>(B_lds + KB * 2048 + lane * 16), bk1 = *reinterpret_cast<const bf16x8*>(B_lds + KB * 2048 + 1024 + lane * 16);
      p0 = __builtin_amdgcn_mfma_f32_32x32x16_bf16(bk0, qo, p0, 0, 0, 0);
      p1 = __builtin_amdgcn_mfma_f32_32x32x16_bf16(bk1, qo, p1, 0, 0, 0); }
}
template <int VB, bool SK>
__device__ __forceinline__ void pv_tile(f32x16* o, int vb0, bf16x8 pa0, bf16x8 pa1, bf16x8 pa2, bf16x8 pa3, bool act) {
    if (SK && !act) return;
#define TRRD(dst, off) asm volatile("ds_read_b64_tr_b16 %0, %1 offset:%2" : "=&v"(dst) : "v"(vb0), "i"(off) : "memory")
#define PV_D0(d0) do { s16x4 l0, l1, l2, l3, h0, h1, h2, h3; constexpr int b_ = VB * SHM_V + v_rd_off(d0, 0, 0);     \
        TRRD(l0, b_); TRRD(h0, b_ + 2048); TRRD(l1, b_ + 4096); TRRD(h1, b_ + 6144); TRRD(l2, b_ + 8192); TRRD(h2, b_ + 10240); TRRD(l3, b_ + 12288); TRRD(h3, b_ + 14336); \
        asm volatile("s_waitcnt lgkmcnt(0)" ::: "memory"); SBAR();                 \
        o[d0] = __builtin_amdgcn_mfma_f32_32x32x16_bf16(pa0, (bf16x8){l0[0], l0[1], l0[2], l0[3], h0[0], h0[1], h0[2], h0[3]}, o[d0], 0, 0, 0);   \
        o[d0] = __builtin_amdgcn_mfma_f32_32x32x16_bf16(pa1, (bf16x8){l1[0], l1[1], l1[2], l1[3], h1[0], h1[1], h1[2], h1[3]}, o[d0], 0, 0, 0);   \
        o[d0] = __builtin_amdgcn_mfma_f32_32x32x16_bf16(pa2, (bf16x8){l2[0], l2[1], l2[2], l2[3], h2[0], h2[1], h2[2], h2[3]}, o[d0], 0, 0, 0);   \
        o[d0] = __builtin_amdgcn_mfma_f32_32x32x16_bf16(pa3, (bf16x8){l3[0], l3[1], l3[2], l3[3], h3[0], h3[1], h3[2], h3[3]}, o[d0], 0, 0, 0); } while (0)
    PV_D0(0); PV_D0(1); PV_D0(2); PV_D0(3);
#undef PV_D0
#undef TRRD
}

template <class TIn, class TOut> struct BlockRef { const TIn* Q; const TIn* K; const TIn* V; TOut* O; const char* FK; const char* Z16; int P0; };
template <class TIn> struct Seam {
    bf16x8 st_v0, st_v1, st_k0, st_k1; f32x4 sf0, sf1, sf2, sf3;
    f32x4 tq[16];
};
__device__ __forceinline__ int swa_jlo(int P0, int W) { const int lowk = P0 - W + 1; return lowk > 0 ? lowk / KVBLK : 0; }
#define ROW(p, k0, rr) ((p) + (size_t)((k0) + (rr)) * PITCH + sc)
#define VMW() asm volatile("s_waitcnt vmcnt(0)" ::: "memory")
#define VMWN(n) asm volatile("s_waitcnt vmcnt(%0)" :: "i"(n) : "memory")
#define SLOAD_H(Kp, Vp, k0) do { S.st_v0 = load8<TIn>(ROW(Vp, k0, sr)); S.st_v1 = load8<TIn>(ROW(Vp, k0, 32 + sr));              \
                         S.st_k0 = load8<TIn>(ROW(Kp, k0, sr)); S.st_k1 = load8<TIn>(ROW(Kp, k0, 32 + sr)); } while (0)
#define LOADB(ref, k0, bf) do { if (wid == 0) { const char* g0_ = hi ? (ref).Z16 : (ref).FK + (size_t)((k0) + r32) * 16; const char* g1_ = hi ? (ref).Z16 : (ref).FK + (size_t)((k0) + 32 + r32) * 16; \
        const unsigned l0_ = (unsigned)(uintptr_t)B_lds + (bf) * 2048; glds16(g0_, l0_); glds16(g1_, l0_ + 1024); } } while (0)
#define SWRITE_HK(bf) do { *(bf16x8*)(K_lds + (bf) * SHM_K + kws) = S.st_k0; *(bf16x8*)(K_lds + (bf) * SHM_K + kws + 32 * 256) = S.st_k1; } while (0)
#define SWRITE_HV(bf) do { *(bf16x8*)(V_lds + (bf) * SHM_V + vst0) = S.st_v0; *(bf16x8*)(V_lds + (bf) * SHM_V + vst1) = S.st_v1; } while (0)
#define SWRITE_H(bf) do { SWRITE_HV(bf); SWRITE_HK(bf); } while (0)
#define SLOAD_F(p, k0) do { S.sf0 = *(const f32x4*)ROW(p, k0, sr); S.sf1 = *(const f32x4*)(ROW(p, k0, sr) + 4);                \
                            S.sf2 = *(const f32x4*)ROW(p, k0, 32 + sr); S.sf3 = *(const f32x4*)(ROW(p, k0, 32 + sr) + 4); } while (0)
#define SWRITE_KF(bf) do { *(bf16x8*)(K_lds + (bf) * SHM_K + kws) = pack8(S.sf0, S.sf1); *(bf16x8*)(K_lds + (bf) * SHM_K + kws + 32 * 256) = pack8(S.sf2, S.sf3); } while (0)
#define SWRITE_VF(bf) do { *(bf16x8*)(V_lds + (bf) * SHM_V + vst0) = pack8(S.sf0, S.sf1); *(bf16x8*)(V_lds + (bf) * SHM_V + vst1) = pack8(S.sf2, S.sf3); } while (0)
template <class TIn, class TOut>
__device__ __forceinline__ void causal_swa_prime(const BlockRef<TIn, TOut>& cur, int W, char* lds, Seam<TIn>& S) {
    constexpr bool F32 = same_t<TIn, float>::v;
    int tid_l = threadIdx.x; asm volatile("" : "+v"(tid_l));
    const int tid = tid_l, wid = __builtin_amdgcn_readfirstlane(tid >> 6), lane = tid & 63, r32 = lane & 31, hi = lane >> 5;
    const int sr = tid >> 4, sc = (tid & 15) * 8, kws = KSWZ(sr, sc * 2); char* K_lds = lds + 2 * SHM_V; char* B_lds = lds + ATT_LDS_BYTES;
    const int kb0 = swa_jlo(cur.P0, W) * KVBLK;
    for (int d0 = 0; d0 < 8; ++d0) glds16(cur.Q + (size_t)(wid * QBLK + r32) * PITCH + d0 * 16 + hi * 8, (unsigned)(uintptr_t)(lds + ATT_LDS_BYTES + 4096) + wid * 8192 + d0 * 1024);
    LOADB(cur, kb0, 0);
    if constexpr (F32) { SLOAD_F((const float*)cur.K, kb0); VMW(); SWRITE_KF(0); SBAR(); SLOAD_F((const float*)cur.V, kb0); }
    else { SLOAD_H(cur.K, cur.V, kb0); VMW(); SWRITE_HK(0); }
    __syncthreads();
}
template <class TIn, class TOut>
__device__ __forceinline__ void causal_swa_block(const BlockRef<TIn, TOut>& cur, const BlockRef<TIn, TOut>& nxt, int skv, int W, char* lds, Seam<TIn>& S) {
    constexpr bool F32 = same_t<TIn, float>::v;
    int tid_l = threadIdx.x; asm volatile("" : "+v"(tid_l));
    const int tid = tid_l, wid = __builtin_amdgcn_readfirstlane(tid >> 6), lane = tid & 63, r32 = lane & 31, hi = lane >> 5;
    const int j_lo = swa_jlo(cur.P0, W);
    int j_hi = (cur.P0 + QB - 1) / KVBLK + 1; if (j_hi > skv / KVBLK) j_hi = skv / KVBLK;
    const int NT = j_hi - j_lo;
    const int kbn = swa_jlo(nxt.P0, W) * KVBLK;
    const int qlo = cur.P0 + wid * QBLK, qm = qlo + r32 - 4 * hi;
    char* V_lds = lds; char* K_lds = lds + 2 * SHM_V; const char* Qw = lds + ATT_LDS_BYTES + 4096 + wid * 8192 + lane * 16;
    char* B_lds = lds + ATT_LDS_BYTES;
    float* ws = (float*)(lds + 2 * SHM_V + 2 * SHM_K) + wid * 64; float* li_l = ws, * al_l = ws + 32;
    float m_reg = -1e30f, l_reg = 0; f32x16 o[4] = {};
    const int sr = tid >> 4, sc = (tid & 15) * 8, vst0 = v_st(sr, sc), vst1 = v_st(32 + sr, sc), kws = KSWZ(sr, sc * 2);
    const int vb0 = (int)(uintptr_t)V_lds + v_rd_base(lane);
    const TIn* Kh = cur.K; const TIn* Vh = cur.V;
#define RESC(a) do { if (__any((a) < 1.f)) { if (hi == 0) al_l[r32] = (a); asm volatile("s_waitcnt lgkmcnt(0)" ::: "memory");              \
                     for (int d_ = 0; d_ < 4; ++d_) for (int r = 0; r < 16; ++r) o[d_][r] *= al_l[crow(r, hi)]; } } while (0)
#define KBASE(t) ((j_lo + (t)) * KVBLK)
#define ACT(t) (KBASE(t) <= qlo + QBLK - 1 && KBASE(t) + KVBLK - 1 >= qlo - W + 1)
#define MASKT(P0_, P1_, t) do { const int kb_ = KBASE(t); if ((!SK || ACT(t)) && (kb_ + KVBLK - 1 > qlo || kb_ <= qlo + QBLK - 1 - W)) mask_tile(P0_, P1_, qm - kb_, (unsigned)W); } while (0)
    constexpr int NQL = F32 ? 16 : 8;
    constexpr bool SK = WSKIP && !F32;
#define SEAM_K0() do { VMWN(NQL); if constexpr (F32) { SWRITE_KF(0); SBAR(); SLOAD_F((const float*)nxt.V, kbn); } else { SWRITE_HK(0); } SBAR(); } while (0)
    f32x16 pA0, pA1, pB0, pB1; float mnA, mnB, alA, alB; bf16x8 pa0, pa1, pa2, pa3;
    if constexpr (F32) { VMW(); SWRITE_VF(0); SBAR(); } else { VMW(); SWRITE_HV(0); SBAR(); }
    if (NT > 1) { if constexpr (F32) SLOAD_F((const float*)Kh, KBASE(1)); else SLOAD_H(Kh, Vh, KBASE(1)); }
    SBAR(); qkt<0, SK>(pA0, pA1, K_lds, r32, hi, Qw, ACT(0), B_lds, lane); if (NT > 1) LOADB(cur, KBASE(1), 1);
    if constexpr (F32) { if (NT > 1) { VMW(); SWRITE_KF(1); SBAR(); SLOAD_F((const float*)Vh, KBASE(1)); } }
    MASKT(pA0, pA1, 0); partialSM(pA0, pA1, m_reg, mnA, alA);
    if (NT > 1) { VMW(); if constexpr (F32) { SWRITE_VF(1); SBAR(); if (NT > 2) SLOAD_F((const float*)Kh, KBASE(2)); } else SWRITE_H(1); }
    __syncthreads();
#define HALF_STEP(PX0, PX1, mnX, alX, PY0, PY1, alY, t, KB, VB, SB) do {                                                      \
        SBAR(); qkt<KB, SK>(PX0, PX1, K_lds, r32, hi, Qw, ACT(t), B_lds, lane);                                   \
        finishSM(PY0, PY1, alY, l_reg, pa0, pa1, pa2, pa3); SBAR();                                                           \
        if ((t) + 1 < NT) { if constexpr (F32) { VMW(); SWRITE_KF(SB); SBAR(); SLOAD_F((const float*)Vh, KBASE((t) + 1)); }  \
                            else { SLOAD_H(Kh, Vh, KBASE((t) + 1)); LOADB(cur, KBASE((t) + 1), SB); } SBAR(); }              \
        pv_tile<VB, SK>(o, vb0, pa0, pa1, pa2, pa3, ACT((t) - 1)); MASKT(PX0, PX1, (t)); partialSM(PX0, PX1, m_reg, mnX, alX);                                        \
        __syncthreads();                                                                                                      \
        if ((t) + 1 < NT) { VMW(); if constexpr (F32) { SWRITE_VF(SB); SBAR(); if ((t) + 2 < NT) SLOAD_F((const float*)Kh, KBASE((t) + 2)); } \
                            else { SWRITE_H(SB); } }                                                                          \
        RESC(alX); __syncthreads(); } while (0)
    for (int t = 1; t + 1 < NT; t += 2) {
        HALF_STEP(pB0, pB1, mnB, alB, pA0, pA1, alA, t, 1, 0, 0);
        HALF_STEP(pA0, pA1, mnA, alA, pB0, pB1, alB, t + 1, 0, 1, 1);
    }
    const bool even = (NT & 1) == 0;
    if (even) { SBAR(); qkt<1, SK>(pB0, pB1, K_lds, r32, hi, Qw, ACT(NT - 1), B_lds, lane); SBAR(); }
#define QROW(e) (nxt.Q + (size_t)(wid * QBLK + r32) * PITCH + ((e) >> 1) * 16 + hi * 8 + ((e) & 1) * 4)
    if constexpr (F32) { SLOAD_F((const float*)nxt.K, kbn); SBAR();
#pragma unroll
        for (int e = 0; e < 8; ++e) S.tq[e] = *(const f32x4*)QROW(e); }
    else { SLOAD_H(nxt.K, nxt.V, kbn); LOADB(nxt, kbn, 0); SBAR();
#pragma unroll
        for (int d0 = 0; d0 < 8; ++d0) glds16(nxt.Q + (size_t)(wid * QBLK + r32) * PITCH + d0 * 16 + hi * 8, (unsigned)(uintptr_t)(lds + ATT_LDS_BYTES + 4096) + wid * 8192 + d0 * 1024); }
    SBAR();
    finishSM(pA0, pA1, alA, l_reg, pa0, pa1, pa2, pa3); SBAR();
    if constexpr (F32) {
#pragma unroll
        for (int e = 8; e < 16; ++e) S.tq[e] = *(const f32x4*)QROW(e); SBAR(); }
#undef QROW
    pv_tile<0, SK>(o, vb0, pa0, pa1, pa2, pa3, ACT(even ? NT - 2 : NT - 1));
    if (even) { MASKT(pB0, pB1, NT - 1); partialSM(pB0, pB1, m_reg, mnB, alB); __syncthreads(); RESC(alB);
        finishSM(pB0, pB1, alB, l_reg, pa0, pa1, pa2, pa3); SBAR(); pv_tile<1, SK>(o, vb0, pa0, pa1, pa2, pa3, ACT(NT - 1)); }
    SBAR(); SEAM_K0();
    if (hi == 0) li_l[r32] = l_reg; asm volatile("s_waitcnt lgkmcnt(0)" ::: "memory");
    float rli[16];
#pragma unroll
    for (int r = 0; r < 16; ++r) rli[r] = __builtin_amdgcn_rcpf(li_l[crow(r, hi)]);
    TOut* Ow = cur.O + (size_t)(wid * QBLK) * PITCH;
#pragma unroll
    for (int r = 0; r < 16; ++r) { const int orow = crow(r, hi);
#pragma unroll
        for (int d0 = 0; d0 < 4; ++d0) { const float v = o[d0][r] * rli[r];
            if constexpr (same_t<TOut, float>::v) { Ow[(size_t)orow * PITCH + d0 * 32 + r32] = v; }
            else { const float vn = __shfl_xor(v, 1);
                   if ((r32 & 1) == 0) *(unsigned*)(Ow + (size_t)orow * PITCH + d0 * 32 + r32) = cvtpk(v, vn); } } }
    __syncthreads();
#undef RESC
#undef KBASE
#undef ACT
#undef MASKT
#undef SEAM_K0
#undef HALF_STEP
}
#undef ROW
#undef VMW
#undef VMWN
#undef SLOAD_H
#undef SWRITE_HK
#undef SWRITE_HV
#undef SWRITE_H
#undef SLOAD_F
#undef SWRITE_KF
#undef SWRITE_VF

#undef LOADB
}

constexpr int NWAVES = 8, NT = NWAVES * 64;
constexpr int BATCH = 4, SEQ = 2048, D = 2048, M = BATCH * SEQ, FF = 8192, DEPTH = 2;
constexpr int INW = 26704, NPAD = 26880;
constexpr int MODW = 6 * D;
constexpr float LN_EPS = 1e-5f, NORM_EPS = 1e-6f, ALPHA = 1.4142135623730951f;
constexpr size_t MiB = 1u << 20;
constexpr size_t ACT_E = (size_t)M * D;
constexpr size_t WS_CTL = 0, CTL_ZERO_BYTES = 1 * MiB;
constexpr size_t WS_MODP = 2 * MiB;
constexpr size_t WS_MOD = 8 * MiB;
constexpr size_t WS_SMALL = 10 * MiB;
constexpr size_t WS_CUM = 18 * MiB;
constexpr size_t WS_BETA = 19 * MiB, WS_GG = 20 * MiB;
constexpr size_t WS_FKB = 21 * MiB;
constexpr size_t WS_W = 32 * MiB;
constexpr size_t W_LAYER = 201 * MiB, W_IN = 0, W_A = 105 * MiB, W_B = 113 * MiB, W_C = 121 * MiB, W_O = 129 * MiB, W_1 = 137 * MiB, W_2 = 169 * MiB;
constexpr size_t WS_U = 448 * MiB;
constexpr size_t WS_X = 480 * MiB;
constexpr size_t WS_PRE = 544 * MiB;
constexpr size_t WS_T = 608 * MiB;
constexpr size_t WS_H = 608 * MiB;
constexpr size_t WS_YA = 1024 * MiB, WS_YB = 1056 * MiB, WS_YC = 1088 * MiB, WS_MG = 1120 * MiB;
constexpr size_t WS_MACC = 1152 * MiB;
constexpr size_t WS_QN = 1216 * MiB, WS_KN = 1280 * MiB, WS_VN = 1344 * MiB, WS_ORAW = 1408 * MiB;
constexpr size_t WS_END = 1472 * MiB;
constexpr int CW_BAR = 4096;
constexpr int LDS_BYTES = 147456, MISC_OFF = LDS_BYTES - 512;
enum { TI_CB = 0, TI_CC, TI_CH, TI_GQ, TI_GK, TI_GV, TI_GZ, TI_FQ, TI_FK, TI_FV, TI_MA, TI_MB, TI_MC };
__host__ __device__ constexpr int src_off(int t) { return t < 7 ? 2048 * t : (t < 10 ? 14400 + 2048 * (t - 7) : 20560 + 2048 * (t - 10)); }
constexpr int SRC_GB = 14336, SRC_FF = 20544;
enum { I_X = 0, I_C, I_WADA, I_BADA, I_WIN, I_CONVW, I_GCONVW, I_ALOG, I_DTB, I_GNORMW, I_FBIAS, I_WA, I_WB, I_WC, I_WO, I_LN1G, I_LN1B, I_W1, I_W2, I_LN2G, I_LN2B, N_IN };

typedef unsigned u32x4 __attribute__((ext_vector_type(4)));
typedef unsigned u32x2 __attribute__((ext_vector_type(2)));
__device__ __forceinline__ float wave_sum(float v) {
#pragma unroll
    for (int o = 1; o < 64; o <<= 1) v += __shfl_xor(v, o);
    return v;
}
__device__ __forceinline__ float wave_max(float v) {
#pragma unroll
    for (int o = 1; o < 64; o <<= 1) v = fmaxf(v, __shfl_xor(v, o));
    return v;
}
__device__ __forceinline__ float bflo(unsigned w) { return __builtin_bit_cast(float, w << 16); }
__device__ __forceinline__ float bfhi(unsigned w) { return __builtin_bit_cast(float, w & 0xffff0000u); }
__device__ __forceinline__ void unpack8(const u32x4 w, float (&f)[8]) { f[0] = bflo(w.x); f[1] = bfhi(w.x); f[2] = bflo(w.y); f[3] = bfhi(w.y); f[4] = bflo(w.z); f[5] = bfhi(w.z); f[6] = bflo(w.w); f[7] = bfhi(w.w); }
__device__ __forceinline__ u32x4 pack8(const float (&f)[8]) { u32x4 w; w.x = pg8::cvt_pk_bf16(f[0], f[1]); w.y = pg8::cvt_pk_bf16(f[2], f[3]); w.z = pg8::cvt_pk_bf16(f[4], f[5]); w.w = pg8::cvt_pk_bf16(f[6], f[7]); return w; }
__device__ __forceinline__ float fsilu(float x) { return x / (1.f + __expf(-x)); }

__device__ __forceinline__ void tr_item(const float* __restrict__ W, size_t ldw, bf16* __restrict__ WT, size_t K, int kb, int nb, int lane) {
    const int kq = lane & 7, nq = lane >> 3;
    const float* src = W + (size_t)(kb * 64 + kq * 8) * ldw + nb * 32 + nq * 4;
    f32x4 v[8];
#pragma unroll
    for (int i = 0; i < 8; ++i) v[i] = *(const f32x4*)(src + (size_t)i * ldw);
    bf16* dst = WT + (size_t)(nb * 32 + nq * 4) * K + kb * 64 + kq * 8;
#pragma unroll
    for (int j = 0; j < 4; ++j) { u32x4 o; o.x = pg8::cvt_pk_bf16(v[0][j], v[1][j]); o.y = pg8::cvt_pk_bf16(v[2][j], v[3][j]); o.z = pg8::cvt_pk_bf16(v[4][j], v[5][j]); o.w = pg8::cvt_pk_bf16(v[6][j], v[7][j]);
        *(u32x4*)(dst + (size_t)j * K) = o; }
}

__device__ __forceinline__ void modulate_row(const float* __restrict__ xr, bf16* __restrict__ ur, const float* __restrict__ shift, const float* __restrict__ scale, int lane) {
#pragma unroll
    for (int j = 0; j < 8; ++j) { const int c = 4 * lane + 256 * j; const f32x4 v = *(const f32x4*)(xr + c), sc = *(const f32x4*)(scale + c), sh = *(const f32x4*)(shift + c);
        const f32x4 y = v * (sc + 1.f) + sh; u32x2 o; o.x = pg8::cvt_pk_bf16(y[0], y[1]); o.y = pg8::cvt_pk_bf16(y[2], y[3]); *(u32x2*)(ur + c) = o; }
}
__device__ __forceinline__ void ln_mod_row(const float* __restrict__ pre, const float* __restrict__ g, const float* __restrict__ bt, float* __restrict__ xo, bf16* __restrict__ uo,
                                           const float* __restrict__ shift, const float* __restrict__ scale, int lane) {
    f32x4 v[8]; float s = 0.f;
#pragma unroll
    for (int j = 0; j < 8; ++j) { v[j] = *(const f32x4*)(pre + 4 * lane + 256 * j); s += (v[j][0] + v[j][1]) + (v[j][2] + v[j][3]); }
    const float mean = wave_sum(s) * (1.f / D); float s2 = 0.f;
#pragma unroll
    for (int j = 0; j < 8; ++j) { v[j] = v[j] - mean; s2 += (v[j][0] * v[j][0] + v[j][1] * v[j][1]) + (v[j][2] * v[j][2] + v[j][3] * v[j][3]); }
    const float rstd = 1.f / sqrtf(wave_sum(s2) * (1.f / D) + LN_EPS);
#pragma unroll
    for (int j = 0; j < 8; ++j) { const int c = 4 * lane + 256 * j; const f32x4 y = v[j] * rstd * *(const f32x4*)(g + c) + *(const f32x4*)(bt + c);
        *(f32x4*)(xo + c) = y;
        if (uo) { const f32x4 u = y * (*(const f32x4*)(scale + c) + 1.f) + *(const f32x4*)(shift + c); u32x2 o; o.x = pg8::cvt_pk_bf16(u[0], u[1]); o.y = pg8::cvt_pk_bf16(u[2], u[3]); *(u32x2*)(uo + c) = o; } }
}

struct Args { const float* in[N_IN]; float* out; unsigned char* ws; int ph_lo, ph_hi; };
constexpr int NPL = 10, NPH = 3 + DEPTH * NPL;

__global__ void __launch_bounds__(NT, 2) fwd_kernel(Args args) {
    extern __shared__ __attribute__((aligned(16))) unsigned char lds_raw[];
    LAS unsigned char* lds = (LAS unsigned char*)lds_raw;
    const int G = gridDim.x, blk = blockIdx.x, NGW = G * NWAVES, NGT = G * NT;
    volatile LAS unsigned* MISC = (volatile LAS unsigned*)(lds + MISC_OFF);
    if (threadIdx.x < 128) ((LAS unsigned*)(lds + MISC_OFF))[threadIdx.x] = 0u;
    __syncthreads();
    XcdBarrier bar = xcd_barrier_post((unsigned*)((gu32*)(args.ws + WS_CTL) + CW_BAR), MISC + 8);
    const int lo = args.ph_lo, hi = args.ph_hi;
#define IN(k) (lo <= (k) && (k) < hi)
#define SEAM(k) do { if (IN(k) && IN((k) + 1)) xcd_barrier(bar); } while (0)
#define PH_BEGIN \
    int tid = threadIdx.x; asm volatile("" : "+v"(tid)); const int lane = tid & 63, wave = __builtin_amdgcn_readfirstlane(tid >> 6); \
    const int gw = blk * NWAVES + wave, gtid = blk * NT + tid; (void)gw; (void)gtid; (void)lane; \
    GAS unsigned char* ws_g = (GAS unsigned char*)args.ws; asm volatile("" : "+s"(ws_g)); unsigned char* ws = (unsigned char*)ws_g;     \
    const float* x_in = args.in[I_X]; (void)x_in; \
    float* modp = (float*)(ws + WS_MODP); float* mod = (float*)(ws + WS_MOD); float* SMALL = (float*)(ws + WS_SMALL); (void)modp; (void)mod; (void)SMALL; \
    float* CUM = (float*)(ws + WS_CUM); float* BETA = (float*)(ws + WS_BETA); float* GG = (float*)(ws + WS_GG); (void)CUM; (void)BETA; (void)GG; \
    bf16* U = (bf16*)(ws + WS_U); float* X = (float*)(ws + WS_X); float* PRE = (float*)(ws + WS_PRE); (void)U; (void)X; (void)PRE; \
    bf16* T = (bf16*)(ws + WS_T); bf16* H = (bf16*)(ws + WS_H); (void)T; (void)H; \
    bf16* YA = (bf16*)(ws + WS_YA); bf16* YB = (bf16*)(ws + WS_YB); bf16* YC = (bf16*)(ws + WS_YC); bf16* MG = (bf16*)(ws + WS_MG); (void)YA; (void)YB; (void)YC; (void)MG; \
    float* MACC = (float*)(ws + WS_MACC); float* QN = (float*)(ws + WS_QN); float* KN = (float*)(ws + WS_KN); float* VN = (float*)(ws + WS_VN); float* ORAW = (float*)(ws + WS_ORAW); \
    (void)MACC; (void)QN; (void)KN; (void)VN; (void)ORAW;

    if (IN(0)) { PH_BEGIN
        LAS f32x4* ca = (LAS f32x4*)lds;
        const float* c = args.in[I_C];
        for (int k = tid; k < D; k += NT) { f32x4 v; for (int b = 0; b < 4; ++b) { const float cv = c[b * D + k]; v[b] = cv / (1.f + expf(-cv)); } ca[k] = v; }
        __syncthreads();
        const float* w_ada = args.in[I_WADA];
        for (int it = gw; it < 1536; it += NGW) {
            const int l = it / 768, r = it % 768, jblk = r >> 4, kc = r & 15;
            const float* W = w_ada + ((size_t)(l * D + kc * 128)) * MODW + jblk * 256 + lane * 4;
            f32x4 a0 = {0.f, 0.f, 0.f, 0.f}, a1 = a0, a2 = a0, a3 = a0;
#pragma unroll 8
            for (int k = 0; k < 128; ++k) { const f32x4 w = *(const f32x4*)(W + (size_t)k * MODW); const f32x4 cv = ca[kc * 128 + k]; a0 += w * cv[0]; a1 += w * cv[1]; a2 += w * cv[2]; a3 += w * cv[3]; }
            float* P = modp + ((size_t)((l * 16 + kc) * 4)) * MODW + jblk * 256 + lane * 4;
            *(f32x4*)(P) = a0; *(f32x4*)(P + MODW) = a1; *(f32x4*)(P + 2 * MODW) = a2; *(f32x4*)(P + 3 * MODW) = a3;
        }
    }
    SEAM(0);
    if (IN(1)) { PH_BEGIN
        const float* b_ada = args.in[I_BADA];
        for (int i = gtid; i < DEPTH * 4 * MODW; i += NGT) { const int l = i / (4 * MODW), r = i % (4 * MODW), b = r / MODW, j = r % MODW; float s = b_ada[l * MODW + j];
            for (int kc = 0; kc < 16; ++kc) s += modp[((size_t)((l * 16 + kc) * 4 + b)) * MODW + j];
            mod[i] = s; }
        constexpr int I_IN = 13 * 32 * 64, I_TAIL = 96, I_SQ = 4 * 32 * 64, I_F1 = 32 * 256, I_F2 = 128 * 64, I_L = I_IN + I_TAIL + I_SQ + I_F1 + I_F2;
        for (int it = gw; it < DEPTH * I_L; it += NGW) {
            const int l = it / I_L; int r = it % I_L; unsigned char* wl = ws + WS_W + (size_t)l * W_LAYER;
            if (r < I_IN) { const int t = r >> 11, q = r & 2047; tr_item(args.in[I_WIN] + (size_t)l * D * INW + src_off(t), INW, (bf16*)(wl + W_IN) + (size_t)t * D * D, D, q >> 6, q & 63, lane); continue; } r -= I_IN;
            if (r < I_TAIL) { const int nb = r >> 5, kb = r & 31; tr_item(args.in[I_WIN] + (size_t)l * D * INW + (nb < 2 ? SRC_GB + 32 * nb : SRC_FF), INW, (bf16*)(wl + W_IN) + (size_t)(13 * D + 32 * nb) * D, D, kb, 0, lane); continue; } r -= I_TAIL;
            if (r < I_SQ) { const int t = r >> 11, q = r & 2047; tr_item((t == 0 ? args.in[I_WA] : t == 1 ? args.in[I_WB] : t == 2 ? args.in[I_WC] : args.in[I_WO]) + (size_t)l * D * D, D, (bf16*)(wl + W_A + (size_t)t * 8 * MiB), D, q >> 6, q & 63, lane); continue; } r -= I_SQ;
            if (r < I_F1) { tr_item(args.in[I_W1] + (size_t)l * D * FF, FF, (bf16*)(wl + W_1), D, r >> 8, r & 255, lane); continue; } r -= I_F1;
            tr_item(args.in[I_W2] + (size_t)l * FF * D, D, (bf16*)(wl + W_2), FF, r >> 6, r & 63, lane);
        }
        for (int i = gtid; i < DEPTH * 160 * (D / 8); i += NGT) { const int l = i / (160 * 256), r = i % (160 * 256); bf16* p = (bf16*)(ws + WS_W + (size_t)l * W_LAYER + W_IN) + (size_t)(13 * D + 96 + (r >> 8)) * D + (r & 255) * 8;
            *(u32x4*)p = (u32x4){0u, 0u, 0u, 0u}; }
    }
    SEAM(1);
    if (IN(2)) { PH_BEGIN
        for (int m = gw; m < M; m += NGW) { const float* mb = mod + (size_t)(m >> 11) * MODW; modulate_row(x_in + (size_t)m * D, U + (size_t)m * D, mb, mb + D, lane); }
    }
    SEAM(2);

    for (int l = 0; l < DEPTH; ++l) {
        const int pb = 3 + l * NPL;
#define LAYER_PTRS unsigned char* wl = ws + WS_W + (size_t)l * W_LAYER; const float* modl = mod + (size_t)l * 4 * MODW; const float* Xin = (l == 0) ? x_in : X; (void)wl; (void)modl; (void)Xin;
        if (IN(pb + 0)) { PH_BEGIN LAYER_PTRS
            pg8::Gemm g{U, (const bf16*)(wl + W_IN), M, NPAD, D}; pg8::StaticOrder S; S.init(M, NPAD, G, blk);
            pg8::EpiInProj E{T, SMALL, ACT_E};
            pg8::gemm_phase<pg8::EpiInProj, pg8::StaticOrder, true, true>(lds, g, S, E);
        }
        SEAM(pb + 0);
        if (IN(pb + 1)) { PH_BEGIN LAYER_PTRS
            { const float* cw = args.in[I_CONVW] + (size_t)l * 3 * D; const bf16 *CB = T + TI_CB * ACT_E, *CC = T + TI_CC * ACT_E, *CH = T + TI_CH * ACT_E;
              for (int it = gtid; it < (M / 8) * 256; it += NGT) {
                const int col = (it & 255) * 8, m0 = (it >> 8) * 8; const bool first = (m0 & (SEQ - 1)) == 0;
                float w0[8], w1[8], w2[8], p2[8], p1[8];
#pragma unroll
                for (int i = 0; i < 8; ++i) { w0[i] = cw[col + i]; w1[i] = cw[D + col + i]; w2[i] = cw[2 * D + col + i]; p2[i] = 0.f; p1[i] = 0.f; }
                if (!first) { float a[8], b[8];
                    unpack8(*(const u32x4*)(CC + (size_t)(m0 - 2) * D + col), a); unpack8(*(const u32x4*)(CH + (size_t)(m0 - 2) * D + col), b);
#pragma unroll
                    for (int i = 0; i < 8; ++i) p2[i] = a[i] * b[i];
                    unpack8(*(const u32x4*)(CC + (size_t)(m0 - 1) * D + col), a); unpack8(*(const u32x4*)(CH + (size_t)(m0 - 1) * D + col), b);
#pragma unroll
                    for (int i = 0; i < 8; ++i) p1[i] = a[i] * b[i]; }
                for (int r = 0; r < 8; ++r) { const size_t o = (size_t)(m0 + r) * D + col; float a[8], b[8], g[8], y[8];
                    unpack8(*(const u32x4*)(CC + o), a); unpack8(*(const u32x4*)(CH + o), b); unpack8(*(const u32x4*)(CB + o), g);
#pragma unroll
                    for (int i = 0; i < 8; ++i) { const float p0 = a[i] * b[i]; y[i] = g[i] * (w0[i] * p2[i] + w1[i] * p1[i] + w2[i] * p0); p2[i] = p1[i]; p1[i] = p0; }
                    *(u32x4*)(YA + o) = pack8(y); }
              } }
            { const float* gcw = args.in[I_GCONVW] + (size_t)l * 4 * 6144;
              for (int it = gw; it < 6144; it += NGW) {
                const int cgp = it & 3, ten = (it >> 2) % 3, rb = it / 12; const int ch = cgp * 512 + lane * 8; const int m0 = rb * 16; const bool first = (m0 & (SEQ - 1)) == 0;
                const bf16* src = T + (size_t)(TI_GQ + ten) * ACT_E; float* dst = (ten == 0) ? QN : (ten == 1 ? KN : VN);
                float w[4][8], h3[8], h2[8], h1[8];
#pragma unroll
                for (int i = 0; i < 8; ++i) { w[0][i] = gcw[ten * D + ch + i]; w[1][i] = gcw[6144 + ten * D + ch + i]; w[2][i] = gcw[2 * 6144 + ten * D + ch + i]; w[3][i] = gcw[3 * 6144 + ten * D + ch + i]; h3[i] = 0.f; h2[i] = 0.f; h1[i] = 0.f; }
                if (!first) { unpack8(*(const u32x4*)(src + (size_t)(m0 - 3) * D + ch), h3); unpack8(*(const u32x4*)(src + (size_t)(m0 - 2) * D + ch), h2); unpack8(*(const u32x4*)(src + (size_t)(m0 - 1) * D + ch), h1); }
                for (int r = 0; r < 16; ++r) { const size_t o = (size_t)(m0 + r) * D + ch; float h0[8], y[8]; unpack8(*(const u32x4*)(src + o), h0); float ss = 0.f;
#pragma unroll
                    for (int i = 0; i < 8; ++i) { const float a = w[0][i] * h3[i] + w[1][i] * h2[i] + w[2][i] * h1[i] + w[3][i] * h0[i]; y[i] = a / (1.f + expf(-a)); ss += y[i] * y[i]; h3[i] = h2[i]; h2[i] = h1[i]; h1[i] = h0[i]; }
                    if (ten < 2) { ss += __shfl_xor(ss, 1); ss += __shfl_xor(ss, 2); ss += __shfl_xor(ss, 4); ss += __shfl_xor(ss, 8); const float rn = 1.f / sqrtf(ss + NORM_EPS);
#pragma unroll
                        for (int i = 0; i < 8; ++i) y[i] *= rn; }
                    *(f32x4*)(dst + o) = (f32x4){y[0], y[1], y[2], y[3]}; *(f32x4*)(dst + o + 4) = (f32x4){y[4], y[5], y[6], y[7]}; }
              } }
            { const float* alog = args.in[I_ALOG] + l * 32; const float* dtb = args.in[I_DTB] + l * 32;
              for (int i = gtid; i < M * 32; i += NGT) { const int m = i >> 5, hv = i & 31; const float bl = SMALL[(size_t)m * 256 + hv], al = SMALL[(size_t)m * 256 + 32 + hv];
                BETA[i] = 1.f / (1.f + expf(-bl)); const float xx = al + dtb[hv]; const float sp = fmaxf(xx, 0.f) + log1pf(expf(-fabsf(xx))); GG[i] = -expf(alog[hv]) * sp; } }
            { const float* fbias = args.in[I_FBIAS] + l * 16;
              for (int it = gw; it < 64; it += NGW) { const int b = it >> 4, h = it & 15; const float fb = fbias[h]; const size_t mbase = (size_t)b * SEQ + lane * 32; float tot = 0.f;
                for (int i = 0; i < 32; ++i) { const float xx = SMALL[(mbase + i) * 256 + 64 + h] + fb; tot += fminf(xx, 0.f) - log1pf(expf(-fabsf(xx))); }
                float inc = tot;
#pragma unroll
                for (int o = 1; o < 64; o <<= 1) { const float n = __shfl_up(inc, o); if (lane >= o) inc += n; }
                float run = inc - tot;
                for (int i = 0; i < 32; ++i) { const float xx = SMALL[(mbase + i) * 256 + 64 + h] + fb; run += fminf(xx, 0.f) - log1pf(expf(-fabsf(xx))); CUM[(size_t)it * SEQ + lane * 32 + i] = run;
                    const float xq = run * 11.313708498984761f; const unsigned h1 = f2bf(xq); const float r1 = xq - __builtin_bit_cast(float, h1 << 16); const unsigned h2 = f2bf(r1); const float r2 = r1 - __builtin_bit_cast(float, h2 << 16); const unsigned h3 = f2bf(r2);
                    const unsigned n1 = h1 ^ 0x8000u, n2 = h2 ^ 0x8000u, n3 = h3 ^ 0x8000u;
                    *((u32x4*)(ws + WS_FKB) + ((size_t)it * SEQ + lane * 32 + i)) = (u32x4){n1 | (n2 << 16), n3, 0u, 0u}; }
              } }
        }
        SEAM(pb + 1);
        if (IN(pb + 2)) { PH_BEGIN LAYER_PTRS
            if (wave < 4) {
                const int it = blk * 4 + wave;
                if (it < 1024) {
                    const int b = it >> 8, hv = (it >> 3) & 31, dvc = it & 7, hk = hv >> 1, kq = lane >> 3, col = lane & 7;
                    float S[16];
#pragma unroll
                    for (int i = 0; i < 16; ++i) S[i] = 0.f;
                    const float* kp = KN + (size_t)b * SEQ * D + hk * 128 + kq * 16; const float* qp = QN + (size_t)b * SEQ * D + hk * 128 + kq * 16;
                    const float* vp = VN + (size_t)b * SEQ * D + hv * 64 + dvc * 8 + col; const float* bp = BETA + (size_t)b * SEQ * 32 + hv; const float* gp = GG + (size_t)b * SEQ * 32 + hv;
                    float* op = ORAW + (size_t)b * SEQ * D + hv * 64 + dvc * 8 + col;
                    f32x4 kn[4], qn[4]; float vn, bn, gn;
#pragma unroll
                    for (int i = 0; i < 4; ++i) { kn[i] = *(const f32x4*)(kp + 4 * i); qn[i] = *(const f32x4*)(qp + 4 * i); }
                    vn = vp[0]; bn = bp[0]; gn = gp[0];
                    for (int t = 0; t < SEQ; ++t) {
                        f32x4 kc[4], qc[4]; const float vc = vn, bc = bn, gc = gn;
#pragma unroll
                        for (int i = 0; i < 4; ++i) { kc[i] = kn[i]; qc[i] = qn[i]; }
                        if (t + 1 < SEQ) { const size_t o = (size_t)(t + 1) * D;
#pragma unroll
                            for (int i = 0; i < 4; ++i) { kn[i] = *(const f32x4*)(kp + o + 4 * i); qn[i] = *(const f32x4*)(qp + o + 4 * i); }
                            vn = vp[o]; bn = bp[(size_t)(t + 1) * 32]; gn = gp[(size_t)(t + 1) * 32]; }
                        const float eg = expf(gc); float p = 0.f;
#pragma unroll
                        for (int i = 0; i < 16; ++i) { S[i] *= eg; p += kc[i >> 2][i & 3] * S[i]; }
                        p += __shfl_xor(p, 8); p += __shfl_xor(p, 16); p += __shfl_xor(p, 32);
                        const float dlt = bc * (vc - p); float o = 0.f;
#pragma unroll
                        for (int i = 0; i < 16; ++i) { S[i] += kc[i >> 2][i & 3] * dlt; o += qc[i >> 2][i & 3] * S[i]; }
                        o += __shfl_xor(o, 8); o += __shfl_xor(o, 16); o += __shfl_xor(o, 32);
                        if (kq == 0) op[(size_t)t * D] = o * 0.08838834764831845f;
                    }
                }
            }
            __syncthreads();
            {
                typedef fox::BlockRef<fox::TIN, fox::TOUT> BR;
                const fox::TIN *FQp = (const fox::TIN*)(T + TI_FQ * ACT_E), *FKp = (const fox::TIN*)(T + TI_FK * ACT_E), *FVp = (const fox::TIN*)(T + TI_FV * ACT_E); fox::TOUT* Op = (fox::TOUT*)YC;
                const char* FKB = (const char*)(ws + WS_FKB); const char* Z16 = (const char*)(ws + 256);
                const int bh = blk >> 2, xq = blk & 3, b = bh >> 4, h = bh & 15;
                if (blk < 256) {
#define FOX_REF(r, qb) do { const size_t row0 = (size_t)b * SEQ + (size_t)(qb) * 256; (r).Q = FQp + row0 * D + h * 128; (r).K = FKp + (size_t)b * SEQ * D + h * 128; (r).V = FVp + (size_t)b * SEQ * D + h * 128; \
                    (r).O = Op + row0 * D + h * 128; (r).FK = FKB + (size_t)bh * SEQ * 16; (r).Z16 = Z16; (r).P0 = (qb) * 256; } while (0)
                    BR cur, nxt; FOX_REF(cur, xq); FOX_REF(nxt, 7 - xq);
                    fox::Seam<fox::TIN> S;
                    fox::causal_swa_prime<fox::TIN, fox::TOUT>(cur, SEQ, (char*)lds_raw, S);
                    for (int pass = 0; pass < 2; ++pass) {
                        fox::causal_swa_block<fox::TIN, fox::TOUT>(cur, nxt, SEQ, SEQ, (char*)lds_raw, S);
                        cur = nxt;
                    }
#undef FOX_REF
                }
            }
        }
        SEAM(pb + 2);
        if (IN(pb + 3)) { PH_BEGIN LAYER_PTRS
            const float* nw = args.in[I_GNORMW] + l * 64; const bf16* GZ = T + TI_GZ * ACT_E;
            float nwv[8];
#pragma unroll
            for (int i = 0; i < 8; ++i) nwv[i] = nw[(lane & 7) * 8 + i];
            for (int it = gw; it < M * 4; it += NGW) { const size_t o = (size_t)(it >> 2) * D + (it & 3) * 512 + lane * 8;
                const f32x4 a = *(const f32x4*)(ORAW + o), b = *(const f32x4*)(ORAW + o + 4); float ov[8] = {a[0], a[1], a[2], a[3], b[0], b[1], b[2], b[3]}, z[8], y[8]; float ss = 0.f;
#pragma unroll
                for (int i = 0; i < 8; ++i) ss += ov[i] * ov[i];
                ss += __shfl_xor(ss, 1); ss += __shfl_xor(ss, 2); ss += __shfl_xor(ss, 4);
                const float rn = 1.f / sqrtf(ss * (1.f / 64.f) + NORM_EPS); unpack8(*(const u32x4*)(GZ + o), z);
#pragma unroll
                for (int i = 0; i < 8; ++i) y[i] = ov[i] * rn * nwv[i] * (z[i] / (1.f + expf(-z[i])));
                *(u32x4*)(YB + o) = pack8(y); }
        }
        SEAM(pb + 3);
        if (IN(pb + 4)) { PH_BEGIN LAYER_PTRS
            pg8::StaticOrder S; S.init(M, D, G, blk);
            { pg8::Gemm g{YA, (const bf16*)(wl + W_A), M, D, D}; pg8::EpiMerge<0> E{T + TI_MA * ACT_E, MACC, MG}; pg8::gemm_phase<pg8::EpiMerge<0>, pg8::StaticOrder, true, true>(lds, g, S, E); }
            { pg8::Gemm g{YB, (const bf16*)(wl + W_B), M, D, D}; pg8::EpiMerge<1> E{T + TI_MB * ACT_E, MACC, MG}; pg8::gemm_phase<pg8::EpiMerge<1>, pg8::StaticOrder, true, true>(lds, g, S, E); }
            { pg8::Gemm g{YC, (const bf16*)(wl + W_C), M, D, D}; pg8::EpiMerge<2> E{T + TI_MC * ACT_E, MACC, MG}; pg8::gemm_phase<pg8::EpiMerge<2>, pg8::StaticOrder, true, true>(lds, g, S, E); }
        }
        SEAM(pb + 4);
        if (IN(pb + 5)) { PH_BEGIN LAYER_PTRS
            pg8::Gemm g{MG, (const bf16*)(wl + W_O), M, D, D}; pg8::StaticOrder S; S.init(M, D, G, blk);
            pg8::EpiResid E{Xin, modl + 2 * D, PRE, ALPHA};
            pg8::gemm_phase<pg8::EpiResid, pg8::StaticOrder, true, true>(lds, g, S, E);
        }
        SEAM(pb + 5);
        if (IN(pb + 6)) { PH_BEGIN LAYER_PTRS
            const float* g1 = args.in[I_LN1G] + (size_t)l * D; const float* b1 = args.in[I_LN1B] + (size_t)l * D;
            for (int m = gw; m < M; m += NGW) { const float* mb = modl + (size_t)(m >> 11) * MODW; ln_mod_row(PRE + (size_t)m * D, g1, b1, X + (size_t)m * D, U + (size_t)m * D, mb + 3 * D, mb + 4 * D, lane); }
        }
        SEAM(pb + 6);
        if (IN(pb + 7)) { PH_BEGIN LAYER_PTRS
            pg8::Gemm g{U, (const bf16*)(wl + W_1), M, FF, D}; pg8::StaticOrder S; S.init(M, FF, G, blk);
            pg8::EpiRelu2 E{H, FF};
            pg8::gemm_phase<pg8::EpiRelu2, pg8::StaticOrder, true, true>(lds, g, S, E);
        }
        SEAM(pb + 7);
        if (IN(pb + 8)) { PH_BEGIN LAYER_PTRS
            pg8::Gemm g{H, (const bf16*)(wl + W_2), M, D, FF}; pg8::StaticOrder S; S.init(M, D, G, blk);
            pg8::EpiResid E{X, modl + 5 * D, PRE, ALPHA};
            pg8::gemm_phase<pg8::EpiResid, pg8::StaticOrder, true, true>(lds, g, S, E);
        }
        SEAM(pb + 8);
        if (IN(pb + 9)) { PH_BEGIN LAYER_PTRS
            const float* g2 = args.in[I_LN2G] + (size_t)l * D; const float* b2 = args.in[I_LN2B] + (size_t)l * D; const bool last = (l == DEPTH - 1);
            float* xo = last ? args.out : X; const float* modn = mod + (size_t)(last ? l : l + 1) * 4 * MODW;
            for (int m = gw; m < M; m += NGW) { const float* mb = modn + (size_t)(m >> 11) * MODW; ln_mod_row(PRE + (size_t)m * D, g2, b2, xo + (size_t)m * D, last ? (bf16*)nullptr : U + (size_t)m * D, mb, mb + D, lane); }
        }
        SEAM(pb + 9);
    }
#undef IN
#undef SEAM
}

#ifndef MK_ONE_LAUNCH
#define MK_ONE_LAUNCH 0
#endif
extern "C" void kernel_launch(void* const* d_in, const int* in_sizes, int n_in, void* d_out, int out_size, void* d_ws, size_t ws_size, hipStream_t stream) {
    static int grid = 0;
    if (grid == 0) {
        if (n_in != N_IN || out_size != M * D || ws_size < WS_END) { fprintf(stderr, "kernel_launch: unexpected shapes: n_in %d out %d ws %zu (need %zu)\n", n_in, out_size, ws_size, (size_t)WS_END); grid = -1; return; }
        int dev = 0, cus = 0, per_cu = 0;
        if (hipGetDevice(&dev) != hipSuccess || hipDeviceGetAttribute(&cus, hipDeviceAttributeMultiprocessorCount, dev) != hipSuccess) { grid = -1; return; }
        if (hipFuncSetAttribute((const void*)fwd_kernel, hipFuncAttributeMaxDynamicSharedMemorySize, LDS_BYTES) != hipSuccess) { fprintf(stderr, "kernel_launch: hipFuncSetAttribute failed\n"); grid = -1; return; }
        if (hipOccupancyMaxActiveBlocksPerMultiprocessor(&per_cu, (const void*)fwd_kernel, NT, LDS_BYTES) != hipSuccess || per_cu < 1) fprintf(stderr, "kernel_launch: occupancy query says %d\n", per_cu);
        (void)hipGetLastError();
        grid = cus;
        if (grid != 256) fprintf(stderr, "kernel_launch: %d CUs (built for 256)\n", grid);
    }
    if (grid < 0) return;
    (void)hipMemsetAsync((char*)d_ws + WS_CTL, 0, CTL_ZERO_BYTES, stream);
    Args a{};
    for (int i = 0; i < N_IN; ++i) a.in[i] = (const float*)d_in[i];
    a.out = (float*)d_out; a.ws = (unsigned char*)d_ws;
#if MK_ONE_LAUNCH
    a.ph_lo = 0; a.ph_hi = NPH;
    hipLaunchKernelGGL(fwd_kernel, dim3(grid), dim3(NT), LDS_BYTES, stream, a);
#else
    for (int p = 0; p < NPH; ++p) { a.ph_lo = p; a.ph_hi = p + 1; hipLaunchKernelGGL(fwd_kernel, dim3(grid), dim3(NT), LDS_BYTES, stream, a); }
#endif
}
```

```cpp
#include <hip/hip_runtime.h>
#include <cstdio>
#include <cstdint>
#define MK_ONE_LAUNCH 1
namespace pg8 {
#define PG8_LAS __attribute__((address_space(3)))
typedef unsigned short bf16_t;
typedef short bf16x8 __attribute__((ext_vector_type(8)));
typedef float f32x4 __attribute__((ext_vector_type(4)));
typedef unsigned u32x4 __attribute__((ext_vector_type(4)));
constexpr int BM = 256, BK = 64, HALF = 128, HTB = HALF * BK * 2  , STAGE_BYTES = 8 * HTB, NXCD = 8, WGM = 8;

__host__ __device__ __forceinline__ int lds_byte(int r, int c) { const int st = (r >> 4) * 2 + (c >> 5), rr = r & 15, cc = c & 31, ob = rr * 64 + cc * 2; return st * 1024 + (ob ^ (((ob >> 9) & 1) << 5)); }
__host__ __device__ __forceinline__ void stage_rc(int b, int& R, int& C) { const int st = b / 1024, sb = b % 1024, swz = sb ^ (((sb >> 9) & 1) << 5); R = (st >> 1) * 16 + swz / 64; C = (st & 1) * 32 + (swz % 64) / 2; }
__host__ __device__ __forceinline__ int perm32(int rho) { const int n = rho >> 4, i = rho & 15; return 8 * (i >> 2) + 4 * n + (i & 3); }

struct Unit { int pm, pn; };
struct Gemm { const bf16_t* A; const bf16_t* Bt; int M, N, K; };

struct StaticOrder {
    int nM, nN, nwg, G, c;
    __host__ __device__ void init(int M, int N, int G_, int c_) { nM = M / BM; nN = N / BM; nwg = nM * nN; G = G_; c = c_; }
    __host__ __device__ bool next(int i, Unit& u) const {
        const long L = (long)i * G + c; if (L >= nwg) return false;
        int wgid = (int)L; { const int q = nwg / NXCD, r = nwg % NXCD, xcd = wgid % NXCD, off = wgid / NXCD; wgid = (xcd < r ? xcd * (q + 1) : r * (q + 1) + (xcd - r) * q) + off; }
        const int nig = WGM * nN, gid = wgid / nig, fm = gid * WGM, gsz = (nM - fm) < WGM ? (nM - fm) : WGM;
        u.pm = fm + ((wgid % nig) % gsz); u.pn = (wgid % nig) / gsz; return true;
    }
    __device__ __forceinline__ void a_ready(const Unit&) const {}
    __device__ __forceinline__ void done(const Unit&) const {}
};

__device__ __forceinline__ unsigned cvt_pk_bf16(float lo, float hi) { unsigned r; asm volatile("v_cvt_pk_bf16_f32 %0, %1, %2" : "=v"(r) : "v"(lo), "v"(hi)); return r; }
typedef float f32x2 __attribute__((ext_vector_type(2)));
__device__ __forceinline__ f32x2 gelu_pk(f32x2 v) {
    const f32x2 av = __builtin_elementwise_abs(v), d = av * 0.2316418882f + 1.0f;
    f32x2 t; t.x = __builtin_amdgcn_rcpf(d.x); t.y = __builtin_amdgcn_rcpf(d.y);
    f32x2 q = t * 0.5307027145f + (-0.7265760135f); q = q * t + 0.7107068705f; q = q * t + (-0.142248368f); q = q * t + 0.127414796f; q = q * t;
    const f32x2 s = (v * v) * (-0.72134752044f);
    f32x2 e; e.x = __builtin_amdgcn_exp2f(s.x); e.y = __builtin_amdgcn_exp2f(s.y);
    const f32x2 m = v * (q * e), r = v - m;
    f32x2 o; o.x = v.x < 0.f ? m.x : r.x; o.y = v.y < 0.f ? m.y : r.y; return o;
}

template <int ACT  > struct EpiBf16 {
    static constexpr bool PERM = true, AFTER_DRAIN = false; static_assert(ACT == 0 || ACT == 1, "EpiBf16: ACT is 0 (none) or 1 (gelu_pk)");
    bf16_t* O; int ldc; const float* bias; int split_cols; size_t split_stride; float scale0;
    __device__ __forceinline__ void operator()(const f32x4 (&acc)[2][2][4][2], const Unit& u, int wr, int wc, int fr, int fq) const {
        const int row0 = u.pm * BM + wr * 64 + fr; int colt = u.pn * BM; bf16_t* base = O;
        float sc = 1.f; if (split_cols) { const int t = colt / split_cols; base += (size_t)t * split_stride; colt -= t * split_cols; if (t == 0) sc = scale0; }
        const int col0 = colt + wc * 32 + 8 * fq, bcol0 = u.pn * BM + wc * 32 + 8 * fq;
        f32x4 bv[2][2];
#pragma unroll
        for (int bj = 0; bj < 2; ++bj)
#pragma unroll
            for (int n = 0; n < 2; ++n) bv[bj][n] = bias ? *(const f32x4*)(bias + bcol0 + bj * HALF + 4 * n) : (f32x4){0.f, 0.f, 0.f, 0.f};
#pragma unroll
        for (int ai = 0; ai < 2; ++ai)
#pragma unroll
            for (int m = 0; m < 4; ++m) { bf16_t* rowp = base + (size_t)(row0 + ai * HALF + m * 16) * ldc + col0;
#pragma unroll
                for (int bj = 0; bj < 2; ++bj) { f32x4 v0 = acc[ai][bj][m][0] + bv[bj][0], v1 = acc[ai][bj][m][1] + bv[bj][1];
                    if (ACT == 1) { f32x2 a = gelu_pk((f32x2){v0[0], v0[1]}), b = gelu_pk((f32x2){v0[2], v0[3]}), c = gelu_pk((f32x2){v1[0], v1[1]}), d = gelu_pk((f32x2){v1[2], v1[3]});
                        v0 = (f32x4){a.x, a.y, b.x, b.y}; v1 = (f32x4){c.x, c.y, d.x, d.y}; }
                    v0 = v0 * sc; v1 = v1 * sc; u32x4 w; w.x = cvt_pk_bf16(v0[0], v0[1]); w.y = cvt_pk_bf16(v0[2], v0[3]); w.z = cvt_pk_bf16(v1[0], v1[1]); w.w = cvt_pk_bf16(v1[2], v1[3]);
                    *(u32x4*)(rowp + bj * HALF) = w; } }
    }
};


template <class Epi, class Sched, bool ALIGN_EPI = false, bool SP2 = false>
__device__ __forceinline__ void gemm_phase(PG8_LAS unsigned char* lds, const Gemm g, const Sched& S, const Epi& E) {
    int tid_l = threadIdx.x; asm volatile("" : "+v"(tid_l));
    const int tid = tid_l, wid = __builtin_amdgcn_readfirstlane(tid >> 6), lane = tid & 63, wr = wid >> 2, wc = wid & 3, fr = lane & 15, fq = lane >> 4;
    const int K = g.K, nt = K / BK;
    unsigned voffA[2], voffB[2];
#pragma unroll
    for (int i = 0; i < 2; ++i) { int R, C; stage_rc(tid * 16 + i * 8192, R, C); const int Rb = Epi::PERM ? ((R & ~31) + perm32(R & 31)) : R;
        voffA[i] = (unsigned)(R * K + C) * 2u; voffB[i] = (unsigned)(Rb * K + C) * 2u; }
    const size_t kstep = (size_t)(BK * 2);
    const size_t hstep = (size_t)HALF * K * 2;
    const size_t tstep = 2 * hstep;
    const unsigned ldsw = (unsigned)wid * 1024u;
    const int aoff = lds_byte(wr * 64 + fr, fq * 8), boff = lds_byte(wc * 32 + fr, fq * 8);
#define PG8_SA(b, h) (((b) * 2 + (h)) * HTB)
#define PG8_SB(b, h) ((4 + (b) * 2 + (h)) * HTB)
#define PG8_STAGE(bufoff, gbase, voff) do { _Pragma("unroll") for (int _i = 0; _i < 2; ++_i) \
        __builtin_amdgcn_global_load_lds((const unsigned*)((const char*)(gbase) + (voff)[_i]), (PG8_LAS unsigned*)(lds + (bufoff) + ldsw + _i * 8192), 16, 0, 0); } while (0)
#define PG8_LDA(dst, b, h) do { _Pragma("unroll") for (int m = 0; m < 4; ++m) _Pragma("unroll") for (int k = 0; k < 2; ++k) dst[m][k] = *(const PG8_LAS bf16x8*)(lds + PG8_SA(b, h) + aoff + m * 2048 + k * 1024); } while (0)
#define PG8_LDB(dst, b, h) do { _Pragma("unroll") for (int n = 0; n < 2; ++n) _Pragma("unroll") for (int k = 0; k < 2; ++k) dst[n][k] = *(const PG8_LAS bf16x8*)(lds + PG8_SB(b, h) + boff + n * 2048 + k * 1024); } while (0)
#define PG8_MMA(ai, bj, At, Bt) do { __builtin_amdgcn_s_setprio(1); _Pragma("unroll") for (int m = 0; m < 4; ++m) _Pragma("unroll") for (int n = 0; n < 2; ++n) _Pragma("unroll") for (int k = 0; k < 2; ++k) \
        acc[ai][bj][m][n] = __builtin_amdgcn_mfma_f32_16x16x32_bf16(Bt[n][k], At[m][k], acc[ai][bj][m][n], 0, 0, 0); __builtin_amdgcn_s_setprio(0); } while (0)
#define PG8_WAIT_V(n) asm volatile("s_waitcnt vmcnt(" #n ")" ::: "memory")
#define PG8_WAIT_L(n) asm volatile("s_waitcnt lgkmcnt(" #n ")" ::: "memory")
#define PG8_BAR __builtin_amdgcn_s_barrier()
#define PG8_SCHED __builtin_amdgcn_sched_barrier(0)
    Unit cur, nxt; int ui = 0;
    if (!S.next(0, cur)) return;
    f32x4 acc[2][2][4][2];
#pragma unroll
    for (int a = 0; a < 2; ++a)
#pragma unroll
        for (int b = 0; b < 2; ++b)
#pragma unroll
            for (int m = 0; m < 4; ++m)
#pragma unroll
                for (int n = 0; n < 2; ++n) acc[a][b][m][n] = (f32x4){0.f, 0.f, 0.f, 0.f};
    bf16x8 At[4][2], B0[2][2], B1[2][2];
    const char* cA = (const char*)g.A + (size_t)cur.pm * tstep; const char* cB = (const char*)g.Bt + (size_t)cur.pn * tstep;
    S.a_ready(cur);
    if constexpr (SP2) {
        PG8_STAGE(PG8_SB(0, 0), cB, voffB); PG8_STAGE(PG8_SB(0, 1), cB + hstep, voffB); PG8_STAGE(PG8_SA(0, 0), cA, voffA); PG8_STAGE(PG8_SA(0, 1), cA + hstep, voffA);
        if (wr == 1) PG8_BAR;
        PG8_WAIT_V(2); PG8_BAR;
        PG8_STAGE(PG8_SB(1, 0), cB + kstep, voffB); PG8_STAGE(PG8_SA(1, 0), cA + kstep, voffA); PG8_STAGE(PG8_SB(1, 1), cB + hstep + kstep, voffB);
        PG8_WAIT_V(6); PG8_BAR;
    } else {
        PG8_STAGE(PG8_SB(0, 0), cB, voffB); PG8_STAGE(PG8_SA(0, 0), cA, voffA); PG8_STAGE(PG8_SB(0, 1), cB + hstep, voffB); PG8_STAGE(PG8_SA(0, 1), cA + hstep, voffA);
        if (wr == 1) PG8_BAR;
        PG8_WAIT_V(4); PG8_BAR;
        PG8_STAGE(PG8_SB(1, 0), cB + kstep, voffB); PG8_STAGE(PG8_SA(1, 0), cA + kstep, voffA); PG8_STAGE(PG8_SB(1, 1), cB + hstep + kstep, voffB);
        PG8_WAIT_V(6); PG8_BAR;
    }
    for (;;) {
        const bool has_next = S.next(ui + 1, nxt);
        const char* nA = has_next ? (const char*)g.A + (size_t)nxt.pm * tstep : cA; const char* nB = has_next ? (const char*)g.Bt + (size_t)nxt.pn * tstep : cB;
        for (int t = 0; t < nt; t += 2) {
            const bool last = (t == nt - 2);
            const char* a1 = cA + (size_t)(t + 1) * kstep;
            const char* a2 = last ? nA : cA + (size_t)(t + 2) * kstep; const char* b2 = last ? nB : cB + (size_t)(t + 2) * kstep;
            const char* a3 = a2 + kstep; const char* b3 = b2 + kstep;
            if (last && has_next) S.a_ready(nxt);
            if constexpr (SP2) {
            PG8_LDB(B0, 0, 0); PG8_LDB(B1, 0, 1); PG8_SCHED; PG8_LDA(At, 0, 0); PG8_STAGE(PG8_SA(1, 1), a1 + hstep, voffA);
            PG8_WAIT_V(8); PG8_WAIT_L(0); PG8_BAR; PG8_MMA(0, 0, At, B0); PG8_MMA(0, 1, At, B1); PG8_BAR; PG8_SCHED;
            PG8_LDA(At, 0, 1); PG8_STAGE(PG8_SB(0, 0), b2, voffB); PG8_STAGE(PG8_SB(0, 1), b2 + hstep, voffB); PG8_STAGE(PG8_SA(0, 0), a2, voffA);
            PG8_WAIT_V(8); PG8_WAIT_L(0); PG8_BAR; PG8_MMA(1, 0, At, B0); PG8_MMA(1, 1, At, B1); PG8_BAR; PG8_SCHED;
            PG8_LDB(B0, 1, 0); PG8_LDB(B1, 1, 1); PG8_SCHED; PG8_LDA(At, 1, 0); PG8_STAGE(PG8_SA(0, 1), a2 + hstep, voffA);
            PG8_WAIT_V(8); PG8_WAIT_L(0); PG8_BAR; PG8_MMA(0, 0, At, B0); PG8_MMA(0, 1, At, B1); PG8_BAR; PG8_SCHED;
            PG8_LDA(At, 1, 1); PG8_STAGE(PG8_SB(1, 0), b3, voffB); PG8_STAGE(PG8_SB(1, 1), b3 + hstep, voffB); PG8_STAGE(PG8_SA(1, 0), a3, voffA);
            PG8_WAIT_V(8); PG8_WAIT_L(0); PG8_BAR; PG8_MMA(1, 0, At, B0); PG8_MMA(1, 1, At, B1); PG8_BAR; PG8_SCHED;
            } else {
            PG8_LDB(B0, 0, 0); PG8_SCHED; PG8_LDA(At, 0, 0); PG8_STAGE(PG8_SA(1, 1), a1 + hstep, voffA);
            PG8_WAIT_L(8); PG8_BAR; PG8_WAIT_L(0); PG8_MMA(0, 0, At, B0); PG8_BAR; PG8_SCHED;
            PG8_LDB(B1, 0, 1); PG8_STAGE(PG8_SB(0, 0), b2, voffB);
            PG8_BAR; PG8_WAIT_L(0); PG8_MMA(0, 1, At, B1); PG8_BAR;
            PG8_LDA(At, 0, 1); PG8_STAGE(PG8_SA(0, 0), a2, voffA);
            PG8_BAR; PG8_WAIT_L(0); PG8_MMA(1, 0, At, B0); PG8_BAR; PG8_SCHED;
            PG8_STAGE(PG8_SB(0, 1), b2 + hstep, voffB);
            PG8_WAIT_V(6); PG8_BAR; PG8_MMA(1, 1, At, B1); PG8_BAR;
            PG8_LDB(B0, 1, 0); PG8_SCHED; PG8_LDA(At, 1, 0); PG8_STAGE(PG8_SA(0, 1), a2 + hstep, voffA);
            PG8_WAIT_L(8); PG8_BAR; PG8_WAIT_L(0); PG8_MMA(0, 0, At, B0); PG8_BAR; PG8_SCHED;
            PG8_LDB(B1, 1, 1); PG8_STAGE(PG8_SB(1, 0), b3, voffB);
            PG8_BAR; PG8_WAIT_L(0); PG8_MMA(0, 1, At, B1); PG8_BAR;
            PG8_LDA(At, 1, 1); PG8_STAGE(PG8_SA(1, 0), a3, voffA);
            PG8_BAR; PG8_WAIT_L(0); PG8_MMA(1, 0, At, B0); PG8_BAR; PG8_SCHED;
            PG8_STAGE(PG8_SB(1, 1), b3 + hstep, voffB);
            PG8_WAIT_V(6); PG8_BAR; PG8_MMA(1, 1, At, B1); PG8_BAR;
            }
        }
        if constexpr (ALIGN_EPI) { if (wr == 0) PG8_BAR; }
        if constexpr (!Epi::AFTER_DRAIN) { E(acc, cur, wr, wc, fr, fq); S.done(cur); }
        if (!has_next) break;
#pragma unroll
        for (int a = 0; a < 2; ++a)
#pragma unroll
            for (int b = 0; b < 2; ++b)
#pragma unroll
                for (int m = 0; m < 4; ++m)
#pragma unroll
                    for (int n = 0; n < 2; ++n) acc[a][b][m][n] = (f32x4){0.f, 0.f, 0.f, 0.f};
        cur = nxt; cA = nA; cB = nB; ++ui;
        if constexpr (ALIGN_EPI) { if (wr == 1) PG8_BAR; }
    }
    PG8_WAIT_V(0);
    if constexpr (!ALIGN_EPI) { if (wr == 0) PG8_BAR; }
    PG8_BAR;
    if constexpr (Epi::AFTER_DRAIN) { E.fused(acc, cur, wr, wc, fr, fq, lds, wid, lane); S.done(cur); }
#undef PG8_SA
#undef PG8_SB
#undef PG8_STAGE
#undef PG8_LDA
#undef PG8_LDB
#undef PG8_MMA
#undef PG8_WAIT_V
#undef PG8_WAIT_L
#undef PG8_BAR
#undef PG8_SCHED
}
}

namespace pg8 {
__device__ __forceinline__ float bf_lo(unsigned w) { return __builtin_bit_cast(float, w << 16); }
__device__ __forceinline__ float bf_hi(unsigned w) { return __builtin_bit_cast(float, w & 0xffff0000u); }
__device__ __forceinline__ float fsigmoid(float x) { return __builtin_amdgcn_rcpf(1.f + __expf(-x)); }

struct EpiInProj {
    static constexpr bool PERM = true, AFTER_DRAIN = false;
    bf16_t* T0; float* SMALL; size_t tstride;
    __device__ __forceinline__ void operator()(const f32x4 (&acc)[2][2][4][2], const Unit& u, int wr, int wc, int fr, int fq) const {
        const int t = u.pn >> 3; const int row0 = u.pm * BM + wr * 64 + fr;
        if (t < 13) {
            bf16_t* base = T0 + (size_t)t * tstride; const int col0 = (u.pn & 7) * BM + wc * 32 + 8 * fq; const bool sg = t >= 10;
#pragma unroll
            for (int ai = 0; ai < 2; ++ai)
#pragma unroll
                for (int m = 0; m < 4; ++m) { bf16_t* rowp = base + (size_t)(row0 + ai * HALF + m * 16) * 2048 + col0;
#pragma unroll
                    for (int bj = 0; bj < 2; ++bj) { f32x4 v0 = acc[ai][bj][m][0], v1 = acc[ai][bj][m][1];
                        if (sg) { v0 = (f32x4){fsigmoid(v0[0]), fsigmoid(v0[1]), fsigmoid(v0[2]), fsigmoid(v0[3])}; v1 = (f32x4){fsigmoid(v1[0]), fsigmoid(v1[1]), fsigmoid(v1[2]), fsigmoid(v1[3])}; }
                        u32x4 w; w.x = cvt_pk_bf16(v0[0], v0[1]); w.y = cvt_pk_bf16(v0[2], v0[3]); w.z = cvt_pk_bf16(v1[0], v1[1]); w.w = cvt_pk_bf16(v1[2], v1[3]);
                        *(u32x4*)(rowp + bj * HALF) = w; } }
        } else {
            const int col0 = wc * 32 + 8 * fq;
#pragma unroll
            for (int ai = 0; ai < 2; ++ai)
#pragma unroll
                for (int m = 0; m < 4; ++m) { float* rowp = SMALL + (size_t)(row0 + ai * HALF + m * 16) * 256 + col0;
#pragma unroll
                    for (int bj = 0; bj < 2; ++bj) { *(f32x4*)(rowp + bj * HALF) = acc[ai][bj][m][0]; *(f32x4*)(rowp + bj * HALF + 4) = acc[ai][bj][m][1]; } }
        }
    }
};

template <int STEP> struct EpiMerge {
    static constexpr bool PERM = true, AFTER_DRAIN = false;
    const bf16_t* G; float* MACC; bf16_t* OUT;
    __device__ __forceinline__ void operator()(const f32x4 (&acc)[2][2][4][2], const Unit& u, int wr, int wc, int fr, int fq) const {
        const int row0 = u.pm * BM + wr * 64 + fr, col0 = u.pn * BM + wc * 32 + 8 * fq;
#pragma unroll
        for (int ai = 0; ai < 2; ++ai)
#pragma unroll
            for (int m = 0; m < 4; ++m) { const size_t ro = (size_t)(row0 + ai * HALF + m * 16) * 2048 + col0;
#pragma unroll
                for (int bj = 0; bj < 2; ++bj) { const size_t o = ro + bj * HALF;
                    const u32x4 g = *(const u32x4*)(G + o);
                    f32x4 r0 = acc[ai][bj][m][0] * (f32x4){bf_lo(g.x), bf_hi(g.x), bf_lo(g.y), bf_hi(g.y)};
                    f32x4 r1 = acc[ai][bj][m][1] * (f32x4){bf_lo(g.z), bf_hi(g.z), bf_lo(g.w), bf_hi(g.w)};
                    if (STEP > 0) { r0 += *(const f32x4*)(MACC + o); r1 += *(const f32x4*)(MACC + o + 4); }
                    if (STEP < 2) { *(f32x4*)(MACC + o) = r0; *(f32x4*)(MACC + o + 4) = r1; }
                    else { u32x4 w; w.x = cvt_pk_bf16(r0[0], r0[1]); w.y = cvt_pk_bf16(r0[2], r0[3]); w.z = cvt_pk_bf16(r1[0], r1[1]); w.w = cvt_pk_bf16(r1[2], r1[3]); *(u32x4*)(OUT + o) = w; } } }
    }
};

struct EpiResid {
    static constexpr bool PERM = false, AFTER_DRAIN = false;
    const float* Xin; const float* gate; float* PRE; float alpha;
    __device__ __forceinline__ void operator()(const f32x4 (&acc)[2][2][4][2], const Unit& u, int wr, int wc, int fr, int fq) const {
        const int row0 = u.pm * BM + wr * 64 + fr, col0 = u.pn * BM + wc * 32 + 4 * fq; const float* gp = gate + (size_t)(u.pm >> 3) * 12288 + col0;
        f32x4 gv[2][2];
#pragma unroll
        for (int bj = 0; bj < 2; ++bj)
#pragma unroll
            for (int n = 0; n < 2; ++n) gv[bj][n] = *(const f32x4*)(gp + bj * HALF + n * 16);
#pragma unroll
        for (int ai = 0; ai < 2; ++ai)
#pragma unroll
            for (int m = 0; m < 4; ++m) { const size_t ro = (size_t)(row0 + ai * HALF + m * 16) * 2048 + col0;
#pragma unroll
                for (int bj = 0; bj < 2; ++bj)
#pragma unroll
                    for (int n = 0; n < 2; ++n) { const size_t o = ro + bj * HALF + n * 16; const f32x4 xv = *(const f32x4*)(Xin + o);
                        *(f32x4*)(PRE + o) = xv * alpha + gv[bj][n] * acc[ai][bj][m][n]; } }
    }
};

struct EpiRelu2 {
    static constexpr bool PERM = true, AFTER_DRAIN = false;
    bf16_t* O; int ldc;
    __device__ __forceinline__ void operator()(const f32x4 (&acc)[2][2][4][2], const Unit& u, int wr, int wc, int fr, int fq) const {
        const int row0 = u.pm * BM + wr * 64 + fr, col0 = u.pn * BM + wc * 32 + 8 * fq;
#pragma unroll
        for (int ai = 0; ai < 2; ++ai)
#pragma unroll
            for (int m = 0; m < 4; ++m) { bf16_t* rowp = O + (size_t)(row0 + ai * HALF + m * 16) * ldc + col0;
#pragma unroll
                for (int bj = 0; bj < 2; ++bj) { f32x4 v0 = acc[ai][bj][m][0], v1 = acc[ai][bj][m][1];
                    v0 = __builtin_elementwise_max(v0, (f32x4){0.f, 0.f, 0.f, 0.f}); v1 = __builtin_elementwise_max(v1, (f32x4){0.f, 0.f, 0.f, 0.f}); v0 = v0 * v0; v1 = v1 * v1;
                    u32x4 w; w.x = cvt_pk_bf16(v0[0], v0[1]); w.y = cvt_pk_bf16(v0[2], v0[3]); w.z = cvt_pk_bf16(v1[0], v1[1]); w.w = cvt_pk_bf16(v1[2], v1[3]);
                    *(u32x4*)(rowp + bj * HALF) = w; } }
    }
};
}

#define GAS __attribute__((address_space(1)))
#define LAS __attribute__((address_space(3)))
typedef unsigned short bf16;
typedef unsigned v4u __attribute__((ext_vector_type(4)));
typedef float f32x4 __attribute__((ext_vector_type(4)));
typedef short bf16x8 __attribute__((ext_vector_type(8)));
typedef GAS unsigned gu32;
typedef GAS unsigned long long gu64;
#define RLX_AGENT __ATOMIC_RELAXED, __HIP_MEMORY_SCOPE_AGENT
#define LDS_WAIT() asm volatile("s_waitcnt lgkmcnt(0)" ::: "memory")
#define VM_WAIT() asm volatile("s_waitcnt vmcnt(0)" ::: "memory")
__device__ __forceinline__ unsigned long long rt() { return __builtin_amdgcn_s_memrealtime(); }
__device__ __forceinline__ unsigned f2bf(float f) { unsigned u = __builtin_bit_cast(unsigned, f); return (u + 0x7fffu + ((u >> 16) & 1u)) >> 16; }
__device__ __forceinline__ unsigned pk2(float lo, float hi) { return f2bf(lo) | (f2bf(hi) << 16); }

#define XB_TMO      128
#define XB_XCNT(j)  (256  + 64 * (j))
#define XB_XSUB(j)  (1280 + 64 * (j))
#define XB_XGEN(j)  (2304 + 64 * (j))
#define XB_TOP      3328
#define XB_TOPGEN   3392
#define XCD_BAR_WORDS 3456
#define XB_SPIN_CAP (1u << 18)

__device__ __forceinline__ unsigned xb_ld(unsigned* p)              { return __hip_atomic_load(p, __ATOMIC_RELAXED, __HIP_MEMORY_SCOPE_AGENT); }
__device__ __forceinline__ unsigned xb_add(unsigned* p, unsigned v) { return __hip_atomic_fetch_add(p, v, __ATOMIC_RELAXED, __HIP_MEMORY_SCOPE_AGENT); }
__device__ __forceinline__ unsigned xb_xcc_id() { return (unsigned)__builtin_amdgcn_s_getreg((3 << 11) | 20) & 0xFu; }
#define XB_SPIN(cond, bar) do { unsigned _sp = 0; while (cond) { __builtin_amdgcn_s_sleep(1); \
    if ((++_sp & 255u) == 0u) { if (xb_ld(&(bar)[XB_TMO])) break; if (_sp > XB_SPIN_CAP) { atomicAdd(&(bar)[XB_TMO], 1u); break; } } } } while (0)

struct XcdBarrier {
    unsigned* bar; unsigned x;
    volatile LAS unsigned* st;
};

__device__ __forceinline__ XcdBarrier xcd_barrier_post(unsigned* bar, volatile LAS unsigned* st) {
    XcdBarrier b; b.bar = bar; b.x = xb_xcc_id(); b.st = st;
    if (threadIdx.x == 0) (void)xb_add(&bar[XB_XCNT(b.x)], 1u);
    return b;
}
__device__ __forceinline__ void xcd_barrier_complete(unsigned* bar, unsigned x, unsigned& nloc, unsigned& nx) {
    const unsigned G = gridDim.x * gridDim.y * gridDim.z;
    unsigned sum, cnt, mine, sp = 0u;
    for (;;) {
        sum = 0u; cnt = 0u; mine = 0u;
#pragma unroll
        for (unsigned j = 0; j < 16; ++j) { const unsigned c = xb_ld(&bar[XB_XCNT(j)]); sum += c; cnt += (c > 0u) ? 1u : 0u; mine = (j == x) ? c : mine; }
        if (sum == G) break;
        __builtin_amdgcn_s_sleep(1);
        if ((++sp & 255u) == 0u) { if (xb_ld(&bar[XB_TMO])) break; if (sp > XB_SPIN_CAP) { atomicAdd(&bar[XB_TMO], 1u); break; } }
    }
    nloc = mine > 0u ? mine : 1u; nx = cnt > 0u ? cnt : 1u;
}

__device__ __forceinline__ void xcd_barrier(const XcdBarrier& b) {
    asm volatile("s_waitcnt vmcnt(0)" ::: "memory");
    __syncthreads();
    if (threadIdx.x == 0) {
        unsigned* bar = b.bar;
        __builtin_amdgcn_s_waitcnt(0);
        unsigned nloc = b.st[0], nx = b.st[1];
        if (nloc == 0u) { xcd_barrier_complete(bar, b.x, nloc, nx); b.st[0] = nloc; b.st[1] = nx; }
        const unsigned old = xb_add(&bar[XB_XSUB(b.x)], 1u);
        const unsigned gen = old / nloc;
        if (old + 1u == (gen + 1u) * nloc) {
            __builtin_amdgcn_fence(__ATOMIC_RELEASE, "agent");
            asm volatile("s_waitcnt vmcnt(0)" ::: "memory");
            const unsigned og = xb_add(&bar[XB_TOP], 1u);
            const unsigned tg = og / nx;
            if (og + 1u == (tg + 1u) * nx) xb_add(&bar[XB_TOPGEN], 1u);
            else XB_SPIN(xb_ld(&bar[XB_TOPGEN]) == tg, bar);
            __builtin_amdgcn_fence(__ATOMIC_ACQUIRE, "agent");
            xb_add(&bar[XB_XGEN(b.x)], 1u);
            asm volatile("s_waitcnt vmcnt(0)" ::: "memory");
        } else {
            XB_SPIN(xb_ld(&bar[XB_XGEN(b.x)]) == gen, bar);
            __builtin_amdgcn_fence(__ATOMIC_ACQUIRE, "agent");
            asm volatile("s_waitcnt vmcnt(0)" ::: "memory");
        }
    }
    __syncthreads();
}

#include <hip/hip_bf16.h>
namespace fox {
using TIN = __hip_bfloat16; using TOUT = __hip_bfloat16;
constexpr int D = 128, PITCH = 2048;
constexpr float THR = 8.f;
constexpr bool WSKIP = false;
constexpr float SCALE = 0.08838834764831845f;
constexpr int NW = 8, QBLK = 32, KVBLK = 64, QB = NW * QBLK;
constexpr int SHM_V = KVBLK * D * 2, SHM_K = KVBLK * D * 2;
constexpr int ATT_LDS_BYTES = 2 * SHM_V + 2 * SHM_K + NW * 64 * 4;


using bf16 = __hip_bfloat16;
typedef short bf16x8 __attribute__((ext_vector_type(8)));
typedef short s16x4 __attribute__((ext_vector_type(4)));
typedef float f32x16 __attribute__((ext_vector_type(16)));
typedef float f32x4 __attribute__((ext_vector_type(4)));
typedef unsigned u32x4 __attribute__((ext_vector_type(4)));
template <class A, class Bt> struct same_t { static constexpr bool v = false; };
template <class A> struct same_t<A, A> { static constexpr bool v = true; };

__device__ __forceinline__ void glds16(const void* gsrc, unsigned lds_dst) { unsigned keep;
    asm volatile("s_mov_b32 %0, m0\n\ts_mov_b32 m0, %2\n\ts_nop 0\n\tglobal_load_lds_dwordx4 %1, off\n\ts_mov_b32 m0, %0" : "=&s"(keep) : "v"(gsrc), "s"(lds_dst) : "memory"); }
#define KSWZ(row, colB) ((row) * 256 + ((colB) ^ (((row) & 7) << 4)))
#define SBAR() __builtin_amdgcn_sched_barrier(0)
__device__ __forceinline__ int v_st(int k, int c) { const int kk = (k & ~0xC) | ((k & 4) << 1) | ((k & 8) >> 1); return ((kk >> 3) * 4 + (c >> 5)) * 512 + ((kk & 7) * 32 + (c & 31)) * 2; }
__device__ __forceinline__ int v_rd_base(int lane) { return ((lane & 3) << 3) | (((lane >> 2) & 3) << 6) | (((lane >> 4) & 1) << 5) | (((lane >> 5) & 1) << 8); }
constexpr int v_rd_off(int d0, int ks, int half) { return d0 * 512 + ks * 4096 + half * 2048; }
__device__ __forceinline__ int crow(int r, int hi) { return (r & 3) + 8 * (r >> 2) + 4 * hi; }
__device__ __forceinline__ unsigned cvtpk(float lo, float hi) {
    unsigned r; asm volatile("v_cvt_pk_bf16_f32 %0, %1, %2" : "=v"(r) : "v"(lo), "v"(hi)); return r;
}
__device__ __forceinline__ bf16x8 pack8(f32x4 a, f32x4 b) {
    u32x4 w = {cvtpk(a[0], a[1]), cvtpk(a[2], a[3]), cvtpk(b[0], b[1]), cvtpk(b[2], b[3])};
    return *reinterpret_cast<bf16x8*>(&w);
}
template <class T> __device__ __forceinline__ bf16x8 load8(const T* p) {
    if constexpr (same_t<T, float>::v) { return pack8(*(const f32x4*)p, *(const f32x4*)(p + 4)); }
    else { return *reinterpret_cast<const bf16x8*>(p); }
}
__device__ __forceinline__ void mask_tile(f32x16& p0, f32x16& p1, int dq, unsigned W) {
    const float NEG = -__builtin_inff();
#pragma unroll
    for (int r = 0; r < 16; ++r) {
        const int c = (r & 3) + 8 * (r >> 2);
        if ((unsigned)(dq - c) >= W) p0[r] = NEG;
        if ((unsigned)(dq - c - 32) >= W) p1[r] = NEG;
    }
}
__device__ __forceinline__ void partialSM(f32x16& p0, f32x16& p1, float& m_reg, float& mn, float& alpha) {
    float pmax = p0[0]; for (int r = 1; r < 16; ++r) pmax = fmaxf(pmax, p0[r]); for (int r = 0; r < 16; ++r) pmax = fmaxf(pmax, p1[r]);
    { auto rr = __builtin_amdgcn_permlane32_swap(__float_as_uint(pmax), __float_as_uint(pmax), false, false);
      pmax = fmaxf(__uint_as_float(rr[0]), __uint_as_float(rr[1])); }
    constexpr float C2 = 1.4426950408889634f * SCALE;
    if (__builtin_expect(__all((pmax - m_reg) * SCALE <= THR), 1)) { mn = m_reg; alpha = 1.f; }
    else { mn = fmaxf(m_reg, pmax); alpha = __builtin_amdgcn_exp2f((m_reg - mn) * C2); m_reg = mn; }
    const float mnL = -mn * C2;
    for (int r = 0; r < 16; ++r) p0[r] = fmaf(p0[r], C2, mnL); for (int r = 0; r < 16; ++r) p1[r] = fmaf(p1[r], C2, mnL);
    for (int r = 0; r < 16; ++r) p0[r] = __builtin_amdgcn_exp2f(p0[r]);
}
__device__ __forceinline__ void finishSM(f32x16& p0, f32x16& p1, float alpha, float& l_reg, bf16x8& pa0, bf16x8& pa1, bf16x8& pa2, bf16x8& pa3) {
    for (int r = 0; r < 16; ++r) p1[r] = __builtin_amdgcn_exp2f(p1[r]);
    float ps = 0; for (int r = 0; r < 16; ++r) ps += p0[r]; for (int r = 0; r < 16; ++r) ps += p1[r];
    { auto rr = __builtin_amdgcn_permlane32_swap(__float_as_uint(ps), __float_as_uint(ps), false, false);
      ps = __uint_as_float(rr[0]) + __uint_as_float(rr[1]); }
    l_reg = l_reg * alpha + ps;
#define PK4(P, B_, OUT) do { unsigned a0 = cvtpk(P[B_+0], P[B_+1]), a1 = cvtpk(P[B_+2], P[B_+3]);                          \
        unsigned b0 = cvtpk(P[B_+4], P[B_+5]), b1 = cvtpk(P[B_+6], P[B_+7]);                                             \
        auto r0 = __builtin_amdgcn_permlane32_swap(a0, b0, false, false); auto r1 = __builtin_amdgcn_permlane32_swap(a1, b1, false, false); \
        u32x4 w = {r0[0], r1[0], r0[1], r1[1]}; OUT = *reinterpret_cast<bf16x8*>(&w); } while (0)
    PK4(p0, 0, pa0); PK4(p0, 8, pa1); PK4(p1, 0, pa2); PK4(p1, 8, pa3);
#undef PK4
}
template <int KB, bool SK>
__device__ __forceinline__ void qkt(f32x16& p0, f32x16& p1, const char* K_lds, int r32, int hi, const char* qr, bool act, const char* B_lds, int lane) {
    if (SK && !act) { const float NEG = -__builtin_inff();
#pragma unroll
        for (int r = 0; r < 16; ++r) { p0[r] = NEG; p1[r] = NEG; } return; }
    p0 = f32x16{}; p1 = f32x16{};
    const char* kb[4];
#pragma unroll
    for (int dd = 0; dd < 4; ++dd) kb[dd] = K_lds + KB * SHM_K + KSWZ(r32, (dd * 16 + hi * 8) * 2);
#pragma unroll
    for (int d0 = 0; d0 < 8; ++d0) { const char* a = kb[d0 & 3] + (d0 >> 2) * 128;
        bf16x8 b0 = *reinterpret_cast<const bf16x8*>(a);
        bf16x8 b1 = *reinterpret_cast<const bf16x8*>(a + 32 * 256);
        const bf16x8 qf = *reinterpret_cast<const bf16x8*>(qr + d0 * 1024);
        p0 = __builtin_amdgcn_mfma_f32_32x32x16_bf16(b0, qf, p0, 0, 0, 0);
        p1 = __builtin_amdgcn_mfma_f32_32x32x16_bf16(b1, qf, p1, 0, 0, 0); }
    { const unsigned o1 = hi ? 0u : 0x3F803F80u, o2 = hi ? 0u : 0x3F80u; const u32x4 qw = {o1, o2, 0u, 0u}; const bf16x8 qo = *reinterpret_cast<const bf16x8*>(&qw);
      const bf16x8 bk0 = *reinterpret_cast<const bf16x8*>(B_lds + KB * 2048 + lane * 16), bk1 = *reinterpret_cast<const bf16x8*>(B_lds + KB * 2048 + 1024 + lane * 16);
      p0 = __builtin_amdgcn_mfma_f32_32x32x16_bf16(bk0, qo, p0, 0, 0, 0);
      p1 = __builtin_amdgcn_mfma_f32_32x32x16_bf16(bk1, qo, p1, 0, 0, 0); }
}
template <int VB, bool SK>
__device__ __forceinline__ void pv_tile(f32x16* o, int vb0, bf16x8 pa0, bf16x8 pa1, bf16x8 pa2, bf16x8 pa3, bool act) {
    if (SK && !act) return;
#define TRRD(dst, off) asm volatile("ds_read_b64_tr_b16 %0, %1 offset:%2" : "=&v"(dst) : "v"(vb0), "i"(off) : "memory")
#define PV_D0(d0) do { s16x4 l0, l1, l2, l3, h0, h1, h2, h3; constexpr int b_ = VB * SHM_V + v_rd_off(d0, 0, 0);     \
        TRRD(l0, b_); TRRD(h0, b_ + 2048); TRRD(l1, b_ + 4096); TRRD(h1, b_ + 6144); TRRD(l2, b_ + 8192); TRRD(h2, b_ + 10240); TRRD(l3, b_ + 12288); TRRD(h3, b_ + 14336); \
        asm volatile("s_waitcnt lgkmcnt(0)" ::: "memory"); SBAR();                 \
        o[d0] = __builtin_amdgcn_mfma_f32_32x32x16_bf16(pa0, (bf16x8){l0[0], l0[1], l0[2], l0[3], h0[0], h0[1], h0[2], h0[3]}, o[d0], 0, 0, 0);   \
        o[d0] = __builtin_amdgcn_mfma_f32_32x32x16_bf16(pa1, (bf16x8){l1[0], l1[1], l1[2], l1[3], h1[0], h1[1], h1[2], h1[3]}, o[d0], 0, 0, 0);   \
        o[d0] = __builtin_amdgcn_mfma_f32_32x32x16_bf16(pa2, (bf16x8){l2[0], l2[1], l2[2], l2[3], h2[0], h2[1], h2[2], h2[3]}, o[d0], 0, 0, 0);   \
        o[d0] = __builtin_amdgcn_mfma_f32_32x32x16_bf16(pa3, (bf16x8){l3[0], l3[1], l3[2], l3[3], h3[0], h3[1], h3[2], h3[3]}, o[d0], 0, 0, 0); } while (0)
    PV_D0(0); PV_D0(1); PV_D0(2); PV_D0(3);
#undef PV_D0
#undef TRRD
}

template <class TIn, class TOut> struct BlockRef { const TIn* Q; const TIn* K; const TIn* V; TOut* O; const char* FK; const char* Z16; int P0; };
template <class TIn> struct Seam {
    bf16x8 st_v0, st_v1, st_k0, st_k1; f32x4 sf0, sf1, sf2, sf3;
    f32x4 tq[16];
};
__device__ __forceinline__ int swa_jlo(int P0, int W) { const int lowk = P0 - W + 1; return lowk > 0 ? lowk / KVBLK : 0; }
#define ROW(p, k0, rr) ((p) + (size_t)((k0) + (rr)) * PITCH + sc)
#define VMW() asm volatile("s_waitcnt vmcnt(0)" ::: "memory")
#define VMWN(n) asm volatile("s_waitcnt vmcnt(%0)" :: "i"(n) : "memory")
#define SLOAD_H(Kp, Vp, k0) do { S.st_v0 = load8<TIn>(ROW(Vp, k0, sr)); S.st_v1 = load8<TIn>(ROW(Vp, k0, 32 + sr));              \
                         S.st_k0 = load8<TIn>(ROW(Kp, k0, sr)); S.st_k1 = load8<TIn>(ROW(Kp, k0, 32 + sr)); } while (0)
#define LOADB(ref, k0, bf) do { if (wid == 0) { const char* g0_ = hi ? (ref).Z16 : (ref).FK + (size_t)((k0) + r32) * 16; const char* g1_ = hi ? (ref).Z16 : (ref).FK + (size_t)((k0) + 32 + r32) * 16; \
        const unsigned l0_ = (unsigned)(uintptr_t)B_lds + (bf) * 2048; glds16(g0_, l0_); glds16(g1_, l0_ + 1024); } } while (0)
#define SWRITE_HK(bf) do { *(bf16x8*)(K_lds + (bf) * SHM_K + kws) = S.st_k0; *(bf16x8*)(K_lds + (bf) * SHM_K + kws + 32 * 256) = S.st_k1; } while (0)
#define SWRITE_HV(bf) do { *(bf16x8*)(V_lds + (bf) * SHM_V + vst0) = S.st_v0; *(bf16x8*)(V_lds + (bf) * SHM_V + vst1) = S.st_v1; } while (0)
#define SWRITE_H(bf) do { SWRITE_HV(bf); SWRITE_HK(bf); } while (0)
#define SLOAD_F(p, k0) do { S.sf0 = *(const f32x4*)ROW(p, k0, sr); S.sf1 = *(const f32x4*)(ROW(p, k0, sr) + 4);                \
                            S.sf2 = *(const f32x4*)ROW(p, k0, 32 + sr); S.sf3 = *(const f32x4*)(ROW(p, k0, 32 + sr) + 4); } while (0)
#define SWRITE_KF(bf) do { *(bf16x8*)(K_lds + (bf) * SHM_K + kws) = pack8(S.sf0, S.sf1); *(bf16x8*)(K_lds + (bf) * SHM_K + kws + 32 * 256) = pack8(S.sf2, S.sf3); } while (0)
#define SWRITE_VF(bf) do { *(bf16x8*)(V_lds + (bf) * SHM_V + vst0) = pack8(S.sf0, S.sf1); *(bf16x8*)(V_lds + (bf) * SHM_V + vst1) = pack8(S.sf2, S.sf3); } while (0)
template <class TIn, class TOut>
__device__ __forceinline__ void causal_swa_prime(const BlockRef<TIn, TOut>& cur, int W, char* lds, Seam<TIn>& S) {
    constexpr bool F32 = same_t<TIn, float>::v;
    int tid_l = threadIdx.x; asm volatile("" : "+v"(tid_l));
    const int tid = tid_l, wid = __builtin_amdgcn_readfirstlane(tid >> 6), lane = tid & 63, r32 = lane & 31, hi = lane >> 5;
    const int sr = tid >> 4, sc = (tid & 15) * 8, kws = KSWZ(sr, sc * 2); char* K_lds = lds + 2 * SHM_V; char* B_lds = lds + ATT_LDS_BYTES;
    const int kb0 = swa_jlo(cur.P0, W) * KVBLK;
    for (int d0 = 0; d0 < 8; ++d0) glds16(cur.Q + (size_t)(wid * QBLK + r32) * PITCH + d0 * 16 + hi * 8, (unsigned)(uintptr_t)(lds + ATT_LDS_BYTES + 4096) + wid * 8192 + d0 * 1024);
    LOADB(cur, kb0, 0);
    if constexpr (F32) { SLOAD_F((const float*)cur.K, kb0); VMW(); SWRITE_KF(0); SBAR(); SLOAD_F((const float*)cur.V, kb0); }
    else { SLOAD_H(cur.K, cur.V, kb0); VMW(); SWRITE_HK(0); }
    __syncthreads();
}
template <class TIn, class TOut>
__device__ __forceinline__ void causal_swa_block(const BlockRef<TIn, TOut>& cur, const BlockRef<TIn, TOut>& nxt, int skv, int W, char* lds, Seam<TIn>& S) {
    constexpr bool F32 = same_t<TIn, float>::v;
    int tid_l = threadIdx.x; asm volatile("" : "+v"(tid_l));
    const int tid = tid_l, wid = __builtin_amdgcn_readfirstlane(tid >> 6), lane = tid & 63, r32 = lane & 31, hi = lane >> 5;
    const int j_lo = swa_jlo(cur.P0, W);
    int j_hi = (cur.P0 + QB - 1) / KVBLK + 1; if (j_hi > skv / KVBLK) j_hi = skv / KVBLK;
    const int NT = j_hi - j_lo;
    const int kbn = swa_jlo(nxt.P0, W) * KVBLK;
    const int qlo = cur.P0 + wid * QBLK, qm = qlo + r32 - 4 * hi;
    char* V_lds = lds; char* K_lds = lds + 2 * SHM_V; const char* Qw = lds + ATT_LDS_BYTES + 4096 + wid * 8192 + lane * 16;
    char* B_lds = lds + ATT_LDS_BYTES;
    float* ws = (float*)(lds + 2 * SHM_V + 2 * SHM_K) + wid * 64; float* li_l = ws, * al_l = ws + 32;
    float m_reg = -1e30f, l_reg = 0; f32x16 o[4] = {};
    const int sr = tid >> 4, sc = (tid & 15) * 8, vst0 = v_st(sr, sc), vst1 = v_st(32 + sr, sc), kws = KSWZ(sr, sc * 2);
    const int vb0 = (int)(uintptr_t)V_lds + v_rd_base(lane);
    const TIn* Kh = cur.K; const TIn* Vh = cur.V;
#define RESC(a) do { if (__any((a) < 1.f)) { if (hi == 0) al_l[r32] = (a); asm volatile("s_waitcnt lgkmcnt(0)" ::: "memory");              \
                     for (int d_ = 0; d_ < 4; ++d_) for (int r = 0; r < 16; ++r) o[d_][r] *= al_l[crow(r, hi)]; } } while (0)
#define KBASE(t) ((j_lo + (t)) * KVBLK)
#define ACT(t) (KBASE(t) <= qlo + QBLK - 1 && KBASE(t) + KVBLK - 1 >= qlo - W + 1)
#define MASKT(P0_, P1_, t) do { const int kb_ = KBASE(t); if ((!SK || ACT(t)) && (kb_ + KVBLK - 1 > qlo || kb_ <= qlo + QBLK - 1 - W)) mask_tile(P0_, P1_, qm - kb_, (unsigned)W); } while (0)
    constexpr int NQL = F32 ? 16 : 8;
    constexpr bool SK = WSKIP && !F32;
#define SEAM_K0() do { VMWN(NQL); if constexpr (F32) { SWRITE_KF(0); SBAR(); SLOAD_F((const float*)nxt.V, kbn); } else { SWRITE_HK(0); } SBAR(); } while (0)
    f32x16 pA0, pA1, pB0, pB1; float mnA, mnB, alA, alB; bf16x8 pa0, pa1, pa2, pa3;
    if constexpr (F32) { VMW(); SWRITE_VF(0); SBAR(); } else { VMW(); SWRITE_HV(0); SBAR(); }
    if (NT > 1) { if constexpr (F32) SLOAD_F((const float*)Kh, KBASE(1)); else SLOAD_H(Kh, Vh, KBASE(1)); }
    SBAR(); qkt<0, SK>(pA0, pA1, K_lds, r32, hi, Qw, ACT(0), B_lds, lane); if (NT > 1) LOADB(cur, KBASE(1), 1);
    if constexpr (F32) { if (NT > 1) { VMW(); SWRITE_KF(1); SBAR(); SLOAD_F((const float*)Vh, KBASE(1)); } }
    MASKT(pA0, pA1, 0); partialSM(pA0, pA1, m_reg, mnA, alA);
    if (NT > 1) { VMW(); if constexpr (F32) { SWRITE_VF(1); SBAR(); if (NT > 2) SLOAD_F((const float*)Kh, KBASE(2)); } else SWRITE_H(1); }
    __syncthreads();
#define HALF_STEP(PX0, PX1, mnX, alX, PY0, PY1, alY, t, KB, VB, SB) do {                                                      \
        SBAR(); qkt<KB, SK>(PX0, PX1, K_lds, r32, hi, Qw, ACT(t), B_lds, lane);                                   \
        finishSM(PY0, PY1, alY, l_reg, pa0, pa1, pa2, pa3); SBAR();                                                           \
        if ((t) + 1 < NT) { if constexpr (F32) { VMW(); SWRITE_KF(SB); SBAR(); SLOAD_F((const float*)Vh, KBASE((t) + 1)); }  \
                            else { SLOAD_H(Kh, Vh, KBASE((t) + 1)); LOADB(cur, KBASE((t) + 1), SB); } SBAR(); }              \
        pv_tile<VB, SK>(o, vb0, pa0, pa1, pa2, pa3, ACT((t) - 1)); MASKT(PX0, PX1, (t)); partialSM(PX0, PX1, m_reg, mnX, alX);                                        \
        __syncthreads();                                                                                                      \
        if ((t) + 1 < NT) { VMW(); if constexpr (F32) { SWRITE_VF(SB); SBAR(); if ((t) + 2 < NT) SLOAD_F((const float*)Kh, KBASE((t) + 2)); } \
                            else { SWRITE_H(SB); } }                                                                          \
        RESC(alX); __syncthreads(); } while (0)
    for (int t = 1; t + 1 < NT; t += 2) {
        HALF_STEP(pB0, pB1, mnB, alB, pA0, pA1, alA, t, 1, 0, 0);
        HALF_STEP(pA0, pA1, mnA, alA, pB0, pB1, alB, t + 1, 0, 1, 1);
    }
    const bool even = (NT & 1) == 0;
    if (even) { SBAR(); qkt<1, SK>(pB0, pB1, K_lds, r32, hi, Qw, ACT(NT - 1), B_lds, lane); SBAR(); }
#define QROW(e) (nxt.Q + (size_t)(wid * QBLK + r32) * PITCH + ((e) >> 1) * 16 + hi * 8 + ((e) & 1) * 4)
    if constexpr (F32) { SLOAD_F((const float*)nxt.K, kbn); SBAR();
#pragma unroll
        for (int e = 0; e < 8; ++e) S.tq[e] = *(const f32x4*)QROW(e); }
    else { SLOAD_H(nxt.K, nxt.V, kbn); LOADB(nxt, kbn, 0); SBAR();
#pragma unroll
        for (int d0 = 0; d0 < 8; ++d0) glds16(nxt.Q + (size_t)(wid * QBLK + r32) * PITCH + d0 * 16 + hi * 8, (unsigned)(uintptr_t)(lds + ATT_LDS_BYTES + 4096) + wid * 8192 + d0 * 1024); }
    SBAR();
    finishSM(pA0, pA1, alA, l_reg, pa0, pa1, pa2, pa3); SBAR();
    if constexpr (F32) {
#pragma unroll
        for (int e = 8; e < 16; ++e) S.tq[e] = *(const f32x4*)QROW(e); SBAR(); }
#undef QROW
    pv_tile<0, SK>(o, vb0, pa0, pa1, pa2, pa3, ACT(even ? NT - 2 : NT - 1));
    if (even) { MASKT(pB0, pB1, NT - 1); partialSM(pB0, pB1, m_reg, mnB, alB); __syncthreads(); RESC(alB);
        finishSM(pB0, pB1, alB, l_reg, pa0, pa1, pa2, pa3); SBAR(); pv_tile<1, SK>(o, vb0, pa0, pa1, pa2, pa3, ACT(NT - 1)); }
    SBAR(); SEAM_K0();
    if (hi == 0) li_l[r32] = l_reg; asm volatile("s_waitcnt lgkmcnt(0)" ::: "memory");
    float rli[16];
#pragma unroll
    for (int r = 0; r < 16; ++r) rli[r] = __builtin_amdgcn_rcpf(li_l[crow(r, hi)]);
    TOut* Ow = cur.O + (size_t)(wid * QBLK) * PITCH;
#pragma unroll
    for (int r = 0; r < 16; ++r) { const int orow = crow(r, hi);
#pragma unroll
        for (int d0 = 0; d0 < 4; ++d0) { const float v = o[d0][r] * rli[r];
            if constexpr (same_t<TOut, float>::v) { Ow[(size_t)orow * PITCH + d0 * 32 + r32] = v; }
            else { const float vn = __shfl_xor(v, 1);
                   if ((r32 & 1) == 0) *(unsigned*)(Ow + (size_t)orow * PITCH + d0 * 32 + r32) = cvtpk(v, vn); } } }
    __syncthreads();
#undef RESC
#undef KBASE
#undef ACT
#undef MASKT
#undef SEAM_K0
#undef HALF_STEP
}
#undef ROW
#undef VMW
#undef VMWN
#undef SLOAD_H
#undef SWRITE_HK
#undef SWRITE_HV
#undef SWRITE_H
#undef SLOAD_F
#undef SWRITE_KF
#undef SWRITE_VF

#undef LOADB
}

constexpr int NWAVES = 8, NT = NWAVES * 64;
constexpr int BATCH = 4, SEQ = 2048, D = 2048, M = BATCH * SEQ, FF = 8192, DEPTH = 2;
constexpr int INW = 26704, NPAD = 26880;
constexpr int MODW = 6 * D;
constexpr float LN_EPS = 1e-5f, NORM_EPS = 1e-6f, ALPHA = 1.4142135623730951f;
constexpr size_t MiB = 1u << 20;
constexpr size_t ACT_E = (size_t)M * D;
constexpr size_t WS_CTL = 0, CTL_ZERO_BYTES = 1 * MiB;
constexpr size_t WS_MODP = 2 * MiB;
constexpr size_t WS_MOD = 8 * MiB;
constexpr size_t WS_SMALL = 10 * MiB;
constexpr size_t WS_CUM = 18 * MiB;
constexpr size_t WS_BETA = 19 * MiB, WS_GG = 20 * MiB;
constexpr size_t WS_FKB = 21 * MiB;
constexpr size_t WS_W = 32 * MiB;
constexpr size_t W_LAYER = 201 * MiB, W_IN = 0, W_A = 105 * MiB, W_B = 113 * MiB, W_C = 121 * MiB, W_O = 129 * MiB, W_1 = 137 * MiB, W_2 = 169 * MiB;
constexpr size_t WS_U = 448 * MiB;
constexpr size_t WS_X = 480 * MiB;
constexpr size_t WS_PRE = 544 * MiB;
constexpr size_t WS_T = 608 * MiB;
constexpr size_t WS_H = 608 * MiB;
constexpr size_t WS_YA = 1024 * MiB, WS_YB = 1056 * MiB, WS_YC = 1088 * MiB, WS_MG = 1120 * MiB;
constexpr size_t WS_MACC = 1152 * MiB;
constexpr size_t WS_QNB = 1216 * MiB, WS_KNB = 1248 * MiB;
constexpr size_t WS_KTP = 1280 * MiB;
constexpr size_t WS_VTP = 1312 * MiB;
constexpr size_t WS_TP = 1344 * MiB, WS_IP = 1376 * MiB;
constexpr size_t WS_ORAW = 1408 * MiB;
constexpr size_t WS_GCUM = 24 * MiB;
constexpr size_t WS_END = 1472 * MiB;
constexpr int CW_BAR = 4096;
constexpr int LDS_BYTES = 147456, MISC_OFF = LDS_BYTES - 512;
enum { TI_CB = 0, TI_CC, TI_CH, TI_GQ, TI_GK, TI_GV, TI_GZ, TI_FQ, TI_FK, TI_FV, TI_MA, TI_MB, TI_MC };
__host__ __device__ constexpr int src_off(int t) { return t < 7 ? 2048 * t : (t < 10 ? 14400 + 2048 * (t - 7) : 20560 + 2048 * (t - 10)); }
constexpr int SRC_GB = 14336, SRC_FF = 20544;
enum { I_X = 0, I_C, I_WADA, I_BADA, I_WIN, I_CONVW, I_GCONVW, I_ALOG, I_DTB, I_GNORMW, I_FBIAS, I_WA, I_WB, I_WC, I_WO, I_LN1G, I_LN1B, I_W1, I_W2, I_LN2G, I_LN2B, N_IN };

typedef unsigned u32x4 __attribute__((ext_vector_type(4)));
typedef unsigned u32x2 __attribute__((ext_vector_type(2)));
__device__ __forceinline__ float wave_sum(float v) {
#pragma unroll
    for (int o = 1; o < 64; o <<= 1) v += __shfl_xor(v, o);
    return v;
}
__device__ __forceinline__ float wave_max(float v) {
#pragma unroll
    for (int o = 1; o < 64; o <<= 1) v = fmaxf(v, __shfl_xor(v, o));
    return v;
}
__device__ __forceinline__ float bflo(unsigned w) { return __builtin_bit_cast(float, w << 16); }
__device__ __forceinline__ float bfhi(unsigned w) { return __builtin_bit_cast(float, w & 0xffff0000u); }
__device__ __forceinline__ void unpack8(const u32x4 w, float (&f)[8]) { f[0] = bflo(w.x); f[1] = bfhi(w.x); f[2] = bflo(w.y); f[3] = bfhi(w.y); f[4] = bflo(w.z); f[5] = bfhi(w.z); f[6] = bflo(w.w); f[7] = bfhi(w.w); }
__device__ __forceinline__ u32x4 pack8(const float (&f)[8]) { u32x4 w; w.x = pg8::cvt_pk_bf16(f[0], f[1]); w.y = pg8::cvt_pk_bf16(f[2], f[3]); w.z = pg8::cvt_pk_bf16(f[4], f[5]); w.w = pg8::cvt_pk_bf16(f[6], f[7]); return w; }
__device__ __forceinline__ float fsilu(float x) { return x / (1.f + __expf(-x)); }

__device__ __forceinline__ void tr_item(const float* __restrict__ W, size_t ldw, bf16* __restrict__ WT, size_t K, int kb, int nb, int lane) {
    const int kq = lane & 7, nq = lane >> 3;
    const float* src = W + (size_t)(kb * 64 + kq * 8) * ldw + nb * 32 + nq * 4;
    f32x4 v[8];
#pragma unroll
    for (int i = 0; i < 8; ++i) v[i] = *(const f32x4*)(src + (size_t)i * ldw);
    bf16* dst = WT + (size_t)(nb * 32 + nq * 4) * K + kb * 64 + kq * 8;
#pragma unroll
    for (int j = 0; j < 4; ++j) { u32x4 o; o.x = pg8::cvt_pk_bf16(v[0][j], v[1][j]); o.y = pg8::cvt_pk_bf16(v[2][j], v[3][j]); o.z = pg8::cvt_pk_bf16(v[4][j], v[5][j]); o.w = pg8::cvt_pk_bf16(v[6][j], v[7][j]);
        *(u32x4*)(dst + (size_t)j * K) = o; }
}

__device__ __forceinline__ void modulate_row(const float* __restrict__ xr, bf16* __restrict__ ur, const float* __restrict__ shift, const float* __restrict__ scale, int lane) {
#pragma unroll
    for (int j = 0; j < 8; ++j) { const int c = 4 * lane + 256 * j; const f32x4 v = *(const f32x4*)(xr + c), sc = *(const f32x4*)(scale + c), sh = *(const f32x4*)(shift + c);
        const f32x4 y = v * (sc + 1.f) + sh; u32x2 o; o.x = pg8::cvt_pk_bf16(y[0], y[1]); o.y = pg8::cvt_pk_bf16(y[2], y[3]); *(u32x2*)(ur + c) = o; }
}
__device__ __forceinline__ void ln_mod_row(const float* __restrict__ pre, const float* __restrict__ g, const float* __restrict__ bt, float* __restrict__ xo, bf16* __restrict__ uo,
                                           const float* __restrict__ shift, const float* __restrict__ scale, int lane) {
    f32x4 v[8]; float s = 0.f;
#pragma unroll
    for (int j = 0; j < 8; ++j) { v[j] = *(const f32x4*)(pre + 4 * lane + 256 * j); s += (v[j][0] + v[j][1]) + (v[j][2] + v[j][3]); }
    const float mean = wave_sum(s) * (1.f / D); float s2 = 0.f;
#pragma unroll
    for (int j = 0; j < 8; ++j) { v[j] = v[j] - mean; s2 += (v[j][0] * v[j][0] + v[j][1] * v[j][1]) + (v[j][2] * v[j][2] + v[j][3] * v[j][3]); }
    const float rstd = 1.f / sqrtf(wave_sum(s2) * (1.f / D) + LN_EPS);
#pragma unroll
    for (int j = 0; j < 8; ++j) { const int c = 4 * lane + 256 * j; const f32x4 y = v[j] * rstd * *(const f32x4*)(g + c) + *(const f32x4*)(bt + c);
        *(f32x4*)(xo + c) = y;
        if (uo) { const f32x4 u = y * (*(const f32x4*)(scale + c) + 1.f) + *(const f32x4*)(shift + c); u32x2 o; o.x = pg8::cvt_pk_bf16(u[0], u[1]); o.y = pg8::cvt_pk_bf16(u[2], u[3]); *(u32x2*)(uo + c) = o; } }
}

struct Args { const float* in[N_IN]; float* out; unsigned char* ws; int ph_lo, ph_hi; };
constexpr int NPL = 11, NPH = 3 + DEPTH * NPL;

__global__ void __launch_bounds__(NT, 2) fwd_kernel(Args args) {
    extern __shared__ __attribute__((aligned(16))) unsigned char lds_raw[];
    LAS unsigned char* lds = (LAS unsigned char*)lds_raw;
    const int G = gridDim.x, blk = blockIdx.x, NGW = G * NWAVES, NGT = G * NT;
    volatile LAS unsigned* MISC = (volatile LAS unsigned*)(lds + MISC_OFF);
    if (threadIdx.x < 128) ((LAS unsigned*)(lds + MISC_OFF))[threadIdx.x] = 0u;
    __syncthreads();
    XcdBarrier bar = xcd_barrier_post((unsigned*)((gu32*)(args.ws + WS_CTL) + CW_BAR), MISC + 8);
    const int lo = args.ph_lo, hi = args.ph_hi;
#define IN(k) (lo <= (k) && (k) < hi)
#define SEAM(k) do { if (IN(k) && IN((k) + 1)) xcd_barrier(bar); } while (0)
#define CAS __attribute__((address_space(4)))
#define AIN(i) ((const float*)(GAS const float*)ap->in[i])
#define PH_BEGIN \
    int tid = threadIdx.x; asm volatile("" : "+v"(tid)); const int lane = tid & 63, wave = __builtin_amdgcn_readfirstlane(tid >> 6); \
    const int gw = blk * NWAVES + wave, gtid = blk * NT + tid; (void)gw; (void)gtid; (void)lane; \
    const CAS Args* ap = (const CAS Args*)__builtin_amdgcn_kernarg_segment_ptr(); asm volatile("" : "+s"(ap));     \
    GAS unsigned char* ws_g = (GAS unsigned char*)ap->ws; asm volatile("" : "+s"(ws_g)); unsigned char* ws = (unsigned char*)ws_g;     \
    const float* x_in = AIN(I_X); (void)x_in; \
    float* modp = (float*)(ws + WS_MODP); float* mod = (float*)(ws + WS_MOD); float* SMALL = (float*)(ws + WS_SMALL); (void)modp; (void)mod; (void)SMALL; \
    float* CUM = (float*)(ws + WS_CUM); float* BETA = (float*)(ws + WS_BETA); float* GG = (float*)(ws + WS_GG); (void)CUM; (void)BETA; (void)GG; \
    bf16* U = (bf16*)(ws + WS_U); float* X = (float*)(ws + WS_X); float* PRE = (float*)(ws + WS_PRE); (void)U; (void)X; (void)PRE; \
    bf16* T = (bf16*)(ws + WS_T); bf16* H = (bf16*)(ws + WS_H); (void)T; (void)H; \
    bf16* YA = (bf16*)(ws + WS_YA); bf16* YB = (bf16*)(ws + WS_YB); bf16* YC = (bf16*)(ws + WS_YC); bf16* MG = (bf16*)(ws + WS_MG); (void)YA; (void)YB; (void)YC; (void)MG; \
    float* MACC = (float*)(ws + WS_MACC); bf16* QNB = (bf16*)(ws + WS_QNB); bf16* KNB = (bf16*)(ws + WS_KNB); bf16* KTP = (bf16*)(ws + WS_KTP); bf16* VTP = (bf16*)(ws + WS_VTP); \
    bf16* TP = (bf16*)(ws + WS_TP); bf16* IP = (bf16*)(ws + WS_IP); float* ORAW = (float*)(ws + WS_ORAW); float* GCUM = (float*)(ws + WS_GCUM); \
    (void)MACC; (void)QNB; (void)KNB; (void)KTP; (void)VTP; (void)TP; (void)IP; (void)ORAW; (void)GCUM;

    if (IN(0)) { PH_BEGIN
        LAS f32x4* ca = (LAS f32x4*)lds;
        const float* c = AIN(I_C);
        for (int k = tid; k < D; k += NT) { f32x4 v; for (int b = 0; b < 4; ++b) { const float cv = c[b * D + k]; v[b] = cv / (1.f + expf(-cv)); } ca[k] = v; }
        __syncthreads();
        const float* w_ada = AIN(I_WADA);
        for (int it = gw; it < 1536; it += NGW) {
            const int l = it / 768, r = it % 768, jblk = r >> 4, kc = r & 15;
            const float* W = w_ada + ((size_t)(l * D + kc * 128)) * MODW + jblk * 256 + lane * 4;
            f32x4 a0 = {0.f, 0.f, 0.f, 0.f}, a1 = a0, a2 = a0, a3 = a0;
#pragma unroll 8
            for (int k = 0; k < 128; ++k) { const f32x4 w = *(const f32x4*)(W + (size_t)k * MODW); const f32x4 cv = ca[kc * 128 + k]; a0 += w * cv[0]; a1 += w * cv[1]; a2 += w * cv[2]; a3 += w * cv[3]; }
            float* P = modp + ((size_t)((l * 16 + kc) * 4)) * MODW + jblk * 256 + lane * 4;
            *(f32x4*)(P) = a0; *(f32x4*)(P + MODW) = a1; *(f32x4*)(P + 2 * MODW) = a2; *(f32x4*)(P + 3 * MODW) = a3;
        }
    }
    SEAM(0);
    if (IN(1)) { PH_BEGIN
        const float* b_ada = AIN(I_BADA);
        for (int i = gtid; i < DEPTH * 4 * MODW; i += NGT) { const int l = i / (4 * MODW), r = i % (4 * MODW), b = r / MODW, j = r % MODW; float s = b_ada[l * MODW + j];
            for (int kc = 0; kc < 16; ++kc) s += modp[((size_t)((l * 16 + kc) * 4 + b)) * MODW + j];
            mod[i] = s; }
        constexpr int I_IN = 13 * 32 * 64, I_TAIL = 96, I_SQ = 4 * 32 * 64, I_F1 = 32 * 256, I_F2 = 128 * 64, I_L = I_IN + I_TAIL + I_SQ + I_F1 + I_F2;
        for (int it = gw; it < DEPTH * I_L; it += NGW) {
            const int l = it / I_L; int r = it % I_L; unsigned char* wl = ws + WS_W + (size_t)l * W_LAYER;
            if (r < I_IN) { const int t = r >> 11, q = r & 2047; tr_item(AIN(I_WIN) + (size_t)l * D * INW + src_off(t), INW, (bf16*)(wl + W_IN) + (size_t)t * D * D, D, q >> 6, q & 63, lane); continue; } r -= I_IN;
            if (r < I_TAIL) { const int nb = r >> 5, kb = r & 31; tr_item(AIN(I_WIN) + (size_t)l * D * INW + (nb < 2 ? SRC_GB + 32 * nb : SRC_FF), INW, (bf16*)(wl + W_IN) + (size_t)(13 * D + 32 * nb) * D, D, kb, 0, lane); continue; } r -= I_TAIL;
            if (r < I_SQ) { const int t = r >> 11, q = r & 2047; tr_item((t == 0 ? AIN(I_WA) : t == 1 ? AIN(I_WB) : t == 2 ? AIN(I_WC) : AIN(I_WO)) + (size_t)l * D * D, D, (bf16*)(wl + W_A + (size_t)t * 8 * MiB), D, q >> 6, q & 63, lane); continue; } r -= I_SQ;
            if (r < I_F1) { tr_item(AIN(I_W1) + (size_t)l * D * FF, FF, (bf16*)(wl + W_1), D, r >> 8, r & 255, lane); continue; } r -= I_F1;
            tr_item(AIN(I_W2) + (size_t)l * FF * D, D, (bf16*)(wl + W_2), FF, r >> 6, r & 63, lane);
        }
        for (int i = gtid; i < DEPTH * 160 * (D / 8); i += NGT) { const int l = i / (160 * 256), r = i % (160 * 256); bf16* p = (bf16*)(ws + WS_W + (size_t)l * W_LAYER + W_IN) + (size_t)(13 * D + 96 + (r >> 8)) * D + (r & 255) * 8;
            *(u32x4*)p = (u32x4){0u, 0u, 0u, 0u}; }
    }
    SEAM(1);
    if (IN(2)) { PH_BEGIN
        for (int m = gw; m < M; m += NGW) { const float* mb = mod + (size_t)(m >> 11) * MODW; modulate_row(x_in + (size_t)m * D, U + (size_t)m * D, mb, mb + D, lane); }
    }
    SEAM(2);

    for (int l = 0; l < DEPTH; ++l) {
        const int pb = 3 + l * NPL;
#define LAYER_PTRS unsigned char* wl = ws + WS_W + (size_t)l * W_LAYER; const float* modl = mod + (size_t)l * 4 * MODW; const float* Xin = (l == 0) ? x_in : X; (void)wl; (void)modl; (void)Xin;
        if (IN(pb + 0)) { PH_BEGIN LAYER_PTRS
            pg8::Gemm g{U, (const bf16*)(wl + W_IN), M, NPAD, D}; pg8::StaticOrder S; S.init(M, NPAD, G, blk);
            pg8::EpiInProj E{T, SMALL, ACT_E};
            pg8::gemm_phase<pg8::EpiInProj, pg8::StaticOrder, true, true>(lds, g, S, E);
        }
        SEAM(pb + 0);
        if (IN(pb + 1)) { PH_BEGIN LAYER_PTRS
            { const float* cw = AIN(I_CONVW) + (size_t)l * 3 * D; const bf16 *CB = T + TI_CB * ACT_E, *CC = T + TI_CC * ACT_E, *CH = T + TI_CH * ACT_E;
              for (int it = gtid; it < (M / 8) * 256; it += NGT) {
                const int col = (it & 255) * 8, m0 = (it >> 8) * 8; const bool first = (m0 & (SEQ - 1)) == 0;
                float w0[8], w1[8], w2[8], p2[8], p1[8];
#pragma unroll
                for (int i = 0; i < 8; ++i) { w0[i] = cw[col + i]; w1[i] = cw[D + col + i]; w2[i] = cw[2 * D + col + i]; p2[i] = 0.f; p1[i] = 0.f; }
                if (!first) { float a[8], b[8];
                    unpack8(*(const u32x4*)(CC + (size_t)(m0 - 2) * D + col), a); unpack8(*(const u32x4*)(CH + (size_t)(m0 - 2) * D + col), b);
#pragma unroll
                    for (int i = 0; i < 8; ++i) p2[i] = a[i] * b[i];
                    unpack8(*(const u32x4*)(CC + (size_t)(m0 - 1) * D + col), a); unpack8(*(const u32x4*)(CH + (size_t)(m0 - 1) * D + col), b);
#pragma unroll
                    for (int i = 0; i < 8; ++i) p1[i] = a[i] * b[i]; }
                for (int r = 0; r < 8; ++r) { const size_t o = (size_t)(m0 + r) * D + col; float a[8], b[8], g[8], y[8];
                    unpack8(*(const u32x4*)(CC + o), a); unpack8(*(const u32x4*)(CH + o), b); unpack8(*(const u32x4*)(CB + o), g);
#pragma unroll
                    for (int i = 0; i < 8; ++i) { const float p0 = a[i] * b[i]; y[i] = g[i] * (w0[i] * p2[i] + w1[i] * p1[i] + w2[i] * p0); p2[i] = p1[i]; p1[i] = p0; }
                    *(u32x4*)(YA + o) = pack8(y); }
              } }
            { const float* gcw = AIN(I_GCONVW) + (size_t)l * 4 * 6144;
              for (int it = gw; it < 6144; it += NGW) {
                const int cgp = it & 3, ten = (it >> 2) % 3, rb = it / 12; const int ch = cgp * 512 + lane * 8; const int m0 = rb * 16; const bool first = (m0 & (SEQ - 1)) == 0;
                const bf16* src = T + (size_t)(TI_GQ + ten) * ACT_E; bf16* dst = (ten == 0) ? QNB : KNB;
                const int bb = m0 >> 11, nn = (m0 & (SEQ - 1)) >> 6; bf16* tdst = (ten == 1) ? KTP + ((size_t)((bb * 32 + nn) * 16) * 128 + ch) * 64 : VTP + ((size_t)((bb * 32 + nn) * 32) * 64 + ch) * 64;
                float w[4][8], h3[8], h2[8], h1[8], yb[3][8];
#pragma unroll
                for (int i = 0; i < 8; ++i) { w[0][i] = gcw[ten * D + ch + i]; w[1][i] = gcw[6144 + ten * D + ch + i]; w[2][i] = gcw[2 * 6144 + ten * D + ch + i]; w[3][i] = gcw[3 * 6144 + ten * D + ch + i]; h3[i] = 0.f; h2[i] = 0.f; h1[i] = 0.f; }
                if (!first) { unpack8(*(const u32x4*)(src + (size_t)(m0 - 3) * D + ch), h3); unpack8(*(const u32x4*)(src + (size_t)(m0 - 2) * D + ch), h2); unpack8(*(const u32x4*)(src + (size_t)(m0 - 1) * D + ch), h1); }
#pragma unroll
                for (int r = 0; r < 16; ++r) { const size_t o = (size_t)(m0 + r) * D + ch; float h0[8], y[8]; unpack8(*(const u32x4*)(src + o), h0); float ss = 0.f;
#pragma unroll
                    for (int i = 0; i < 8; ++i) { const float a = w[0][i] * h3[i] + w[1][i] * h2[i] + w[2][i] * h1[i] + w[3][i] * h0[i]; y[i] = a / (1.f + expf(-a)); ss += y[i] * y[i]; h3[i] = h2[i]; h2[i] = h1[i]; h1[i] = h0[i]; }
                    if (ten < 2) { ss += __shfl_xor(ss, 1); ss += __shfl_xor(ss, 2); ss += __shfl_xor(ss, 4); ss += __shfl_xor(ss, 8); const float rn = 1.f / sqrtf(ss + NORM_EPS);
#pragma unroll
                        for (int i = 0; i < 8; ++i) y[i] *= rn;
                        *(u32x4*)(dst + o) = pack8(y); }
                    if (ten >= 1) {
                        if ((r & 3) < 3) {
#pragma unroll
                            for (int i = 0; i < 8; ++i) yb[r & 3][i] = y[i];
                        } else {
                            const int pos4 = ((m0 & 63) + r - 3), pp = (pos4 & 32) + 8 * ((pos4 >> 2) & 3) + 4 * ((pos4 >> 4) & 1);
#pragma unroll
                            for (int i = 0; i < 8; ++i) { u32x2 v; v.x = pg8::cvt_pk_bf16(yb[0][i], yb[1][i]); v.y = pg8::cvt_pk_bf16(yb[2][i], y[i]); *(u32x2*)(tdst + (size_t)i * 64 + pp) = v; }
                        } } }
              } }
            { const float* alog = AIN(I_ALOG) + l * 32; const float* dtb = AIN(I_DTB) + l * 32;
              for (int i = gtid; i < M * 32; i += NGT) { const int m = i >> 5, hv = i & 31; const float bl = SMALL[(size_t)m * 256 + hv], al = SMALL[(size_t)m * 256 + 32 + hv];
                BETA[i] = 1.f / (1.f + expf(-bl)); const float xx = al + dtb[hv]; const float sp = fmaxf(xx, 0.f) + log1pf(expf(-fabsf(xx))); GG[i] = -expf(alog[hv]) * sp; } }
            { const float* fbias = AIN(I_FBIAS) + l * 16;
              for (int it = gw; it < 64; it += NGW) { const int b = it >> 4, h = it & 15; const float fb = fbias[h]; const size_t mbase = (size_t)b * SEQ + lane * 32; float tot = 0.f;
                for (int i = 0; i < 32; ++i) { const float xx = SMALL[(mbase + i) * 256 + 64 + h] + fb; tot += fminf(xx, 0.f) - log1pf(expf(-fabsf(xx))); }
                float inc = tot;
#pragma unroll
                for (int o = 1; o < 64; o <<= 1) { const float n = __shfl_up(inc, o); if (lane >= o) inc += n; }
                float run = inc - tot;
                for (int i = 0; i < 32; ++i) { const float xx = SMALL[(mbase + i) * 256 + 64 + h] + fb; run += fminf(xx, 0.f) - log1pf(expf(-fabsf(xx))); CUM[(size_t)it * SEQ + lane * 32 + i] = run;
                    const float xq = run * 11.313708498984761f; const unsigned h1 = f2bf(xq); const float r1 = xq - __builtin_bit_cast(float, h1 << 16); const unsigned h2 = f2bf(r1); const float r2 = r1 - __builtin_bit_cast(float, h2 << 16); const unsigned h3 = f2bf(r2);
                    const unsigned n1 = h1 ^ 0x8000u, n2 = h2 ^ 0x8000u, n3 = h3 ^ 0x8000u;
                    *((u32x4*)(ws + WS_FKB) + ((size_t)it * SEQ + lane * 32 + i)) = (u32x4){n1 | (n2 << 16), n3, 0u, 0u}; }
              } }
        }
        SEAM(pb + 1);
        if (IN(pb + 2)) { PH_BEGIN LAYER_PTRS
            LAS float* Ll = (LAS float*)lds;
            LAS float* GCl = (LAS float*)(lds + 131072);
            LAS float* BTl = GCl + 512;
            const int lane_o = lane;
            for (int it = blk; it < 512; it += G) {
                int lane = lane_o; asm volatile("" : "+v"(lane));
                const int fr = lane & 15, fq = lane >> 4;
                const int b = it >> 7, hk = (it >> 3) & 15, cq = it & 7; const int row0 = b * SEQ + cq * 256;
                __syncthreads();
                { const int e = wave >> 2, c = wave & 3, hv = 2 * hk + e; const size_t mm = (size_t)row0 + c * 64 + lane;
                  float gv = GG[mm * 32 + hv]; const float bv = BETA[mm * 32 + hv];
#pragma unroll
                  for (int o = 1; o < 64; o <<= 1) { const float nb = __shfl_up(gv, o); if (lane >= o) gv += nb; }
                  GCl[e * 256 + c * 64 + lane] = gv; BTl[e * 256 + c * 64 + lane] = bv; GCUM[mm * 32 + hv] = gv; }
                __syncthreads();
                { const int c = wave >> 1, P = wave & 1, n = cq * 4 + c; const bf16* Kb = KNB + ((size_t)row0 + c * 64) * D + hk * 128; const bf16* Qb = QNB + ((size_t)row0 + c * 64) * D + hk * 128;
                  pg8::bf16x8 Kf[4][4];
#pragma unroll
                  for (int t = 0; t < 4; ++t)
#pragma unroll
                      for (int s = 0; s < 4; ++s) Kf[t][s] = *(const pg8::bf16x8*)(Kb + (size_t)(16 * t + fr) * D + 32 * s + 8 * fq);
                  if (P == 0) {
#pragma unroll
                      for (int a = 0; a < 4; ++a)
#pragma unroll
                          for (int b2 = 0; b2 <= a; ++b2) { f32x4 acc = {0.f, 0.f, 0.f, 0.f};
#pragma unroll
                              for (int s = 0; s < 4; ++s) acc = __builtin_amdgcn_mfma_f32_16x16x32_bf16(Kf[a][s], Kf[b2][s], acc, 0, 0, 0);
#pragma unroll
                              for (int e = 0; e < 2; ++e) { const f32x4 gi = *(const LAS f32x4*)(GCl + e * 256 + c * 64 + 16 * a + 4 * fq), bi = *(const LAS f32x4*)(BTl + e * 256 + c * 64 + 16 * a + 4 * fq); const float gj = GCl[e * 256 + c * 64 + 16 * b2 + fr];
#pragma unroll
                                  for (int r = 0; r < 4; ++r) { const int i = 16 * a + 4 * fq + r, j = 16 * b2 + fr; Ll[((c * 2 + e) * 64 + i) * 64 + j] = (i > j) ? bi[r] * acc[r] * __expf(gi[r] - gj) : 0.f; } } }
                  } else {
#pragma unroll
                      for (int nt = 0; nt < 4; ++nt) { pg8::bf16x8 Qf[4];
#pragma unroll
                          for (int s = 0; s < 4; ++s) Qf[s] = *(const pg8::bf16x8*)(Qb + (size_t)(16 * nt + fr) * D + 32 * s + 8 * fq);
#pragma unroll
                          for (int mt = 0; mt < 4; ++mt) { f32x4 acc = {0.f, 0.f, 0.f, 0.f};
                              if (mt <= nt) {
#pragma unroll
                                  for (int s = 0; s < 4; ++s) acc = __builtin_amdgcn_mfma_f32_16x16x32_bf16(Kf[mt][s], Qf[s], acc, 0, 0, 0); }
#pragma unroll
                              for (int e = 0; e < 2; ++e) { const int hv = 2 * hk + e, i = 16 * nt + fr; float y[4] = {0.f, 0.f, 0.f, 0.f};
                                  if (mt <= nt) { const float gi = GCl[e * 256 + c * 64 + i]; const f32x4 gj = *(const LAS f32x4*)(GCl + e * 256 + c * 64 + 16 * mt + 4 * fq);
#pragma unroll
                                      for (int r = 0; r < 4; ++r) { const int j = 16 * mt + 4 * fq + r; y[r] = (i >= j) ? acc[r] * 0.08838834764831845f * __expf(gi - gj[r]) : 0.f; } }
                                  u32x2 v; v.x = pg8::cvt_pk_bf16(y[0], y[1]); v.y = pg8::cvt_pk_bf16(y[2], y[3]);
                                  *(u32x2*)(IP + ((size_t)((b * 32 + n) * 32 + hv)) * 4096 + i * 64 + 32 * (mt >> 1) + 8 * fq + 4 * (mt & 1)) = v; } } }
                  } }
                __syncthreads();
                { const int c = wave >> 1, e = wave & 1, hv = 2 * hk + e, n = cq * 4 + c; LAS float* L = Ll + (c * 2 + e) * 4096;
                  float Tc[64];
#pragma unroll
                  for (int i = 0; i < 64; ++i) { float acc = (i == lane) ? 1.f : 0.f;
#pragma unroll
                      for (int j4 = 0; j4 < (i + 3) / 4; ++j4) { const f32x4 lv = *(const LAS f32x4*)(L + i * 64 + 4 * j4);
#pragma unroll
                          for (int k = 0; k < 4; ++k) if (4 * j4 + k < i) acc -= lv[k] * Tc[4 * j4 + k]; }
                      Tc[i] = acc; }
                  const float bc = BTl[e * 256 + c * 64 + lane]; const int pp = (lane & 32) + 8 * ((lane >> 2) & 3) + 4 * ((lane >> 4) & 1) + (lane & 3);
                  LAS unsigned short* Tl = (LAS unsigned short*)L;
                  asm volatile("s_waitcnt lgkmcnt(0)" ::: "memory");
#pragma unroll
                  for (int i = 0; i < 64; ++i) Tl[i * 64 + pp] = (unsigned short)f2bf(Tc[i] * bc);
                  asm volatile("s_waitcnt lgkmcnt(0)" ::: "memory");
                  bf16* tp = TP + ((size_t)((b * 32 + n) * 32 + hv)) * 4096;
#pragma unroll
                  for (int k = 0; k < 8; ++k) *(u32x4*)(tp + (k * 64 + lane) * 8) = *(const LAS u32x4*)((const LAS unsigned char*)L + (k * 64 + lane) * 16); }
            }
        }
        SEAM(pb + 2);
        if (IN(pb + 3)) { PH_BEGIN LAYER_PTRS
            if (blk < 128) {
                const int b = blk >> 5, hv = blk & 31, hk = hv >> 1, fr = lane & 15, fq = lane >> 4;
                LAS float* EGl = (LAS float*)(lds + 131072);
                if (wave >= 4) {
                    const int lw = wave - 4;
                    for (int n = 0; n < 32; ++n) {
                        const int row0 = b * SEQ + n * 64; const unsigned dstb = (unsigned)(uintptr_t)(lds) + (unsigned)((n & 1) * 65536);
                        if (lw < 2) { const bf16* srcb = (lw == 0 ? KNB : QNB) + (size_t)row0 * D + hk * 128;
#pragma unroll
                            for (int f = 0; f < 16; ++f) fox::glds16(srcb + (size_t)(16 * (f >> 2) + fr) * D + 32 * (f & 3) + 8 * fq, dstb + lw * 16384 + f * 1024);
                        } else if (lw == 2) { const bf16* srcb = KTP + ((size_t)((b * 32 + n) * 16 + hk)) * 8192;
#pragma unroll
                            for (int f = 0; f < 16; ++f) { const int tau = f >> 1, s2 = f & 1, dkr = 32 * (tau >> 1) + 8 * (fr >> 2) + 4 * (tau & 1) + (fr & 3); fox::glds16(srcb + (size_t)dkr * 64 + 32 * s2 + 8 * fq, dstb + 32768 + f * 1024); }
                        } else { const bf16* st = TP + ((size_t)((b * 32 + n) * 32 + hv)) * 4096; const bf16* si = IP + ((size_t)((b * 32 + n) * 32 + hv)) * 4096;
#pragma unroll
                            for (int f = 0; f < 8; ++f) { fox::glds16(st + (16 * (f >> 1) + fr) * 64 + 32 * (f & 1) + 8 * fq, dstb + 49152 + f * 1024); fox::glds16(si + (16 * (f >> 1) + fr) * 64 + 32 * (f & 1) + 8 * fq, dstb + 57344 + f * 1024); }
                            const float gc = GCUM[(size_t)(row0 + lane) * 32 + hv], gl = GCUM[(size_t)(row0 + 63) * 32 + hv];
                            EGl[(n & 1) * 128 + lane] = __expf(gc); EGl[(n & 1) * 128 + 64 + lane] = __expf(gl - gc); }
                        asm volatile("s_waitcnt vmcnt(0) lgkmcnt(0)" ::: "memory");
                        __builtin_amdgcn_s_barrier();
                    }
                } else {
                    const int w = wave;
                    f32x4 Sacc[8];
#pragma unroll
                    for (int t = 0; t < 8; ++t) Sacc[t] = (f32x4){0.f, 0.f, 0.f, 0.f};
                    const bf16* vb = VTP + ((size_t)(b * 32) * 32 + hv) * 4096 + (size_t)(16 * w + fr) * 64 + 8 * fq;
                    u32x4 vnx0 = *(const u32x4*)(vb), vnx1 = *(const u32x4*)(vb + 32);
                    for (int n = 0; n < 32; ++n) {
                        asm volatile("s_waitcnt lgkmcnt(0)" ::: "memory");
                        __builtin_amdgcn_s_barrier();
                        asm volatile("" ::: "memory");
                        const LAS unsigned char* B = lds + (n & 1) * 65536 + lane * 16; const LAS float* EG = EGl + (n & 1) * 128; const LAS float* EGL = EG + 64; const int row0 = b * SEQ + n * 64;
                        const u32x4 vc0 = vnx0, vc1 = vnx1;
                        if (n + 1 < 32) { vnx0 = *(const u32x4*)(vb + (size_t)(n + 1) * 32 * 4096); vnx1 = *(const u32x4*)(vb + (size_t)(n + 1) * 32 * 4096 + 32); }
                        pg8::bf16x8 Sb[4];
#pragma unroll
                        for (int s = 0; s < 4; ++s) { const float t8[8] = {Sacc[2 * s][0], Sacc[2 * s][1], Sacc[2 * s][2], Sacc[2 * s][3], Sacc[2 * s + 1][0], Sacc[2 * s + 1][1], Sacc[2 * s + 1][2], Sacc[2 * s + 1][3]}; const u32x4 pk = pack8(t8); Sb[s] = __builtin_bit_cast(pg8::bf16x8, pk); }
                        f32x4 KS[4], QS[4];
#pragma unroll
                        for (int mt = 0; mt < 4; ++mt) { KS[mt] = (f32x4){0.f, 0.f, 0.f, 0.f}; QS[mt] = (f32x4){0.f, 0.f, 0.f, 0.f};
#pragma unroll
                            for (int s = 0; s < 4; ++s) { KS[mt] = __builtin_amdgcn_mfma_f32_16x16x32_bf16(*(const LAS pg8::bf16x8*)(B + (mt * 4 + s) * 1024), Sb[s], KS[mt], 0, 0, 0);
                                QS[mt] = __builtin_amdgcn_mfma_f32_16x16x32_bf16(*(const LAS pg8::bf16x8*)(B + 16384 + (mt * 4 + s) * 1024), Sb[s], QS[mt], 0, 0, 0); } }
                        pg8::bf16x8 Rb[2];
#pragma unroll
                        for (int s2 = 0; s2 < 2; ++s2) { const f32x4 e0 = *(const LAS f32x4*)(EG + 32 * s2 + 4 * fq), e1 = *(const LAS f32x4*)(EG + 32 * s2 + 16 + 4 * fq); float v8[8]; unpack8(s2 ? vc1 : vc0, v8); float r8[8];
#pragma unroll
                            for (int k = 0; k < 4; ++k) { r8[k] = v8[k] - e0[k] * KS[2 * s2][k]; r8[4 + k] = v8[4 + k] - e1[k] * KS[2 * s2 + 1][k]; }
                            const u32x4 pk = pack8(r8); Rb[s2] = __builtin_bit_cast(pg8::bf16x8, pk); }
                        f32x4 Vn[4];
#pragma unroll
                        for (int mt = 0; mt < 4; ++mt) { Vn[mt] = (f32x4){0.f, 0.f, 0.f, 0.f};
#pragma unroll
                            for (int s2 = 0; s2 < 2; ++s2) Vn[mt] = __builtin_amdgcn_mfma_f32_16x16x32_bf16(*(const LAS pg8::bf16x8*)(B + 49152 + (mt * 2 + s2) * 1024), Rb[s2], Vn[mt], 0, 0, 0); }
                        pg8::bf16x8 Vnb[2], Vsb[2];
#pragma unroll
                        for (int s2 = 0; s2 < 2; ++s2) { const f32x4 g0 = *(const LAS f32x4*)(EGL + 32 * s2 + 4 * fq), g1 = *(const LAS f32x4*)(EGL + 32 * s2 + 16 + 4 * fq);
                            const float a8[8] = {Vn[2 * s2][0], Vn[2 * s2][1], Vn[2 * s2][2], Vn[2 * s2][3], Vn[2 * s2 + 1][0], Vn[2 * s2 + 1][1], Vn[2 * s2 + 1][2], Vn[2 * s2 + 1][3]};
                            const float b8[8] = {a8[0] * g0[0], a8[1] * g0[1], a8[2] * g0[2], a8[3] * g0[3], a8[4] * g1[0], a8[5] * g1[1], a8[6] * g1[2], a8[7] * g1[3]};
                            const u32x4 pa = pack8(a8), pb2 = pack8(b8); Vnb[s2] = __builtin_bit_cast(pg8::bf16x8, pa); Vsb[s2] = __builtin_bit_cast(pg8::bf16x8, pb2); }
#pragma unroll
                        for (int mt = 0; mt < 4; ++mt) { const f32x4 eg = *(const LAS f32x4*)(EG + 16 * mt + 4 * fq); f32x4 o = QS[mt] * eg * 0.08838834764831845f;
#pragma unroll
                            for (int s2 = 0; s2 < 2; ++s2) o = __builtin_amdgcn_mfma_f32_16x16x32_bf16(*(const LAS pg8::bf16x8*)(B + 57344 + (mt * 2 + s2) * 1024), Vnb[s2], o, 0, 0, 0);
                            float* op = ORAW + (size_t)(row0 + 16 * mt + 4 * fq) * D + hv * 64 + 16 * w + fr;
#pragma unroll
                            for (int r = 0; r < 4; ++r) op[(size_t)r * D] = o[r]; }
                        const float cd = EG[63];
#pragma unroll
                        for (int t = 0; t < 8; ++t) { Sacc[t] = Sacc[t] * cd;
#pragma unroll
                            for (int s2 = 0; s2 < 2; ++s2) Sacc[t] = __builtin_amdgcn_mfma_f32_16x16x32_bf16(*(const LAS pg8::bf16x8*)(B + 32768 + (t * 2 + s2) * 1024), Vsb[s2], Sacc[t], 0, 0, 0); }
                    }
                }
            }
            __syncthreads();
            {
                typedef fox::BlockRef<fox::TIN, fox::TOUT> BR;
                const fox::TIN *FQp = (const fox::TIN*)(T + TI_FQ * ACT_E), *FKp = (const fox::TIN*)(T + TI_FK * ACT_E), *FVp = (const fox::TIN*)(T + TI_FV * ACT_E); fox::TOUT* Op = (fox::TOUT*)YC;
                const char* FKB = (const char*)(ws + WS_FKB); const char* Z16 = (const char*)(ws + 256);
                const int bh = blk >> 2, xq = blk & 3, b = bh >> 4, h = bh & 15;
                if (blk < 256) {
#define FOX_REF(r, qb) do { const size_t row0 = (size_t)b * SEQ + (size_t)(qb) * 256; (r).Q = FQp + row0 * D + h * 128; (r).K = FKp + (size_t)b * SEQ * D + h * 128; (r).V = FVp + (size_t)b * SEQ * D + h * 128; \
                    (r).O = Op + row0 * D + h * 128; (r).FK = FKB + (size_t)bh * SEQ * 16; (r).Z16 = Z16; (r).P0 = (qb) * 256; } while (0)
                    BR cur, nxt; FOX_REF(cur, xq); FOX_REF(nxt, 7 - xq);
                    fox::Seam<fox::TIN> S;
                    fox::causal_swa_prime<fox::TIN, fox::TOUT>(cur, SEQ, (char*)lds_raw, S);
                    for (int pass = 0; pass < 2; ++pass) {
                        fox::causal_swa_block<fox::TIN, fox::TOUT>(cur, nxt, SEQ, SEQ, (char*)lds_raw, S);
                        cur = nxt;
                    }
#undef FOX_REF
                }
            }
        }
        SEAM(pb + 3);
        if (IN(pb + 4)) { PH_BEGIN LAYER_PTRS
            const float* nw = AIN(I_GNORMW) + l * 64; const bf16* GZ = T + TI_GZ * ACT_E;
            float nwv[8];
#pragma unroll
            for (int i = 0; i < 8; ++i) nwv[i] = nw[(lane & 7) * 8 + i];
            for (int it = gw; it < M * 4; it += NGW) { const size_t o = (size_t)(it >> 2) * D + (it & 3) * 512 + lane * 8;
                const f32x4 a = *(const f32x4*)(ORAW + o), b = *(const f32x4*)(ORAW + o + 4); float ov[8] = {a[0], a[1], a[2], a[3], b[0], b[1], b[2], b[3]}, z[8], y[8]; float ss = 0.f;
#pragma unroll
                for (int i = 0; i < 8; ++i) ss += ov[i] * ov[i];
                ss += __shfl_xor(ss, 1); ss += __shfl_xor(ss, 2); ss += __shfl_xor(ss, 4);
                const float rn = 1.f / sqrtf(ss * (1.f / 64.f) + NORM_EPS); unpack8(*(const u32x4*)(GZ + o), z);
#pragma unroll
                for (int i = 0; i < 8; ++i) y[i] = ov[i] * rn * nwv[i] * (z[i] / (1.f + expf(-z[i])));
                *(u32x4*)(YB + o) = pack8(y); }
        }
        SEAM(pb + 4);
        if (IN(pb + 5)) { PH_BEGIN LAYER_PTRS
            pg8::StaticOrder S; S.init(M, D, G, blk);
            { pg8::Gemm g{YA, (const bf16*)(wl + W_A), M, D, D}; pg8::EpiMerge<0> E{T + TI_MA * ACT_E, MACC, MG}; pg8::gemm_phase<pg8::EpiMerge<0>, pg8::StaticOrder, true, true>(lds, g, S, E); }
            { pg8::Gemm g{YB, (const bf16*)(wl + W_B), M, D, D}; pg8::EpiMerge<1> E{T + TI_MB * ACT_E, MACC, MG}; pg8::gemm_phase<pg8::EpiMerge<1>, pg8::StaticOrder, true, true>(lds, g, S, E); }
            { pg8::Gemm g{YC, (const bf16*)(wl + W_C), M, D, D}; pg8::EpiMerge<2> E{T + TI_MC * ACT_E, MACC, MG}; pg8::gemm_phase<pg8::EpiMerge<2>, pg8::StaticOrder, true, true>(lds, g, S, E); }
        }
        SEAM(pb + 5);
        if (IN(pb + 6)) { PH_BEGIN LAYER_PTRS
            pg8::Gemm g{MG, (const bf16*)(wl + W_O), M, D, D}; pg8::StaticOrder S; S.init(M, D, G, blk);
            pg8::EpiResid E{Xin, modl + 2 * D, PRE, ALPHA};
            pg8::gemm_phase<pg8::EpiResid, pg8::StaticOrder, true, true>(lds, g, S, E);
        }
        SEAM(pb + 6);
        if (IN(pb + 7)) { PH_BEGIN LAYER_PTRS
            const float* g1 = AIN(I_LN1G) + (size_t)l * D; const float* b1 = AIN(I_LN1B) + (size_t)l * D;
            for (int m = gw; m < M; m += NGW) { const float* mb = modl + (size_t)(m >> 11) * MODW; ln_mod_row(PRE + (size_t)m * D, g1, b1, X + (size_t)m * D, U + (size_t)m * D, mb + 3 * D, mb + 4 * D, lane); }
        }
        SEAM(pb + 7);
        if (IN(pb + 8)) { PH_BEGIN LAYER_PTRS
            pg8::Gemm g{U, (const bf16*)(wl + W_1), M, FF, D}; pg8::StaticOrder S; S.init(M, FF, G, blk);
            pg8::EpiRelu2 E{H, FF};
            pg8::gemm_phase<pg8::EpiRelu2, pg8::StaticOrder, true, true>(lds, g, S, E);
        }
        SEAM(pb + 8);
        if (IN(pb + 9)) { PH_BEGIN LAYER_PTRS
            pg8::Gemm g{H, (const bf16*)(wl + W_2), M, D, FF}; pg8::StaticOrder S; S.init(M, D, G, blk);
            pg8::EpiResid E{X, modl + 5 * D, PRE, ALPHA};
            pg8::gemm_phase<pg8::EpiResid, pg8::StaticOrder, true, true>(lds, g, S, E);
        }
        SEAM(pb + 9);
        if (IN(pb + 10)) { PH_BEGIN LAYER_PTRS
            const float* g2 = AIN(I_LN2G) + (size_t)l * D; const float* b2 = AIN(I_LN2B) + (size_t)l * D; const bool last = (l == DEPTH - 1);
            float* xo = last ? ((float*)(GAS float*)ap->out) : X; const float* modn = mod + (size_t)(last ? l : l + 1) * 4 * MODW;
            for (int m = gw; m < M; m += NGW) { const float* mb = modn + (size_t)(m >> 11) * MODW; ln_mod_row(PRE + (size_t)m * D, g2, b2, xo + (size_t)m * D, last ? (bf16*)nullptr : U + (size_t)m * D, mb, mb + D, lane); }
        }
        SEAM(pb + 10);
    }
#undef IN
#undef SEAM
}

#ifndef MK_ONE_LAUNCH
#define MK_ONE_LAUNCH 0
#endif
extern "C" void kernel_launch(void* const* d_in, const int* in_sizes, int n_in, void* d_out, int out_size, void* d_ws, size_t ws_size, hipStream_t stream) {
    static int grid = 0;
    if (grid == 0) {
        if (n_in != N_IN || out_size != M * D || ws_size < WS_END) { fprintf(stderr, "kernel_launch: unexpected shapes: n_in %d out %d ws %zu (need %zu)\n", n_in, out_size, ws_size, (size_t)WS_END); grid = -1; return; }
        int dev = 0, cus = 0, per_cu = 0;
        if (hipGetDevice(&dev) != hipSuccess || hipDeviceGetAttribute(&cus, hipDeviceAttributeMultiprocessorCount, dev) != hipSuccess) { grid = -1; return; }
        if (hipFuncSetAttribute((const void*)fwd_kernel, hipFuncAttributeMaxDynamicSharedMemorySize, LDS_BYTES) != hipSuccess) { fprintf(stderr, "kernel_launch: hipFuncSetAttribute failed\n"); grid = -1; return; }
        if (hipOccupancyMaxActiveBlocksPerMultiprocessor(&per_cu, (const void*)fwd_kernel, NT, LDS_BYTES) != hipSuccess || per_cu < 1) fprintf(stderr, "kernel_launch: occupancy query says %d\n", per_cu);
        (void)hipGetLastError();
        grid = cus;
        if (grid != 256) fprintf(stderr, "kernel_launch: %d CUs (built for 256)\n", grid);
    }
    if (grid < 0) return;
    (void)hipMemsetAsync((char*)d_ws + WS_CTL, 0, CTL_ZERO_BYTES, stream);
    Args a{};
    for (int i = 0; i < N_IN; ++i) a.in[i] = (const float*)d_in[i];
    a.out = (float*)d_out; a.ws = (unsigned char*)d_ws;
#if MK_ONE_LAUNCH
    a.ph_lo = 0; a.ph_hi = NPH;
    hipLaunchKernelGGL(fwd_kernel, dim3(grid), dim3(NT), LDS_BYTES, stream, a);
#else
    for (int p = 0; p < NPH; ++p) { a.ph_lo = p; a.ph_hi = p + 1; hipLaunchKernelGGL(fwd_kernel, dim3(grid), dim3(NT), LDS_BYTES, stream, a); }
#endif
}
```

```cpp
#include <hip/hip_runtime.h>
#include <cstdio>
#include <cstdint>
#define MK_ONE_LAUNCH 1
namespace pg8 {
#define PG8_LAS __attribute__((address_space(3)))
typedef unsigned short bf16_t;
typedef short bf16x8 __attribute__((ext_vector_type(8)));
typedef float f32x4 __attribute__((ext_vector_type(4)));
typedef unsigned u32x4 __attribute__((ext_vector_type(4)));
constexpr int BM = 256, BK = 64, HALF = 128, HTB = HALF * BK * 2  , STAGE_BYTES = 8 * HTB, NXCD = 8, WGM = 8;

__host__ __device__ __forceinline__ int lds_byte(int r, int c) { const int st = (r >> 4) * 2 + (c >> 5), rr = r & 15, cc = c & 31, ob = rr * 64 + cc * 2; return st * 1024 + (ob ^ (((ob >> 9) & 1) << 5)); }
__host__ __device__ __forceinline__ void stage_rc(int b, int& R, int& C) { const int st = b / 1024, sb = b % 1024, swz = sb ^ (((sb >> 9) & 1) << 5); R = (st >> 1) * 16 + swz / 64; C = (st & 1) * 32 + (swz % 64) / 2; }
__host__ __device__ __forceinline__ int perm32(int rho) { const int n = rho >> 4, i = rho & 15; return 8 * (i >> 2) + 4 * n + (i & 3); }

struct Unit { int pm, pn; };
struct Gemm { const bf16_t* A; const bf16_t* Bt; int M, N, K; };

struct StaticOrder {
    int nM, nN, nwg, G, c;
    __host__ __device__ void init(int M, int N, int G_, int c_) { nM = M / BM; nN = N / BM; nwg = nM * nN; G = G_; c = c_; }
    __host__ __device__ bool next(int i, Unit& u) const {
        const long L = (long)i * G + c; if (L >= nwg) return false;
        int wgid = (int)L; { const int q = nwg / NXCD, r = nwg % NXCD, xcd = wgid % NXCD, off = wgid / NXCD; wgid = (xcd < r ? xcd * (q + 1) : r * (q + 1) + (xcd - r) * q) + off; }
        const int nig = WGM * nN, gid = wgid / nig, fm = gid * WGM, gsz = (nM - fm) < WGM ? (nM - fm) : WGM;
        u.pm = fm + ((wgid % nig) % gsz); u.pn = (wgid % nig) / gsz; return true;
    }
    __device__ __forceinline__ void a_ready(const Unit&) const {}
    __device__ __forceinline__ void done(const Unit&) const {}
};

__device__ __forceinline__ unsigned cvt_pk_bf16(float lo, float hi) { unsigned r; asm volatile("v_cvt_pk_bf16_f32 %0, %1, %2" : "=v"(r) : "v"(lo), "v"(hi)); return r; }
typedef float f32x2 __attribute__((ext_vector_type(2)));
__device__ __forceinline__ f32x2 gelu_pk(f32x2 v) {
    const f32x2 av = __builtin_elementwise_abs(v), d = av * 0.2316418882f + 1.0f;
    f32x2 t; t.x = __builtin_amdgcn_rcpf(d.x); t.y = __builtin_amdgcn_rcpf(d.y);
    f32x2 q = t * 0.5307027145f + (-0.7265760135f); q = q * t + 0.7107068705f; q = q * t + (-0.142248368f); q = q * t + 0.127414796f; q = q * t;
    const f32x2 s = (v * v) * (-0.72134752044f);
    f32x2 e; e.x = __builtin_amdgcn_exp2f(s.x); e.y = __builtin_amdgcn_exp2f(s.y);
    const f32x2 m = v * (q * e), r = v - m;
    f32x2 o; o.x = v.x < 0.f ? m.x : r.x; o.y = v.y < 0.f ? m.y : r.y; return o;
}

template <int ACT  > struct EpiBf16 {
    static constexpr bool PERM = true, AFTER_DRAIN = false; static_assert(ACT == 0 || ACT == 1, "EpiBf16: ACT is 0 (none) or 1 (gelu_pk)");
    bf16_t* O; int ldc; const float* bias; int split_cols; size_t split_stride; float scale0;
    __device__ __forceinline__ void operator()(const f32x4 (&acc)[2][2][4][2], const Unit& u, int wr, int wc, int fr, int fq) const {
        const int row0 = u.pm * BM + wr * 64 + fr; int colt = u.pn * BM; bf16_t* base = O;
        float sc = 1.f; if (split_cols) { const int t = colt / split_cols; base += (size_t)t * split_stride; colt -= t * split_cols; if (t == 0) sc = scale0; }
        const int col0 = colt + wc * 32 + 8 * fq, bcol0 = u.pn * BM + wc * 32 + 8 * fq;
        f32x4 bv[2][2];
#pragma unroll
        for (int bj = 0; bj < 2; ++bj)
#pragma unroll
            for (int n = 0; n < 2; ++n) bv[bj][n] = bias ? *(const f32x4*)(bias + bcol0 + bj * HALF + 4 * n) : (f32x4){0.f, 0.f, 0.f, 0.f};
#pragma unroll
        for (int ai = 0; ai < 2; ++ai)
#pragma unroll
            for (int m = 0; m < 4; ++m) { bf16_t* rowp = base + (size_t)(row0 + ai * HALF + m * 16) * ldc + col0;
#pragma unroll
                for (int bj = 0; bj < 2; ++bj) { f32x4 v0 = acc[ai][bj][m][0] + bv[bj][0], v1 = acc[ai][bj][m][1] + bv[bj][1];
                    if (ACT == 1) { f32x2 a = gelu_pk((f32x2){v0[0], v0[1]}), b = gelu_pk((f32x2){v0[2], v0[3]}), c = gelu_pk((f32x2){v1[0], v1[1]}), d = gelu_pk((f32x2){v1[2], v1[3]});
                        v0 = (f32x4){a.x, a.y, b.x, b.y}; v1 = (f32x4){c.x, c.y, d.x, d.y}; }
                    v0 = v0 * sc; v1 = v1 * sc; u32x4 w; w.x = cvt_pk_bf16(v0[0], v0[1]); w.y = cvt_pk_bf16(v0[2], v0[3]); w.z = cvt_pk_bf16(v1[0], v1[1]); w.w = cvt_pk_bf16(v1[2], v1[3]);
                    *(u32x4*)(rowp + bj * HALF) = w; } }
    }
};


template <class Epi, class Sched, bool ALIGN_EPI = false, bool SP2 = false>
__device__ __forceinline__ void gemm_phase(PG8_LAS unsigned char* lds, const Gemm g, const Sched& S, const Epi& E) {
    int tid_l = threadIdx.x; asm volatile("" : "+v"(tid_l));
    const int tid = tid_l, wid = __builtin_amdgcn_readfirstlane(tid >> 6), lane = tid & 63, wr = wid >> 2, wc = wid & 3, fr = lane & 15, fq = lane >> 4;
    const int K = g.K, nt = K / BK;
    unsigned voffA[2], voffB[2];
#pragma unroll
    for (int i = 0; i < 2; ++i) { int R, C; stage_rc(tid * 16 + i * 8192, R, C); const int Rb = Epi::PERM ? ((R & ~31) + perm32(R & 31)) : R;
        voffA[i] = (unsigned)(R * K + C) * 2u; voffB[i] = (unsigned)(Rb * K + C) * 2u; }
    const size_t kstep = (size_t)(BK * 2);
    const size_t hstep = (size_t)HALF * K * 2;
    const size_t tstep = 2 * hstep;
    const unsigned ldsw = (unsigned)wid * 1024u;
    const int aoff = lds_byte(wr * 64 + fr, fq * 8), boff = lds_byte(wc * 32 + fr, fq * 8);
#define PG8_SA(b, h) (((b) * 2 + (h)) * HTB)
#define PG8_SB(b, h) ((4 + (b) * 2 + (h)) * HTB)
#define PG8_STAGE(bufoff, gbase, voff) do { _Pragma("unroll") for (int _i = 0; _i < 2; ++_i) \
        __builtin_amdgcn_global_load_lds((const unsigned*)((const char*)(gbase) + (voff)[_i]), (PG8_LAS unsigned*)(lds + (bufoff) + ldsw + _i * 8192), 16, 0, 0); } while (0)
#define PG8_LDA(dst, b, h) do { _Pragma("unroll") for (int m = 0; m < 4; ++m) _Pragma("unroll") for (int k = 0; k < 2; ++k) dst[m][k] = *(const PG8_LAS bf16x8*)(lds + PG8_SA(b, h) + aoff + m * 2048 + k * 1024); } while (0)
#define PG8_LDB(dst, b, h) do { _Pragma("unroll") for (int n = 0; n < 2; ++n) _Pragma("unroll") for (int k = 0; k < 2; ++k) dst[n][k] = *(const PG8_LAS bf16x8*)(lds + PG8_SB(b, h) + boff + n * 2048 + k * 1024); } while (0)
#define PG8_MMA(ai, bj, At, Bt) do { __builtin_amdgcn_s_setprio(1); _Pragma("unroll") for (int m = 0; m < 4; ++m) _Pragma("unroll") for (int n = 0; n < 2; ++n) _Pragma("unroll") for (int k = 0; k < 2; ++k) \
        acc[ai][bj][m][n] = __builtin_amdgcn_mfma_f32_16x16x32_bf16(Bt[n][k], At[m][k], acc[ai][bj][m][n], 0, 0, 0); __builtin_amdgcn_s_setprio(0); } while (0)
#define PG8_WAIT_V(n) asm volatile("s_waitcnt vmcnt(" #n ")" ::: "memory")
#define PG8_WAIT_L(n) asm volatile("s_waitcnt lgkmcnt(" #n ")" ::: "memory")
#define PG8_BAR __builtin_amdgcn_s_barrier()
#define PG8_SCHED __builtin_amdgcn_sched_barrier(0)
    Unit cur, nxt; int ui = 0;
    if (!S.next(0, cur)) return;
    f32x4 acc[2][2][4][2];
#pragma unroll
    for (int a = 0; a < 2; ++a)
#pragma unroll
        for (int b = 0; b < 2; ++b)
#pragma unroll
            for (int m = 0; m < 4; ++m)
#pragma unroll
                for (int n = 0; n < 2; ++n) acc[a][b][m][n] = (f32x4){0.f, 0.f, 0.f, 0.f};
    bf16x8 At[4][2], B0[2][2], B1[2][2];
    const char* cA = (const char*)g.A + (size_t)cur.pm * tstep; const char* cB = (const char*)g.Bt + (size_t)cur.pn * tstep;
    S.a_ready(cur);
    if constexpr (SP2) {
        PG8_STAGE(PG8_SB(0, 0), cB, voffB); PG8_STAGE(PG8_SB(0, 1), cB + hstep, voffB); PG8_STAGE(PG8_SA(0, 0), cA, voffA); PG8_STAGE(PG8_SA(0, 1), cA + hstep, voffA);
        if (wr == 1) PG8_BAR;
        PG8_WAIT_V(2); PG8_BAR;
        PG8_STAGE(PG8_SB(1, 0), cB + kstep, voffB); PG8_STAGE(PG8_SA(1, 0), cA + kstep, voffA); PG8_STAGE(PG8_SB(1, 1), cB + hstep + kstep, voffB);
        PG8_WAIT_V(6); PG8_BAR;
    } else {
        PG8_STAGE(PG8_SB(0, 0), cB, voffB); PG8_STAGE(PG8_SA(0, 0), cA, voffA); PG8_STAGE(PG8_SB(0, 1), cB + hstep, voffB); PG8_STAGE(PG8_SA(0, 1), cA + hstep, voffA);
        if (wr == 1) PG8_BAR;
        PG8_WAIT_V(4); PG8_BAR;
        PG8_STAGE(PG8_SB(1, 0), cB + kstep, voffB); PG8_STAGE(PG8_SA(1, 0), cA + kstep, voffA); PG8_STAGE(PG8_SB(1, 1), cB + hstep + kstep, voffB);
        PG8_WAIT_V(6); PG8_BAR;
    }
    for (;;) {
        const bool has_next = S.next(ui + 1, nxt);
        const char* nA = has_next ? (const char*)g.A + (size_t)nxt.pm * tstep : cA; const char* nB = has_next ? (const char*)g.Bt + (size_t)nxt.pn * tstep : cB;
        for (int t = 0; t < nt; t += 2) {
            const bool last = (t == nt - 2);
            const char* a1 = cA + (size_t)(t + 1) * kstep;
            const char* a2 = last ? nA : cA + (size_t)(t + 2) * kstep; const char* b2 = last ? nB : cB + (size_t)(t + 2) * kstep;
            const char* a3 = a2 + kstep; const char* b3 = b2 + kstep;
            if (last && has_next) S.a_ready(nxt);
            if constexpr (SP2) {
            PG8_LDB(B0, 0, 0); PG8_LDB(B1, 0, 1); PG8_SCHED; PG8_LDA(At, 0, 0); PG8_STAGE(PG8_SA(1, 1), a1 + hstep, voffA);
            PG8_WAIT_V(8); PG8_WAIT_L(0); PG8_BAR; PG8_MMA(0, 0, At, B0); PG8_MMA(0, 1, At, B1); PG8_BAR; PG8_SCHED;
            PG8_LDA(At, 0, 1); PG8_STAGE(PG8_SB(0, 0), b2, voffB); PG8_STAGE(PG8_SB(0, 1), b2 + hstep, voffB); PG8_STAGE(PG8_SA(0, 0), a2, voffA);
            PG8_WAIT_V(8); PG8_WAIT_L(0); PG8_BAR; PG8_MMA(1, 0, At, B0); PG8_MMA(1, 1, At, B1); PG8_BAR; PG8_SCHED;
            PG8_LDB(B0, 1, 0); PG8_LDB(B1, 1, 1); PG8_SCHED; PG8_LDA(At, 1, 0); PG8_STAGE(PG8_SA(0, 1), a2 + hstep, voffA);
            PG8_WAIT_V(8); PG8_WAIT_L(0); PG8_BAR; PG8_MMA(0, 0, At, B0); PG8_MMA(0, 1, At, B1); PG8_BAR; PG8_SCHED;
            PG8_LDA(At, 1, 1); PG8_STAGE(PG8_SB(1, 0), b3, voffB); PG8_STAGE(PG8_SB(1, 1), b3 + hstep, voffB); PG8_STAGE(PG8_SA(1, 0), a3, voffA);
            PG8_WAIT_V(8); PG8_WAIT_L(0); PG8_BAR; PG8_MMA(1, 0, At, B0); PG8_MMA(1, 1, At, B1); PG8_BAR; PG8_SCHED;
            } else {
            PG8_LDB(B0, 0, 0); PG8_SCHED; PG8_LDA(At, 0, 0); PG8_STAGE(PG8_SA(1, 1), a1 + hstep, voffA);
            PG8_WAIT_L(8); PG8_BAR; PG8_WAIT_L(0); PG8_MMA(0, 0, At, B0); PG8_BAR; PG8_SCHED;
            PG8_LDB(B1, 0, 1); PG8_STAGE(PG8_SB(0, 0), b2, voffB);
            PG8_BAR; PG8_WAIT_L(0); PG8_MMA(0, 1, At, B1); PG8_BAR;
            PG8_LDA(At, 0, 1); PG8_STAGE(PG8_SA(0, 0), a2, voffA);
            PG8_BAR; PG8_WAIT_L(0); PG8_MMA(1, 0, At, B0); PG8_BAR; PG8_SCHED;
            PG8_STAGE(PG8_SB(0, 1), b2 + hstep, voffB);
            PG8_WAIT_V(6); PG8_BAR; PG8_MMA(1, 1, At, B1); PG8_BAR;
            PG8_LDB(B0, 1, 0); PG8_SCHED; PG8_LDA(At, 1, 0); PG8_STAGE(PG8_SA(0, 1), a2 + hstep, voffA);
            PG8_WAIT_L(8); PG8_BAR; PG8_WAIT_L(0); PG8_MMA(0, 0, At, B0); PG8_BAR; PG8_SCHED;
            PG8_LDB(B1, 1, 1); PG8_STAGE(PG8_SB(1, 0), b3, voffB);
            PG8_BAR; PG8_WAIT_L(0); PG8_MMA(0, 1, At, B1); PG8_BAR;
            PG8_LDA(At, 1, 1); PG8_STAGE(PG8_SA(1, 0), a3, voffA);
            PG8_BAR; PG8_WAIT_L(0); PG8_MMA(1, 0, At, B0); PG8_BAR; PG8_SCHED;
            PG8_STAGE(PG8_SB(1, 1), b3 + hstep, voffB);
            PG8_WAIT_V(6); PG8_BAR; PG8_MMA(1, 1, At, B1); PG8_BAR;
            }
        }
        if constexpr (ALIGN_EPI) { if (wr == 0) PG8_BAR; }
        if constexpr (!Epi::AFTER_DRAIN) { E(acc, cur, wr, wc, fr, fq); S.done(cur); }
        if (!has_next) break;
#pragma unroll
        for (int a = 0; a < 2; ++a)
#pragma unroll
            for (int b = 0; b < 2; ++b)
#pragma unroll
                for (int m = 0; m < 4; ++m)
#pragma unroll
                    for (int n = 0; n < 2; ++n) acc[a][b][m][n] = (f32x4){0.f, 0.f, 0.f, 0.f};
        cur = nxt; cA = nA; cB = nB; ++ui;
        if constexpr (ALIGN_EPI) { if (wr == 1) PG8_BAR; }
    }
    PG8_WAIT_V(0);
    if constexpr (!ALIGN_EPI) { if (wr == 0) PG8_BAR; }
    PG8_BAR;
    if constexpr (Epi::AFTER_DRAIN) { E.fused(acc, cur, wr, wc, fr, fq, lds, wid, lane); S.done(cur); }
#undef PG8_SA
#undef PG8_SB
#undef PG8_STAGE
#undef PG8_LDA
#undef PG8_LDB
#undef PG8_MMA
#undef PG8_WAIT_V
#undef PG8_WAIT_L
#undef PG8_BAR
#undef PG8_SCHED
}
}

namespace pg8 {
__device__ __forceinline__ float bf_lo(unsigned w) { return __builtin_bit_cast(float, w << 16); }
__device__ __forceinline__ float bf_hi(unsigned w) { return __builtin_bit_cast(float, w & 0xffff0000u); }
__device__ __forceinline__ float fsigmoid(float x) { return __builtin_amdgcn_rcpf(1.f + __expf(-x)); }

struct EpiInProj {
    static constexpr bool PERM = true, AFTER_DRAIN = false;
    bf16_t* T0; float* SMALL; size_t tstride;
    __device__ __forceinline__ void operator()(const f32x4 (&acc)[2][2][4][2], const Unit& u, int wr, int wc, int fr, int fq) const {
        const int t = u.pn >> 3; const int row0 = u.pm * BM + wr * 64 + fr;
        if (t < 13) {
            bf16_t* base = T0 + (size_t)t * tstride; const int col0 = (u.pn & 7) * BM + wc * 32 + 8 * fq; const bool sg = t >= 10;
#pragma unroll
            for (int ai = 0; ai < 2; ++ai)
#pragma unroll
                for (int m = 0; m < 4; ++m) { bf16_t* rowp = base + (size_t)(row0 + ai * HALF + m * 16) * 2048 + col0;
#pragma unroll
                    for (int bj = 0; bj < 2; ++bj) { f32x4 v0 = acc[ai][bj][m][0], v1 = acc[ai][bj][m][1];
                        if (sg) { v0 = (f32x4){fsigmoid(v0[0]), fsigmoid(v0[1]), fsigmoid(v0[2]), fsigmoid(v0[3])}; v1 = (f32x4){fsigmoid(v1[0]), fsigmoid(v1[1]), fsigmoid(v1[2]), fsigmoid(v1[3])}; }
                        u32x4 w; w.x = cvt_pk_bf16(v0[0], v0[1]); w.y = cvt_pk_bf16(v0[2], v0[3]); w.z = cvt_pk_bf16(v1[0], v1[1]); w.w = cvt_pk_bf16(v1[2], v1[3]);
                        *(u32x4*)(rowp + bj * HALF) = w; } }
        } else {
            const int col0 = wc * 32 + 8 * fq;
#pragma unroll
            for (int ai = 0; ai < 2; ++ai)
#pragma unroll
                for (int m = 0; m < 4; ++m) { float* rowp = SMALL + (size_t)(row0 + ai * HALF + m * 16) * 256 + col0;
#pragma unroll
                    for (int bj = 0; bj < 2; ++bj) { *(f32x4*)(rowp + bj * HALF) = acc[ai][bj][m][0]; *(f32x4*)(rowp + bj * HALF + 4) = acc[ai][bj][m][1]; } }
        }
    }
};

template <int STEP> struct EpiMerge {
    static constexpr bool PERM = true, AFTER_DRAIN = false;
    const bf16_t* G; float* MACC; bf16_t* OUT;
    __device__ __forceinline__ void operator()(const f32x4 (&acc)[2][2][4][2], const Unit& u, int wr, int wc, int fr, int fq) const {
        const int row0 = u.pm * BM + wr * 64 + fr, col0 = u.pn * BM + wc * 32 + 8 * fq;
#pragma unroll
        for (int ai = 0; ai < 2; ++ai)
#pragma unroll
            for (int m = 0; m < 4; ++m) { const size_t ro = (size_t)(row0 + ai * HALF + m * 16) * 2048 + col0;
#pragma unroll
                for (int bj = 0; bj < 2; ++bj) { const size_t o = ro + bj * HALF;
                    const u32x4 g = *(const u32x4*)(G + o);
                    f32x4 r0 = acc[ai][bj][m][0] * (f32x4){bf_lo(g.x), bf_hi(g.x), bf_lo(g.y), bf_hi(g.y)};
                    f32x4 r1 = acc[ai][bj][m][1] * (f32x4){bf_lo(g.z), bf_hi(g.z), bf_lo(g.w), bf_hi(g.w)};
                    if (STEP > 0) { r0 += *(const f32x4*)(MACC + o); r1 += *(const f32x4*)(MACC + o + 4); }
                    if (STEP < 2) { *(f32x4*)(MACC + o) = r0; *(f32x4*)(MACC + o + 4) = r1; }
                    else { u32x4 w; w.x = cvt_pk_bf16(r0[0], r0[1]); w.y = cvt_pk_bf16(r0[2], r0[3]); w.z = cvt_pk_bf16(r1[0], r1[1]); w.w = cvt_pk_bf16(r1[2], r1[3]); *(u32x4*)(OUT + o) = w; } } }
    }
};

struct EpiResid {
    static constexpr bool PERM = false, AFTER_DRAIN = false;
    const float* Xin; const float* gate; float* PRE; float alpha;
    __device__ __forceinline__ void operator()(const f32x4 (&acc)[2][2][4][2], const Unit& u, int wr, int wc, int fr, int fq) const {
        const int row0 = u.pm * BM + wr * 64 + fr, col0 = u.pn * BM + wc * 32 + 4 * fq; const float* gp = gate + (size_t)(u.pm >> 3) * 12288 + col0;
        f32x4 gv[2][2];
#pragma unroll
        for (int bj = 0; bj < 2; ++bj)
#pragma unroll
            for (int n = 0; n < 2; ++n) gv[bj][n] = *(const f32x4*)(gp + bj * HALF + n * 16);
#pragma unroll
        for (int ai = 0; ai < 2; ++ai)
#pragma unroll
            for (int m = 0; m < 4; ++m) { const size_t ro = (size_t)(row0 + ai * HALF + m * 16) * 2048 + col0;
#pragma unroll
                for (int bj = 0; bj < 2; ++bj)
#pragma unroll
                    for (int n = 0; n < 2; ++n) { const size_t o = ro + bj * HALF + n * 16; const f32x4 xv = *(const f32x4*)(Xin + o);
                        *(f32x4*)(PRE + o) = xv * alpha + gv[bj][n] * acc[ai][bj][m][n]; } }
    }
};

struct EpiRelu2 {
    static constexpr bool PERM = true, AFTER_DRAIN = false;
    bf16_t* O; int ldc;
    __device__ __forceinline__ void operator()(const f32x4 (&acc)[2][2][4][2], const Unit& u, int wr, int wc, int fr, int fq) const {
        const int row0 = u.pm * BM + wr * 64 + fr, col0 = u.pn * BM + wc * 32 + 8 * fq;
#pragma unroll
        for (int ai = 0; ai < 2; ++ai)
#pragma unroll
            for (int m = 0; m < 4; ++m) { bf16_t* rowp = O + (size_t)(row0 + ai * HALF + m * 16) * ldc + col0;
#pragma unroll
                for (int bj = 0; bj < 2; ++bj) { f32x4 v0 = acc[ai][bj][m][0], v1 = acc[ai][bj][m][1];
                    v0 = __builtin_elementwise_max(v0, (f32x4){0.f, 0.f, 0.f, 0.f}); v1 = __builtin_elementwise_max(v1, (f32x4){0.f, 0.f, 0.f, 0.f}); v0 = v0 * v0; v1 = v1 * v1;
                    u32x4 w; w.x = cvt_pk_bf16(v0[0], v0[1]); w.y = cvt_pk_bf16(v0[2], v0[3]); w.z = cvt_pk_bf16(v1[0], v1[1]); w.w = cvt_pk_bf16(v1[2], v1[3]);
                    *(u32x4*)(rowp + bj * HALF) = w; } }
    }
};
}

#define GAS __attribute__((address_space(1)))
#define LAS __attribute__((address_space(3)))
typedef unsigned short bf16;
typedef unsigned v4u __attribute__((ext_vector_type(4)));
typedef float f32x4 __attribute__((ext_vector_type(4)));
typedef short bf16x8 __attribute__((ext_vector_type(8)));
typedef GAS unsigned gu32;
typedef GAS unsigned long long gu64;
#define RLX_AGENT __ATOMIC_RELAXED, __HIP_MEMORY_SCOPE_AGENT
#define LDS_WAIT() asm volatile("s_waitcnt lgkmcnt(0)" ::: "memory")
#define VM_WAIT() asm volatile("s_waitcnt vmcnt(0)" ::: "memory")
__device__ __forceinline__ unsigned long long rt() { return __builtin_amdgcn_s_memrealtime(); }
__device__ __forceinline__ unsigned f2bf(float f) { unsigned u = __builtin_bit_cast(unsigned, f); return (u + 0x7fffu + ((u >> 16) & 1u)) >> 16; }
__device__ __forceinline__ unsigned pk2(float lo, float hi) { return f2bf(lo) | (f2bf(hi) << 16); }

#define XB_TMO      128
#define XB_XCNT(j)  (256  + 64 * (j))
#define XB_XSUB(j)  (1280 + 64 * (j))
#define XB_XGEN(j)  (2304 + 64 * (j))
#define XB_TOP      3328
#define XB_TOPGEN   3392
#define XCD_BAR_WORDS 3456
#define XB_SPIN_CAP (1u << 18)

__device__ __forceinline__ unsigned xb_ld(unsigned* p)              { return __hip_atomic_load(p, __ATOMIC_RELAXED, __HIP_MEMORY_SCOPE_AGENT); }
__device__ __forceinline__ unsigned xb_add(unsigned* p, unsigned v) { return __hip_atomic_fetch_add(p, v, __ATOMIC_RELAXED, __HIP_MEMORY_SCOPE_AGENT); }
__device__ __forceinline__ unsigned xb_xcc_id() { return (unsigned)__builtin_amdgcn_s_getreg((3 << 11) | 20) & 0xFu; }
#define XB_SPIN(cond, bar) do { unsigned _sp = 0; while (cond) { __builtin_amdgcn_s_sleep(1); \
    if ((++_sp & 255u) == 0u) { if (xb_ld(&(bar)[XB_TMO])) break; if (_sp > XB_SPIN_CAP) { atomicAdd(&(bar)[XB_TMO], 1u); break; } } } } while (0)

struct XcdBarrier {
    unsigned* bar; unsigned x;
    volatile LAS unsigned* st;
};

__device__ __forceinline__ XcdBarrier xcd_barrier_post(unsigned* bar, volatile LAS unsigned* st) {
    XcdBarrier b; b.bar = bar; b.x = xb_xcc_id(); b.st = st;
    if (threadIdx.x == 0) (void)xb_add(&bar[XB_XCNT(b.x)], 1u);
    return b;
}
__device__ __forceinline__ void xcd_barrier_complete(unsigned* bar, unsigned x, unsigned& nloc, unsigned& nx) {
    const unsigned G = gridDim.x * gridDim.y * gridDim.z;
    unsigned sum, cnt, mine, sp = 0u;
    for (;;) {
        sum = 0u; cnt = 0u; mine = 0u;
#pragma unroll
        for (unsigned j = 0; j < 16; ++j) { const unsigned c = xb_ld(&bar[XB_XCNT(j)]); sum += c; cnt += (c > 0u) ? 1u : 0u; mine = (j == x) ? c : mine; }
        if (sum == G) break;
        __builtin_amdgcn_s_sleep(1);
        if ((++sp & 255u) == 0u) { if (xb_ld(&bar[XB_TMO])) break; if (sp > XB_SPIN_CAP) { atomicAdd(&bar[XB_TMO], 1u); break; } }
    }
    nloc = mine > 0u ? mine : 1u; nx = cnt > 0u ? cnt : 1u;
}

__device__ __forceinline__ void xcd_barrier(const XcdBarrier& b) {
    asm volatile("s_waitcnt vmcnt(0)" ::: "memory");
    __syncthreads();
    if (threadIdx.x == 0) {
        unsigned* bar = b.bar;
        __builtin_amdgcn_s_waitcnt(0);
        unsigned nloc = b.st[0], nx = b.st[1];
        if (nloc == 0u) { xcd_barrier_complete(bar, b.x, nloc, nx); b.st[0] = nloc; b.st[1] = nx; }
        const unsigned old = xb_add(&bar[XB_XSUB(b.x)], 1u);
        const unsigned gen = old / nloc;
        if (old + 1u == (gen + 1u) * nloc) {
            __builtin_amdgcn_fence(__ATOMIC_RELEASE, "agent");
            asm volatile("s_waitcnt vmcnt(0)" ::: "memory");
            const unsigned og = xb_add(&bar[XB_TOP], 1u);
            const unsigned tg = og / nx;
            if (og + 1u == (tg + 1u) * nx) xb_add(&bar[XB_TOPGEN], 1u);
            else XB_SPIN(xb_ld(&bar[XB_TOPGEN]) == tg, bar);
            __builtin_amdgcn_fence(__ATOMIC_ACQUIRE, "agent");
            xb_add(&bar[XB_XGEN(b.x)], 1u);
            asm volatile("s_waitcnt vmcnt(0)" ::: "memory");
        } else {
            XB_SPIN(xb_ld(&bar[XB_XGEN(b.x)]) == gen, bar);
            __builtin_amdgcn_fence(__ATOMIC_ACQUIRE, "agent");
            asm volatile("s_waitcnt vmcnt(0)" ::: "memory");
        }
    }
    __syncthreads();
}

#include <hip/hip_bf16.h>
namespace fox {
using TIN = __hip_bfloat16; using TOUT = __hip_bfloat16;
constexpr int D = 128, PITCH = 2048;
constexpr float THR = 8.f;
constexpr bool WSKIP = false;
constexpr float SCALE = 0.08838834764831845f;
constexpr int NW = 8, QBLK = 32, KVBLK = 64, QB = NW * QBLK;
constexpr int SHM_V = KVBLK * D * 2, SHM_K = KVBLK * D * 2;
constexpr int ATT_LDS_BYTES = 2 * SHM_V + 2 * SHM_K + NW * 64 * 4;


using bf16 = __hip_bfloat16;
typedef short bf16x8 __attribute__((ext_vector_type(8)));
typedef short s16x4 __attribute__((ext_vector_type(4)));
typedef float f32x16 __attribute__((ext_vector_type(16)));
typedef float f32x4 __attribute__((ext_vector_type(4)));
typedef unsigned u32x4 __attribute__((ext_vector_type(4)));
template <class A, class Bt> struct same_t { static constexpr bool v = false; };
template <class A> struct same_t<A, A> { static constexpr bool v = true; };

__device__ __forceinline__ void glds16(const void* gsrc, unsigned lds_dst) { unsigned keep;
    asm volatile("s_mov_b32 %0, m0\n\ts_mov_b32 m0, %2\n\ts_nop 0\n\tglobal_load_lds_dwordx4 %1, off\n\ts_mov_b32 m0, %0" : "=&s"(keep) : "v"(gsrc), "s"(lds_dst) : "memory"); }
#define KSWZ(row, colB) ((row) * 256 + ((colB) ^ (((row) & 7) << 4)))
#define SBAR() __builtin_amdgcn_sched_barrier(0)
__device__ __forceinline__ int v_st(int k, int c) { const int kk = (k & ~0xC) | ((k & 4) << 1) | ((k & 8) >> 1); return ((kk >> 3) * 4 + (c >> 5)) * 512 + ((kk & 7) * 32 + (c & 31)) * 2; }
__device__ __forceinline__ int v_rd_base(int lane) { return ((lane & 3) << 3) | (((lane >> 2) & 3) << 6) | (((lane >> 4) & 1) << 5) | (((lane >> 5) & 1) << 8); }
constexpr int v_rd_off(int d0, int ks, int half) { return d0 * 512 + ks * 4096 + half * 2048; }
__device__ __forceinline__ int crow(int r, int hi) { return (r & 3) + 8 * (r >> 2) + 4 * hi; }
__device__ __forceinline__ unsigned cvtpk(float lo, float hi) {
    unsigned r; asm volatile("v_cvt_pk_bf16_f32 %0, %1, %2" : "=v"(r) : "v"(lo), "v"(hi)); return r;
}
__device__ __forceinline__ bf16x8 pack8(f32x4 a, f32x4 b) {
    u32x4 w = {cvtpk(a[0], a[1]), cvtpk(a[2], a[3]), cvtpk(b[0], b[1]), cvtpk(b[2], b[3])};
    return *reinterpret_cast<bf16x8*>(&w);
}
template <class T> __device__ __forceinline__ bf16x8 load8(const T* p) {
    if constexpr (same_t<T, float>::v) { return pack8(*(const f32x4*)p, *(const f32x4*)(p + 4)); }
    else { return *reinterpret_cast<const bf16x8*>(p); }
}
__device__ __forceinline__ void mask_tile(f32x16& p0, f32x16& p1, int dq, unsigned W) {
    const float NEG = -__builtin_inff();
#pragma unroll
    for (int r = 0; r < 16; ++r) {
        const int c = (r & 3) + 8 * (r >> 2);
        if ((unsigned)(dq - c) >= W) p0[r] = NEG;
        if ((unsigned)(dq - c - 32) >= W) p1[r] = NEG;
    }
}
__device__ __forceinline__ void partialSM(f32x16& p0, f32x16& p1, float& m_reg, float& mn, float& alpha) {
    float pmax = p0[0]; for (int r = 1; r < 16; ++r) pmax = fmaxf(pmax, p0[r]); for (int r = 0; r < 16; ++r) pmax = fmaxf(pmax, p1[r]);
    { auto rr = __builtin_amdgcn_permlane32_swap(__float_as_uint(pmax), __float_as_uint(pmax), false, false);
      pmax = fmaxf(__uint_as_float(rr[0]), __uint_as_float(rr[1])); }
    constexpr float C2 = 1.4426950408889634f * SCALE;
    if (__builtin_expect(__all((pmax - m_reg) * SCALE <= THR), 1)) { mn = m_reg; alpha = 1.f; }
    else { mn = fmaxf(m_reg, pmax); alpha = __builtin_amdgcn_exp2f((m_reg - mn) * C2); m_reg = mn; }
    const float mnL = -mn * C2;
    for (int r = 0; r < 16; ++r) p0[r] = fmaf(p0[r], C2, mnL); for (int r = 0; r < 16; ++r) p1[r] = fmaf(p1[r], C2, mnL);
    for (int r = 0; r < 16; ++r) p0[r] = __builtin_amdgcn_exp2f(p0[r]);
}
__device__ __forceinline__ void finishSM(f32x16& p0, f32x16& p1, float alpha, float& l_reg, bf16x8& pa0, bf16x8& pa1, bf16x8& pa2, bf16x8& pa3) {
    for (int r = 0; r < 16; ++r) p1[r] = __builtin_amdgcn_exp2f(p1[r]);
    float ps = 0; for (int r = 0; r < 16; ++r) ps += p0[r]; for (int r = 0; r < 16; ++r) ps += p1[r];
    { auto rr = __builtin_amdgcn_permlane32_swap(__float_as_uint(ps), __float_as_uint(ps), false, false);
      ps = __uint_as_float(rr[0]) + __uint_as_float(rr[1]); }
    l_reg = l_reg * alpha + ps;
#define PK4(P, B_, OUT) do { unsigned a0 = cvtpk(P[B_+0], P[B_+1]), a1 = cvtpk(P[B_+2], P[B_+3]);                          \
        unsigned b0 = cvtpk(P[B_+4], P[B_+5]), b1 = cvtpk(P[B_+6], P[B_+7]);                                             \
        auto r0 = __builtin_amdgcn_permlane32_swap(a0, b0, false, false); auto r1 = __builtin_amdgcn_permlane32_swap(a1, b1, false, false); \
        u32x4 w = {r0[0], r1[0], r0[1], r1[1]}; OUT = *reinterpret_cast<bf16x8*>(&w); } while (0)
    PK4(p0, 0, pa0); PK4(p0, 8, pa1); PK4(p1, 0, pa2); PK4(p1, 8, pa3);
#undef PK4
}
template <int KB, bool SK>
__device__ __forceinline__ void qkt(f32x16& p0, f32x16& p1, const char* K_lds, int r32, int hi, const char* qr, bool act, const char* B_lds, int lane) {
    if (SK && !act) { const float NEG = -__builtin_inff();
#pragma unroll
        for (int r = 0; r < 16; ++r) { p0[r] = NEG; p1[r] = NEG; } return; }
    p0 = f32x16{}; p1 = f32x16{};
    const char* kb[4];
#pragma unroll
    for (int dd = 0; dd < 4; ++dd) kb[dd] = K_lds + KB * SHM_K + KSWZ(r32, (dd * 16 + hi * 8) * 2);
#pragma unroll
    for (int d0 = 0; d0 < 8; ++d0) { const char* a = kb[d0 & 3] + (d0 >> 2) * 128;
        bf16x8 b0 = *reinterpret_cast<const bf16x8*>(a);
        bf16x8 b1 = *reinterpret_cast<const bf16x8*>(a + 32 * 256);
        const bf16x8 qf = *reinterpret_cast<const bf16x8*>(qr + d0 * 1024);
        p0 = __builtin_amdgcn_mfma_f32_32x32x16_bf16(b0, qf, p0, 0, 0, 0);
        p1 = __builtin_amdgcn_mfma_f32_32x32x16_bf16(b1, qf, p1, 0, 0, 0); }
    { const unsigned o1 = hi ? 0u : 0x3F803F80u, o2 = hi ? 0u : 0x3F80u; const u32x4 qw = {o1, o2, 0u, 0u}; const bf16x8 qo = *reinterpret_cast<const bf16x8*>(&qw);
      const bf16x8 bk0 = *reinterpret_cast<const bf16x8*>(B_lds + KB * 2048 + lane * 16), bk1 = *reinterpret_cast<const bf16x8*>(B_lds + KB * 2048 + 1024 + lane * 16);
      p0 = __builtin_amdgcn_mfma_f32_32x32x16_bf16(bk0, qo, p0, 0, 0, 0);
      p1 = __builtin_amdgcn_mfma_f32_32x32x16_bf16(bk1, qo, p1, 0, 0, 0); }
}
template <int VB, bool SK>
__device__ __forceinline__ void pv_tile(f32x16* o, int vb0, bf16x8 pa0, bf16x8 pa1, bf16x8 pa2, bf16x8 pa3, bool act) {
    if (SK && !act) return;
#define TRRD(dst, off) asm volatile("ds_read_b64_tr_b16 %0, %1 offset:%2" : "=&v"(dst) : "v"(vb0), "i"(off) : "memory")
#define PV_D0(d0) do { s16x4 l0, l1, l2, l3, h0, h1, h2, h3; constexpr int b_ = VB * SHM_V + v_rd_off(d0, 0, 0);     \
        TRRD(l0, b_); TRRD(h0, b_ + 2048); TRRD(l1, b_ + 4096); TRRD(h1, b_ + 6144); TRRD(l2, b_ + 8192); TRRD(h2, b_ + 10240); TRRD(l3, b_ + 12288); TRRD(h3, b_ + 14336); \
        asm volatile("s_waitcnt lgkmcnt(0)" ::: "memory"); SBAR();                 \
        o[d0] = __builtin_amdgcn_mfma_f32_32x32x16_bf16(pa0, (bf16x8){l0[0], l0[1], l0[2], l0[3], h0[0], h0[1], h0[2], h0[3]}, o[d0], 0, 0, 0);   \
        o[d0] = __builtin_amdgcn_mfma_f32_32x32x16_bf16(pa1, (bf16x8){l1[0], l1[1], l1[2], l1[3], h1[0], h1[1], h1[2], h1[3]}, o[d0], 0, 0, 0);   \
        o[d0] = __builtin_amdgcn_mfma_f32_32x32x16_bf16(pa2, (bf16x8){l2[0], l2[1], l2[2], l2[3], h2[0], h2[1], h2[2], h2[3]}, o[d0], 0, 0, 0);   \
        o[d0] = __builtin_amdgcn_mfma_f32_32x32x16_bf16(pa3, (bf16x8){l3[0], l3[1], l3[2], l3[3], h3[0], h3[1], h3[2], h3[3]}, o[d0], 0, 0, 0); } while (0)
    PV_D0(0); PV_D0(1); PV_D0(2); PV_D0(3);
#undef PV_D0
#undef TRRD
}

template <class TIn, class TOut> struct BlockRef { const TIn* Q; const TIn* K; const TIn* V; TOut* O; const char* FK; const char* Z16; int P0; };
template <class TIn> struct Seam {
    bf16x8 st_v0, st_v1, st_k0, st_k1; f32x4 sf0, sf1, sf2, sf3;
    f32x4 tq[16];
};
__device__ __forceinline__ int swa_jlo(int P0, int W) { const int lowk = P0 - W + 1; return lowk > 0 ? lowk / KVBLK : 0; }
#define ROW(p, k0, rr) ((p) + (size_t)((k0) + (rr)) * PITCH + sc)
#define VMW() asm volatile("s_waitcnt vmcnt(0)" ::: "memory")
#define VMWN(n) asm volatile("s_waitcnt vmcnt(%0)" :: "i"(n) : "memory")
#define SLOAD_H(Kp, Vp, k0) do { S.st_v0 = load8<TIn>(ROW(Vp, k0, sr)); S.st_v1 = load8<TIn>(ROW(Vp, k0, 32 + sr));              \
                         S.st_k0 = load8<TIn>(ROW(Kp, k0, sr)); S.st_k1 = load8<TIn>(ROW(Kp, k0, 32 + sr)); } while (0)
#define LOADB(ref, k0, bf) do { if (wid == 0) { const char* g0_ = hi ? (ref).Z16 : (ref).FK + (size_t)((k0) + r32) * 16; const char* g1_ = hi ? (ref).Z16 : (ref).FK + (size_t)((k0) + 32 + r32) * 16; \
        const unsigned l0_ = (unsigned)(uintptr_t)B_lds + (bf) * 2048; glds16(g0_, l0_); glds16(g1_, l0_ + 1024); } } while (0)
#define SWRITE_HK(bf) do { *(bf16x8*)(K_lds + (bf) * SHM_K + kws) = S.st_k0; *(bf16x8*)(K_lds + (bf) * SHM_K + kws + 32 * 256) = S.st_k1; } while (0)
#define SWRITE_HV(bf) do { *(bf16x8*)(V_lds + (bf) * SHM_V + vst0) = S.st_v0; *(bf16x8*)(V_lds + (bf) * SHM_V + vst1) = S.st_v1; } while (0)
#define SWRITE_H(bf) do { SWRITE_HV(bf); SWRITE_HK(bf); } while (0)
#define SLOAD_F(p, k0) do { S.sf0 = *(const f32x4*)ROW(p, k0, sr); S.sf1 = *(const f32x4*)(ROW(p, k0, sr) + 4);                \
                            S.sf2 = *(const f32x4*)ROW(p, k0, 32 + sr); S.sf3 = *(const f32x4*)(ROW(p, k0, 32 + sr) + 4); } while (0)
#define SWRITE_KF(bf) do { *(bf16x8*)(K_lds + (bf) * SHM_K + kws) = pack8(S.sf0, S.sf1); *(bf16x8*)(K_lds + (bf) * SHM_K + kws + 32 * 256) = pack8(S.sf2, S.sf3); } while (0)
#define SWRITE_VF(bf) do { *(bf16x8*)(V_lds + (bf) * SHM_V + vst0) = pack8(S.sf0, S.sf1); *(bf16x8*)(V_lds + (bf) * SHM_V + vst1) = pack8(S.sf2, S.sf3); } while (0)
template <class TIn, class TOut>
__device__ __forceinline__ void causal_swa_prime(const BlockRef<TIn, TOut>& cur, int W, char* lds, Seam<TIn>& S) {
    constexpr bool F32 = same_t<TIn, float>::v;
    int tid_l = threadIdx.x; asm volatile("" : "+v"(tid_l));
    const int tid = tid_l, wid = __builtin_amdgcn_readfirstlane(tid >> 6), lane = tid & 63, r32 = lane & 31, hi = lane >> 5;
    const int sr = tid >> 4, sc = (tid & 15) * 8, kws = KSWZ(sr, sc * 2); char* K_lds = lds + 2 * SHM_V; char* B_lds = lds + ATT_LDS_BYTES;
    const int kb0 = swa_jlo(cur.P0, W) * KVBLK;
    for (int d0 = 0; d0 < 8; ++d0) glds16(cur.Q + (size_t)(wid * QBLK + r32) * PITCH + d0 * 16 + hi * 8, (unsigned)(uintptr_t)(lds + ATT_LDS_BYTES + 4096) + wid * 8192 + d0 * 1024);
    LOADB(cur, kb0, 0);
    if constexpr (F32) { SLOAD_F((const float*)cur.K, kb0); VMW(); SWRITE_KF(0); SBAR(); SLOAD_F((const float*)cur.V, kb0); }
    else { SLOAD_H(cur.K, cur.V, kb0); VMW(); SWRITE_HK(0); }
    __syncthreads();
}
template <class TIn, class TOut>
__device__ __forceinline__ void causal_swa_block(const BlockRef<TIn, TOut>& cur, const BlockRef<TIn, TOut>& nxt, int skv, int W, char* lds, Seam<TIn>& S) {
    constexpr bool F32 = same_t<TIn, float>::v;
    int tid_l = threadIdx.x; asm volatile("" : "+v"(tid_l));
    const int tid = tid_l, wid = __builtin_amdgcn_readfirstlane(tid >> 6), lane = tid & 63, r32 = lane & 31, hi = lane >> 5;
    const int j_lo = swa_jlo(cur.P0, W);
    int j_hi = (cur.P0 + QB - 1) / KVBLK + 1; if (j_hi > skv / KVBLK) j_hi = skv / KVBLK;
    const int NT = j_hi - j_lo;
    const int kbn = swa_jlo(nxt.P0, W) * KVBLK;
    const int qlo = cur.P0 + wid * QBLK, qm = qlo + r32 - 4 * hi;
    char* V_lds = lds; char* K_lds = lds + 2 * SHM_V; const char* Qw = lds + ATT_LDS_BYTES + 4096 + wid * 8192 + lane * 16;
    char* B_lds = lds + ATT_LDS_BYTES;
    float* ws = (float*)(lds + 2 * SHM_V + 2 * SHM_K) + wid * 64; float* li_l = ws, * al_l = ws + 32;
    float m_reg = -1e30f, l_reg = 0; f32x16 o[4] = {};
    const int sr = tid >> 4, sc = (tid & 15) * 8, vst0 = v_st(sr, sc), vst1 = v_st(32 + sr, sc), kws = KSWZ(sr, sc * 2);
    const int vb0 = (int)(uintptr_t)V_lds + v_rd_base(lane);
    const TIn* Kh = cur.K; const TIn* Vh = cur.V;
#define RESC(a) do { if (__any((a) < 1.f)) { if (hi == 0) al_l[r32] = (a); asm volatile("s_waitcnt lgkmcnt(0)" ::: "memory");              \
                     for (int d_ = 0; d_ < 4; ++d_) for (int r = 0; r < 16; ++r) o[d_][r] *= al_l[crow(r, hi)]; } } while (0)
#define KBASE(t) ((j_lo + (t)) * KVBLK)
#define ACT(t) (KBASE(t) <= qlo + QBLK - 1 && KBASE(t) + KVBLK - 1 >= qlo - W + 1)
#define MASKT(P0_, P1_, t) do { const int kb_ = KBASE(t); if ((!SK || ACT(t)) && (kb_ + KVBLK - 1 > qlo || kb_ <= qlo + QBLK - 1 - W)) mask_tile(P0_, P1_, qm - kb_, (unsigned)W); } while (0)
    constexpr int NQL = F32 ? 16 : 8;
    constexpr bool SK = WSKIP && !F32;
#define SEAM_K0() do { VMWN(NQL); if constexpr (F32) { SWRITE_KF(0); SBAR(); SLOAD_F((const float*)nxt.V, kbn); } else { SWRITE_HK(0); } SBAR(); } while (0)
    f32x16 pA0, pA1, pB0, pB1; float mnA, mnB, alA, alB; bf16x8 pa0, pa1, pa2, pa3;
    if constexpr (F32) { VMW(); SWRITE_VF(0); SBAR(); } else { VMW(); SWRITE_HV(0); SBAR(); }
    if (NT > 1) { if constexpr (F32) SLOAD_F((const float*)Kh, KBASE(1)); else SLOAD_H(Kh, Vh, KBASE(1)); }
    SBAR(); qkt<0, SK>(pA0, pA1, K_lds, r32, hi, Qw, ACT(0), B_lds, lane); if (NT > 1) LOADB(cur, KBASE(1), 1);
    if constexpr (F32) { if (NT > 1) { VMW(); SWRITE_KF(1); SBAR(); SLOAD_F((const float*)Vh, KBASE(1)); } }
    MASKT(pA0, pA1, 0); partialSM(pA0, pA1, m_reg, mnA, alA);
    if (NT > 1) { VMW(); if constexpr (F32) { SWRITE_VF(1); SBAR(); if (NT > 2) SLOAD_F((const float*)Kh, KBASE(2)); } else SWRITE_H(1); }
    __syncthreads();
#define HALF_STEP(PX0, PX1, mnX, alX, PY0, PY1, alY, t, KB, VB, SB) do {                                                      \
        SBAR(); qkt<KB, SK>(PX0, PX1, K_lds, r32, hi, Qw, ACT(t), B_lds, lane);                                   \
        finishSM(PY0, PY1, alY, l_reg, pa0, pa1, pa2, pa3); SBAR();                                                           \
        if ((t) + 1 < NT) { if constexpr (F32) { VMW(); SWRITE_KF(SB); SBAR(); SLOAD_F((const float*)Vh, KBASE((t) + 1)); }  \
                            else { SLOAD_H(Kh, Vh, KBASE((t) + 1)); LOADB(cur, KBASE((t) + 1), SB); } SBAR(); }              \
        pv_tile<VB, SK>(o, vb0, pa0, pa1, pa2, pa3, ACT((t) - 1)); MASKT(PX0, PX1, (t)); partialSM(PX0, PX1, m_reg, mnX, alX);                                        \
        __syncthreads();                                                                                                      \
        if ((t) + 1 < NT) { VMW(); if constexpr (F32) { SWRITE_VF(SB); SBAR(); if ((t) + 2 < NT) SLOAD_F((const float*)Kh, KBASE((t) + 2)); } \
                            else { SWRITE_H(SB); } }                                                                          \
        RESC(alX); __syncthreads(); } while (0)
    for (int t = 1; t + 1 < NT; t += 2) {
        HALF_STEP(pB0, pB1, mnB, alB, pA0, pA1, alA, t, 1, 0, 0);
        HALF_STEP(pA0, pA1, mnA, alA, pB0, pB1, alB, t + 1, 0, 1, 1);
    }
    const bool even = (NT & 1) == 0;
    if (even) { SBAR(); qkt<1, SK>(pB0, pB1, K_lds, r32, hi, Qw, ACT(NT - 1), B_lds, lane); SBAR(); }
#define QROW(e) (nxt.Q + (size_t)(wid * QBLK + r32) * PITCH + ((e) >> 1) * 16 + hi * 8 + ((e) & 1) * 4)
    if constexpr (F32) { SLOAD_F((const float*)nxt.K, kbn); SBAR();
#pragma unroll
        for (int e = 0; e < 8; ++e) S.tq[e] = *(const f32x4*)QROW(e); }
    else { SLOAD_H(nxt.K, nxt.V, kbn); LOADB(nxt, kbn, 0); SBAR();
#pragma unroll
        for (int d0 = 0; d0 < 8; ++d0) glds16(nxt.Q + (size_t)(wid * QBLK + r32) * PITCH + d0 * 16 + hi * 8, (unsigned)(uintptr_t)(lds + ATT_LDS_BYTES + 4096) + wid * 8192 + d0 * 1024); }
    SBAR();
    finishSM(pA0, pA1, alA, l_reg, pa0, pa1, pa2, pa3); SBAR();
    if constexpr (F32) {
#pragma unroll
        for (int e = 8; e < 16; ++e) S.tq[e] = *(const f32x4*)QROW(e); SBAR(); }
#undef QROW
    pv_tile<0, SK>(o, vb0, pa0, pa1, pa2, pa3, ACT(even ? NT - 2 : NT - 1));
    if (even) { MASKT(pB0, pB1, NT - 1); partialSM(pB0, pB1, m_reg, mnB, alB); __syncthreads(); RESC(alB);
        finishSM(pB0, pB1, alB, l_reg, pa0, pa1, pa2, pa3); SBAR(); pv_tile<1, SK>(o, vb0, pa0, pa1, pa2, pa3, ACT(NT - 1)); }
    SBAR(); SEAM_K0();
    if (hi == 0) li_l[r32] = l_reg; asm volatile("s_waitcnt lgkmcnt(0)" ::: "memory");
    float rli[16];
#pragma unroll
    for (int r = 0; r < 16; ++r) rli[r] = __builtin_amdgcn_rcpf(li_l[crow(r, hi)]);
    TOut* Ow = cur.O + (size_t)(wid * QBLK) * PITCH;
#pragma unroll
    for (int r = 0; r < 16; ++r) { const int orow = crow(r, hi);
#pragma unroll
        for (int d0 = 0; d0 < 4; ++d0) { const float v = o[d0][r] * rli[r];
            if constexpr (same_t<TOut, float>::v) { Ow[(size_t)orow * PITCH + d0 * 32 + r32] = v; }
            else { const float vn = __shfl_xor(v, 1);
                   if ((r32 & 1) == 0) *(unsigned*)(Ow + (size_t)orow * PITCH + d0 * 32 + r32) = cvtpk(v, vn); } } }
    __syncthreads();
#undef RESC
#undef KBASE
#undef ACT
#undef MASKT
#undef SEAM_K0
#undef HALF_STEP
}
#undef ROW
#undef VMW
#undef VMWN
#undef SLOAD_H
#undef SWRITE_HK
#undef SWRITE_HV
#undef SWRITE_H
#undef SLOAD_F
#undef SWRITE_KF
#undef SWRITE_VF

#undef LOADB
}

constexpr int NWAVES = 8, NT = NWAVES * 64;
constexpr int BATCH = 4, SEQ = 2048, D = 2048, M = BATCH * SEQ, FF = 8192, DEPTH = 2;
constexpr int INW = 26704, NPAD = 26880;
constexpr int MODW = 6 * D;
constexpr float LN_EPS = 1e-5f, NORM_EPS = 1e-6f, ALPHA = 1.4142135623730951f;
constexpr size_t MiB = 1u << 20;
constexpr size_t ACT_E = (size_t)M * D;
constexpr size_t WS_CTL = 0, CTL_ZERO_BYTES = 1 * MiB;
constexpr size_t WS_MODP = 2 * MiB;
constexpr size_t WS_MOD = 8 * MiB;
constexpr size_t WS_SMALL = 10 * MiB;
constexpr size_t WS_CUM = 18 * MiB;
constexpr size_t WS_BETA = 19 * MiB, WS_GG = 20 * MiB;
constexpr size_t WS_FKB = 21 * MiB;
constexpr size_t WS_W = 32 * MiB;
constexpr size_t W_LAYER = 201 * MiB, W_IN = 0, W_A = 105 * MiB, W_B = 113 * MiB, W_C = 121 * MiB, W_O = 129 * MiB, W_1 = 137 * MiB, W_2 = 169 * MiB;
constexpr size_t WS_U = 448 * MiB;
constexpr size_t WS_X = 480 * MiB;
constexpr size_t WS_PRE = 544 * MiB;
constexpr size_t WS_T = 608 * MiB;
constexpr size_t WS_H = 608 * MiB;
constexpr size_t WS_YA = 1024 * MiB, WS_YB = 1056 * MiB, WS_YC = 1088 * MiB, WS_MG = 1120 * MiB;
constexpr size_t WS_MACC = 1152 * MiB;
constexpr size_t WS_QNB = 1216 * MiB, WS_KNB = 1248 * MiB;
constexpr size_t WS_KTP = 1280 * MiB;
constexpr size_t WS_VTP = 1312 * MiB;
constexpr size_t WS_TP = 1344 * MiB, WS_IP = 1376 * MiB;
constexpr size_t WS_ORAW = 1408 * MiB;
constexpr size_t WS_GCUM = 24 * MiB;
constexpr size_t WS_END = 1472 * MiB;
constexpr int CW_BAR = 4096;
constexpr int LDS_BYTES = 147456, MISC_OFF = LDS_BYTES - 512;
enum { TI_CB = 0, TI_CC, TI_CH, TI_GQ, TI_GK, TI_GV, TI_GZ, TI_FQ, TI_FK, TI_FV, TI_MA, TI_MB, TI_MC };
__host__ __device__ constexpr int src_off(int t) { return t < 7 ? 2048 * t : (t < 10 ? 14400 + 2048 * (t - 7) : 20560 + 2048 * (t - 10)); }
constexpr int SRC_GB = 14336, SRC_FF = 20544;
enum { I_X = 0, I_C, I_WADA, I_BADA, I_WIN, I_CONVW, I_GCONVW, I_ALOG, I_DTB, I_GNORMW, I_FBIAS, I_WA, I_WB, I_WC, I_WO, I_LN1G, I_LN1B, I_W1, I_W2, I_LN2G, I_LN2B, N_IN };

typedef unsigned u32x4 __attribute__((ext_vector_type(4)));
typedef unsigned u32x2 __attribute__((ext_vector_type(2)));
__device__ __forceinline__ float wave_sum(float v) {
#pragma unroll
    for (int o = 1; o < 64; o <<= 1) v += __shfl_xor(v, o);
    return v;
}
__device__ __forceinline__ float wave_max(float v) {
#pragma unroll
    for (int o = 1; o < 64; o <<= 1) v = fmaxf(v, __shfl_xor(v, o));
    return v;
}
__device__ __forceinline__ float bflo(unsigned w) { return __builtin_bit_cast(float, w << 16); }
__device__ __forceinline__ float bfhi(unsigned w) { return __builtin_bit_cast(float, w & 0xffff0000u); }
__device__ __forceinline__ void unpack8(const u32x4 w, float (&f)[8]) { f[0] = bflo(w.x); f[1] = bfhi(w.x); f[2] = bflo(w.y); f[3] = bfhi(w.y); f[4] = bflo(w.z); f[5] = bfhi(w.z); f[6] = bflo(w.w); f[7] = bfhi(w.w); }
__device__ __forceinline__ u32x4 pack8(const float (&f)[8]) { u32x4 w; w.x = pg8::cvt_pk_bf16(f[0], f[1]); w.y = pg8::cvt_pk_bf16(f[2], f[3]); w.z = pg8::cvt_pk_bf16(f[4], f[5]); w.w = pg8::cvt_pk_bf16(f[6], f[7]); return w; }
__device__ __forceinline__ float fsilu(float x) { return x * __builtin_amdgcn_rcpf(1.f + __expf(-x)); }

__device__ __forceinline__ void tr_item(const float* __restrict__ W, size_t ldw, bf16* __restrict__ WT, size_t K, int kb, int nb, int lane) {
    const int kq = lane & 7, nq = lane >> 3;
    const float* src = W + (size_t)(kb * 64 + kq * 8) * ldw + nb * 32 + nq * 4;
    f32x4 v[8];
#pragma unroll
    for (int i = 0; i < 8; ++i) v[i] = *(const f32x4*)(src + (size_t)i * ldw);
    bf16* dst = WT + (size_t)(nb * 32 + nq * 4) * K + kb * 64 + kq * 8;
#pragma unroll
    for (int j = 0; j < 4; ++j) { u32x4 o; o.x = pg8::cvt_pk_bf16(v[0][j], v[1][j]); o.y = pg8::cvt_pk_bf16(v[2][j], v[3][j]); o.z = pg8::cvt_pk_bf16(v[4][j], v[5][j]); o.w = pg8::cvt_pk_bf16(v[6][j], v[7][j]);
        *(u32x4*)(dst + (size_t)j * K) = o; }
}

__device__ __forceinline__ void modulate_row(const float* __restrict__ xr, bf16* __restrict__ ur, const float* __restrict__ shift, const float* __restrict__ scale, int lane) {
#pragma unroll
    for (int j = 0; j < 8; ++j) { const int c = 4 * lane + 256 * j; const f32x4 v = *(const f32x4*)(xr + c), sc = *(const f32x4*)(scale + c), sh = *(const f32x4*)(shift + c);
        const f32x4 y = v * (sc + 1.f) + sh; u32x2 o; o.x = pg8::cvt_pk_bf16(y[0], y[1]); o.y = pg8::cvt_pk_bf16(y[2], y[3]); *(u32x2*)(ur + c) = o; }
}
__device__ __forceinline__ void ln_mod_row(const float* __restrict__ pre, const float* __restrict__ g, const float* __restrict__ bt, float* __restrict__ xo, bf16* __restrict__ uo,
                                           const float* __restrict__ shift, const float* __restrict__ scale, int lane) {
    f32x4 v[8]; float s = 0.f;
#pragma unroll
    for (int j = 0; j < 8; ++j) { v[j] = *(const f32x4*)(pre + 4 * lane + 256 * j); s += (v[j][0] + v[j][1]) + (v[j][2] + v[j][3]); }
    const float mean = wave_sum(s) * (1.f / D); float s2 = 0.f;
#pragma unroll
    for (int j = 0; j < 8; ++j) { v[j] = v[j] - mean; s2 += (v[j][0] * v[j][0] + v[j][1] * v[j][1]) + (v[j][2] * v[j][2] + v[j][3] * v[j][3]); }
    const float rstd = 1.f / sqrtf(wave_sum(s2) * (1.f / D) + LN_EPS);
#pragma unroll
    for (int j = 0; j < 8; ++j) { const int c = 4 * lane + 256 * j; const f32x4 y = v[j] * rstd * *(const f32x4*)(g + c) + *(const f32x4*)(bt + c);
        *(f32x4*)(xo + c) = y;
        if (uo) { const f32x4 u = y * (*(const f32x4*)(scale + c) + 1.f) + *(const f32x4*)(shift + c); u32x2 o; o.x = pg8::cvt_pk_bf16(u[0], u[1]); o.y = pg8::cvt_pk_bf16(u[2], u[3]); *(u32x2*)(uo + c) = o; } }
}

struct Args { const float* in[N_IN]; float* out; unsigned char* ws; int ph_lo, ph_hi; };
constexpr int NPL = 11, NPH = 3 + DEPTH * NPL;

#define IN(k) (lo <= (k) && (k) < hi)
#define SEAM(k) do { if (IN(k) && IN((k) + 1)) xcd_barrier(bar); } while (0)
#define CAS __attribute__((address_space(4)))
#define AIN(i) ((const float*)(GAS const float*)ap->in[i])
#define PH_BEGIN \
    int tid = threadIdx.x; asm volatile("" : "+v"(tid)); const int lane = tid & 63, wave = __builtin_amdgcn_readfirstlane(tid >> 6); \
    const int gw = blk * NWAVES + wave, gtid = blk * NT + tid; (void)gw; (void)gtid; (void)lane; \
    const CAS Args* ap = (const CAS Args*)__builtin_amdgcn_kernarg_segment_ptr(); asm volatile("" : "+s"(ap));     \
    GAS unsigned char* ws_g = (GAS unsigned char*)ap->ws; asm volatile("" : "+s"(ws_g)); unsigned char* ws = (unsigned char*)ws_g;     \
    const float* x_in = AIN(I_X); (void)x_in; \
    float* modp = (float*)(ws + WS_MODP); float* mod = (float*)(ws + WS_MOD); float* SMALL = (float*)(ws + WS_SMALL); (void)modp; (void)mod; (void)SMALL; \
    float* CUM = (float*)(ws + WS_CUM); float* BETA = (float*)(ws + WS_BETA); float* GG = (float*)(ws + WS_GG); (void)CUM; (void)BETA; (void)GG; \
    bf16* U = (bf16*)(ws + WS_U); float* X = (float*)(ws + WS_X); float* PRE = (float*)(ws + WS_PRE); (void)U; (void)X; (void)PRE; \
    bf16* T = (bf16*)(ws + WS_T); bf16* H = (bf16*)(ws + WS_H); (void)T; (void)H; \
    bf16* YA = (bf16*)(ws + WS_YA); bf16* YB = (bf16*)(ws + WS_YB); bf16* YC = (bf16*)(ws + WS_YC); bf16* MG = (bf16*)(ws + WS_MG); (void)YA; (void)YB; (void)YC; (void)MG; \
    float* MACC = (float*)(ws + WS_MACC); bf16* QNB = (bf16*)(ws + WS_QNB); bf16* KNB = (bf16*)(ws + WS_KNB); bf16* KTP = (bf16*)(ws + WS_KTP); bf16* VTP = (bf16*)(ws + WS_VTP); \
    bf16* TP = (bf16*)(ws + WS_TP); bf16* IP = (bf16*)(ws + WS_IP); float* ORAW = (float*)(ws + WS_ORAW); float* GCUM = (float*)(ws + WS_GCUM); \
    (void)MACC; (void)QNB; (void)KNB; (void)KTP; (void)VTP; (void)TP; (void)IP; (void)ORAW; (void)GCUM;


template <int l> __device__ __forceinline__ void layer_phases(const int lo, const int hi, const XcdBarrier& bar, LAS unsigned char* lds, unsigned char* lds_raw, const int blk, const int G, const int NGW, const int NGT) {
        const int pb = 3 + l * NPL;
#define LAYER_PTRS unsigned char* wl = ws + WS_W + (size_t)l * W_LAYER; const float* modl = mod + (size_t)l * 4 * MODW; const float* Xin = (l == 0) ? x_in : X; (void)wl; (void)modl; (void)Xin;
        if (IN(pb + 0)) { PH_BEGIN LAYER_PTRS
            pg8::Gemm g{U, (const bf16*)(wl + W_IN), M, NPAD, D}; pg8::StaticOrder S; S.init(M, NPAD, G, blk);
            pg8::EpiInProj E{T, SMALL, ACT_E};
            pg8::gemm_phase<pg8::EpiInProj, pg8::StaticOrder, true, true>(lds, g, S, E);
        }
        SEAM(pb + 0);
        if (IN(pb + 1)) { PH_BEGIN LAYER_PTRS
            { const float* cw = AIN(I_CONVW) + (size_t)l * 3 * D; const bf16 *CB = T + TI_CB * ACT_E, *CC = T + TI_CC * ACT_E, *CH = T + TI_CH * ACT_E;
              for (int it = gtid; it < (M / 8) * 256; it += NGT) {
                const int col = (it & 255) * 8, m0 = (it >> 8) * 8; const bool first = (m0 & (SEQ - 1)) == 0;
                float w0[8], w1[8], w2[8], p2[8], p1[8];
#pragma unroll
                for (int i = 0; i < 8; ++i) { w0[i] = cw[col + i]; w1[i] = cw[D + col + i]; w2[i] = cw[2 * D + col + i]; p2[i] = 0.f; p1[i] = 0.f; }
                if (!first) { float a[8], b[8];
                    unpack8(*(const u32x4*)(CC + (size_t)(m0 - 2) * D + col), a); unpack8(*(const u32x4*)(CH + (size_t)(m0 - 2) * D + col), b);
#pragma unroll
                    for (int i = 0; i < 8; ++i) p2[i] = a[i] * b[i];
                    unpack8(*(const u32x4*)(CC + (size_t)(m0 - 1) * D + col), a); unpack8(*(const u32x4*)(CH + (size_t)(m0 - 1) * D + col), b);
#pragma unroll
                    for (int i = 0; i < 8; ++i) p1[i] = a[i] * b[i]; }
                for (int r = 0; r < 8; ++r) { const size_t o = (size_t)(m0 + r) * D + col; float a[8], b[8], g[8], y[8];
                    unpack8(*(const u32x4*)(CC + o), a); unpack8(*(const u32x4*)(CH + o), b); unpack8(*(const u32x4*)(CB + o), g);
#pragma unroll
                    for (int i = 0; i < 8; ++i) { const float p0 = a[i] * b[i]; y[i] = g[i] * (w0[i] * p2[i] + w1[i] * p1[i] + w2[i] * p0); p2[i] = p1[i]; p1[i] = p0; }
                    *(u32x4*)(YA + o) = pack8(y); }
              } }
            { const float* gcw = AIN(I_GCONVW) + (size_t)l * 4 * 6144;
              for (int it = gw; it < 6144; it += NGW) {
                const int cgp = it & 3, ten = (it >> 2) % 3, rb = it / 12; const int ch = cgp * 512 + lane * 8; const int m0 = rb * 16; const bool first = (m0 & (SEQ - 1)) == 0;
                const bf16* src = T + (size_t)(TI_GQ + ten) * ACT_E; bf16* dst = (ten == 0) ? QNB : KNB;
                const int bb = m0 >> 11, nn = (m0 & (SEQ - 1)) >> 6; bf16* tdst = (ten == 1) ? KTP + ((size_t)((bb * 32 + nn) * 16) * 128 + ch) * 64 : VTP + ((size_t)((bb * 32 + nn) * 32) * 64 + ch) * 64;
                float w[4][8], h3[8], h2[8], h1[8], yb[3][8];
#pragma unroll
                for (int i = 0; i < 8; ++i) { w[0][i] = gcw[ten * D + ch + i]; w[1][i] = gcw[6144 + ten * D + ch + i]; w[2][i] = gcw[2 * 6144 + ten * D + ch + i]; w[3][i] = gcw[3 * 6144 + ten * D + ch + i]; h3[i] = 0.f; h2[i] = 0.f; h1[i] = 0.f; }
                if (!first) { unpack8(*(const u32x4*)(src + (size_t)(m0 - 3) * D + ch), h3); unpack8(*(const u32x4*)(src + (size_t)(m0 - 2) * D + ch), h2); unpack8(*(const u32x4*)(src + (size_t)(m0 - 1) * D + ch), h1); }
#pragma unroll
                for (int r = 0; r < 16; ++r) { const size_t o = (size_t)(m0 + r) * D + ch; float h0[8], y[8]; unpack8(*(const u32x4*)(src + o), h0); float ss = 0.f;
#pragma unroll
                    for (int i = 0; i < 8; ++i) { const float a = w[0][i] * h3[i] + w[1][i] * h2[i] + w[2][i] * h1[i] + w[3][i] * h0[i]; y[i] = fsilu(a); ss += y[i] * y[i]; h3[i] = h2[i]; h2[i] = h1[i]; h1[i] = h0[i]; }
                    if (ten < 2) { ss += __shfl_xor(ss, 1); ss += __shfl_xor(ss, 2); ss += __shfl_xor(ss, 4); ss += __shfl_xor(ss, 8); const float rn = __builtin_amdgcn_rsqf(ss + NORM_EPS);
#pragma unroll
                        for (int i = 0; i < 8; ++i) y[i] *= rn;
                        *(u32x4*)(dst + o) = pack8(y); }
                    if (ten >= 1) {
                        if ((r & 3) < 3) {
#pragma unroll
                            for (int i = 0; i < 8; ++i) yb[r & 3][i] = y[i];
                        } else {
                            const int pos4 = ((m0 & 63) + r - 3), pp = (pos4 & 32) + 8 * ((pos4 >> 2) & 3) + 4 * ((pos4 >> 4) & 1);
#pragma unroll
                            for (int i = 0; i < 8; ++i) { u32x2 v; v.x = pg8::cvt_pk_bf16(yb[0][i], yb[1][i]); v.y = pg8::cvt_pk_bf16(yb[2][i], y[i]); *(u32x2*)(tdst + (size_t)i * 64 + pp) = v; }
                        } } }
              } }
            { const float* alog = AIN(I_ALOG) + l * 32; const float* dtb = AIN(I_DTB) + l * 32;
              for (int i = gtid; i < M * 32; i += NGT) { const int m = i >> 5, hv = i & 31; const float bl = SMALL[(size_t)m * 256 + hv], al = SMALL[(size_t)m * 256 + 32 + hv];
                BETA[i] = 1.f / (1.f + expf(-bl)); const float xx = al + dtb[hv]; const float sp = fmaxf(xx, 0.f) + log1pf(expf(-fabsf(xx))); GG[i] = -expf(alog[hv]) * sp; } }
            { const float* fbias = AIN(I_FBIAS) + l * 16;
              for (int it = gw; it < 64; it += NGW) { const int b = it >> 4, h = it & 15; const float fb = fbias[h]; const size_t mbase = (size_t)b * SEQ + lane * 32; float tot = 0.f;
                for (int i = 0; i < 32; ++i) { const float xx = SMALL[(mbase + i) * 256 + 64 + h] + fb; tot += fminf(xx, 0.f) - log1pf(expf(-fabsf(xx))); }
                float inc = tot;
#pragma unroll
                for (int o = 1; o < 64; o <<= 1) { const float n = __shfl_up(inc, o); if (lane >= o) inc += n; }
                float run = inc - tot;
                for (int i = 0; i < 32; ++i) { const float xx = SMALL[(mbase + i) * 256 + 64 + h] + fb; run += fminf(xx, 0.f) - log1pf(expf(-fabsf(xx))); CUM[(size_t)it * SEQ + lane * 32 + i] = run;
                    const float xq = run * 11.313708498984761f; const unsigned h1 = f2bf(xq); const float r1 = xq - __builtin_bit_cast(float, h1 << 16); const unsigned h2 = f2bf(r1); const float r2 = r1 - __builtin_bit_cast(float, h2 << 16); const unsigned h3 = f2bf(r2);
                    const unsigned n1 = h1 ^ 0x8000u, n2 = h2 ^ 0x8000u, n3 = h3 ^ 0x8000u;
                    *((u32x4*)(ws + WS_FKB) + ((size_t)it * SEQ + lane * 32 + i)) = (u32x4){n1 | (n2 << 16), n3, 0u, 0u}; }
              } }
        }
        SEAM(pb + 1);
        if (IN(pb + 2)) { PH_BEGIN LAYER_PTRS
            LAS float* Ll = (LAS float*)lds;
            LAS float* GCl = (LAS float*)(lds + 131072);
            LAS float* BTl = GCl + 512;
            const int lane_o = lane;
            for (int it = blk; it < 512; it += G) {
                int lane = lane_o; asm volatile("" : "+v"(lane));
                const int fr = lane & 15, fq = lane >> 4;
                const int b = it >> 7, hk = (it >> 3) & 15, cq = it & 7; const int row0 = b * SEQ + cq * 256;
                __syncthreads();
                { const int e = wave >> 2, c = wave & 3, hv = 2 * hk + e; const size_t mm = (size_t)row0 + c * 64 + lane;
                  float gv = GG[mm * 32 + hv]; const float bv = BETA[mm * 32 + hv];
#pragma unroll
                  for (int o = 1; o < 64; o <<= 1) { const float nb = __shfl_up(gv, o); if (lane >= o) gv += nb; }
                  GCl[e * 256 + c * 64 + lane] = gv; BTl[e * 256 + c * 64 + lane] = bv; GCUM[mm * 32 + hv] = gv; }
                __syncthreads();
                { const int c = wave >> 1, P = wave & 1, n = cq * 4 + c; const bf16* Kb = KNB + ((size_t)row0 + c * 64) * D + hk * 128; const bf16* Qb = QNB + ((size_t)row0 + c * 64) * D + hk * 128;
                  pg8::bf16x8 Kf[4][4];
#pragma unroll
                  for (int t = 0; t < 4; ++t)
#pragma unroll
                      for (int s = 0; s < 4; ++s) Kf[t][s] = *(const pg8::bf16x8*)(Kb + (size_t)(16 * t + fr) * D + 32 * s + 8 * fq);
                  if (P == 0) {
#pragma unroll
                      for (int a = 0; a < 4; ++a)
#pragma unroll
                          for (int b2 = 0; b2 <= a; ++b2) { f32x4 acc = {0.f, 0.f, 0.f, 0.f};
#pragma unroll
                              for (int s = 0; s < 4; ++s) acc = __builtin_amdgcn_mfma_f32_16x16x32_bf16(Kf[a][s], Kf[b2][s], acc, 0, 0, 0);
#pragma unroll
                              for (int e = 0; e < 2; ++e) { const f32x4 gi = *(const LAS f32x4*)(GCl + e * 256 + c * 64 + 16 * a + 4 * fq), bi = *(const LAS f32x4*)(BTl + e * 256 + c * 64 + 16 * a + 4 * fq); const float gj = GCl[e * 256 + c * 64 + 16 * b2 + fr];
#pragma unroll
                                  for (int r = 0; r < 4; ++r) { const int i = 16 * a + 4 * fq + r, j = 16 * b2 + fr; Ll[((c * 2 + e) * 64 + i) * 64 + j] = (i > j) ? bi[r] * acc[r] * __expf(gi[r] - gj) : 0.f; } } }
                  } else {
#pragma unroll
                      for (int nt = 0; nt < 4; ++nt) { pg8::bf16x8 Qf[4];
#pragma unroll
                          for (int s = 0; s < 4; ++s) Qf[s] = *(const pg8::bf16x8*)(Qb + (size_t)(16 * nt + fr) * D + 32 * s + 8 * fq);
#pragma unroll
                          for (int mt = 0; mt < 4; ++mt) { f32x4 acc = {0.f, 0.f, 0.f, 0.f};
                              if (mt <= nt) {
#pragma unroll
                                  for (int s = 0; s < 4; ++s) acc = __builtin_amdgcn_mfma_f32_16x16x32_bf16(Kf[mt][s], Qf[s], acc, 0, 0, 0); }
#pragma unroll
                              for (int e = 0; e < 2; ++e) { const int hv = 2 * hk + e, i = 16 * nt + fr; float y[4] = {0.f, 0.f, 0.f, 0.f};
                                  if (mt <= nt) { const float gi = GCl[e * 256 + c * 64 + i]; const f32x4 gj = *(const LAS f32x4*)(GCl + e * 256 + c * 64 + 16 * mt + 4 * fq);
#pragma unroll
                                      for (int r = 0; r < 4; ++r) { const int j = 16 * mt + 4 * fq + r; y[r] = (i >= j) ? acc[r] * 0.08838834764831845f * __expf(gi - gj[r]) : 0.f; } }
                                  u32x2 v; v.x = pg8::cvt_pk_bf16(y[0], y[1]); v.y = pg8::cvt_pk_bf16(y[2], y[3]);
                                  *(u32x2*)(IP + ((size_t)((b * 32 + n) * 32 + hv)) * 4096 + i * 64 + 32 * (mt >> 1) + 8 * fq + 4 * (mt & 1)) = v; } } }
                  } }
                __syncthreads();
                { const int c = wave >> 1, e = wave & 1, hv = 2 * hk + e, n = cq * 4 + c; LAS float* L = Ll + (c * 2 + e) * 4096;
                  float Tc[64];
#pragma unroll
                  for (int i = 0; i < 64; ++i) { float acc = (i == lane) ? 1.f : 0.f;
#pragma unroll
                      for (int j4 = 0; j4 < (i + 3) / 4; ++j4) { const f32x4 lv = *(const LAS f32x4*)(L + i * 64 + 4 * j4);
#pragma unroll
                          for (int k = 0; k < 4; ++k) if (4 * j4 + k < i) acc -= lv[k] * Tc[4 * j4 + k]; }
                      Tc[i] = acc; }
                  const float bc = BTl[e * 256 + c * 64 + lane]; const int pp = (lane & 32) + 8 * ((lane >> 2) & 3) + 4 * ((lane >> 4) & 1) + (lane & 3);
                  LAS unsigned short* Tl = (LAS unsigned short*)L;
                  asm volatile("s_waitcnt lgkmcnt(0)" ::: "memory");
#pragma unroll
                  for (int i = 0; i < 64; ++i) Tl[i * 64 + pp] = (unsigned short)f2bf(Tc[i] * bc);
                  asm volatile("s_waitcnt lgkmcnt(0)" ::: "memory");
                  bf16* tp = TP + ((size_t)((b * 32 + n) * 32 + hv)) * 4096;
#pragma unroll
                  for (int k = 0; k < 8; ++k) *(u32x4*)(tp + (k * 64 + lane) * 8) = *(const LAS u32x4*)((const LAS unsigned char*)L + (k * 64 + lane) * 16); }
            }
        }
        SEAM(pb + 2);
        if (IN(pb + 3)) { PH_BEGIN LAYER_PTRS
            if (blk < 128) {
                const int b = blk >> 5, hv = blk & 31, hk = hv >> 1, fr = lane & 15, fq = lane >> 4;
                LAS float* EGl = (LAS float*)(lds + 131072);
                if (wave >= 4) {
                    const int lw = wave - 4;
                    for (int n = 0; n < 32; ++n) {
                        const int row0 = b * SEQ + n * 64; const unsigned dstb = (unsigned)(uintptr_t)(lds) + (unsigned)((n & 1) * 65536);
                        if (lw < 2) { const bf16* srcb = (lw == 0 ? KNB : QNB) + (size_t)row0 * D + hk * 128;
#pragma unroll
                            for (int f = 0; f < 16; ++f) fox::glds16(srcb + (size_t)(16 * (f >> 2) + fr) * D + 32 * (f & 3) + 8 * fq, dstb + lw * 16384 + f * 1024);
                        } else if (lw == 2) { const bf16* srcb = KTP + ((size_t)((b * 32 + n) * 16 + hk)) * 8192;
#pragma unroll
                            for (int f = 0; f < 16; ++f) { const int tau = f >> 1, s2 = f & 1, dkr = 32 * (tau >> 1) + 8 * (fr >> 2) + 4 * (tau & 1) + (fr & 3); fox::glds16(srcb + (size_t)dkr * 64 + 32 * s2 + 8 * fq, dstb + 32768 + f * 1024); }
                        } else { const bf16* st = TP + ((size_t)((b * 32 + n) * 32 + hv)) * 4096; const bf16* si = IP + ((size_t)((b * 32 + n) * 32 + hv)) * 4096;
#pragma unroll
                            for (int f = 0; f < 8; ++f) { fox::glds16(st + (16 * (f >> 1) + fr) * 64 + 32 * (f & 1) + 8 * fq, dstb + 49152 + f * 1024); fox::glds16(si + (16 * (f >> 1) + fr) * 64 + 32 * (f & 1) + 8 * fq, dstb + 57344 + f * 1024); }
                            const float gc = GCUM[(size_t)(row0 + lane) * 32 + hv], gl = GCUM[(size_t)(row0 + 63) * 32 + hv];
                            EGl[(n & 1) * 128 + lane] = __expf(gc); EGl[(n & 1) * 128 + 64 + lane] = __expf(gl - gc); }
                        asm volatile("s_waitcnt vmcnt(0) lgkmcnt(0)" ::: "memory");
                        __builtin_amdgcn_s_barrier();
                    }
                } else {
                    const int w = wave;
                    f32x4 Sacc[8];
#pragma unroll
                    for (int t = 0; t < 8; ++t) Sacc[t] = (f32x4){0.f, 0.f, 0.f, 0.f};
                    const bf16* vb = VTP + ((size_t)(b * 32) * 32 + hv) * 4096 + (size_t)(16 * w + fr) * 64 + 8 * fq;
                    u32x4 vnx0 = *(const u32x4*)(vb), vnx1 = *(const u32x4*)(vb + 32);
                    for (int n = 0; n < 32; ++n) {
                        asm volatile("s_waitcnt lgkmcnt(0)" ::: "memory");
                        __builtin_amdgcn_s_barrier();
                        asm volatile("" ::: "memory");
                        const LAS unsigned char* B = lds + (n & 1) * 65536 + lane * 16; const LAS float* EG = EGl + (n & 1) * 128; const LAS float* EGL = EG + 64; const int row0 = b * SEQ + n * 64;
                        const u32x4 vc0 = vnx0, vc1 = vnx1;
                        if (n + 1 < 32) { vnx0 = *(const u32x4*)(vb + (size_t)(n + 1) * 32 * 4096); vnx1 = *(const u32x4*)(vb + (size_t)(n + 1) * 32 * 4096 + 32); }
                        pg8::bf16x8 Sb[4];
#pragma unroll
                        for (int s = 0; s < 4; ++s) { const float t8[8] = {Sacc[2 * s][0], Sacc[2 * s][1], Sacc[2 * s][2], Sacc[2 * s][3], Sacc[2 * s + 1][0], Sacc[2 * s + 1][1], Sacc[2 * s + 1][2], Sacc[2 * s + 1][3]}; const u32x4 pk = pack8(t8); Sb[s] = __builtin_bit_cast(pg8::bf16x8, pk); }
                        f32x4 KS[4], QS[4];
#pragma unroll
                        for (int mt = 0; mt < 4; ++mt) { KS[mt] = (f32x4){0.f, 0.f, 0.f, 0.f}; QS[mt] = (f32x4){0.f, 0.f, 0.f, 0.f};
#pragma unroll
                            for (int s = 0; s < 4; ++s) { KS[mt] = __builtin_amdgcn_mfma_f32_16x16x32_bf16(*(const LAS pg8::bf16x8*)(B + (mt * 4 + s) * 1024), Sb[s], KS[mt], 0, 0, 0);
                                QS[mt] = __builtin_amdgcn_mfma_f32_16x16x32_bf16(*(const LAS pg8::bf16x8*)(B + 16384 + (mt * 4 + s) * 1024), Sb[s], QS[mt], 0, 0, 0); } }
                        pg8::bf16x8 Rb[2];
#pragma unroll
                        for (int s2 = 0; s2 < 2; ++s2) { const f32x4 e0 = *(const LAS f32x4*)(EG + 32 * s2 + 4 * fq), e1 = *(const LAS f32x4*)(EG + 32 * s2 + 16 + 4 * fq); float v8[8]; unpack8(s2 ? vc1 : vc0, v8); float r8[8];
#pragma unroll
                            for (int k = 0; k < 4; ++k) { r8[k] = v8[k] - e0[k] * KS[2 * s2][k]; r8[4 + k] = v8[4 + k] - e1[k] * KS[2 * s2 + 1][k]; }
                            const u32x4 pk = pack8(r8); Rb[s2] = __builtin_bit_cast(pg8::bf16x8, pk); }
                        f32x4 Vn[4];
#pragma unroll
                        for (int mt = 0; mt < 4; ++mt) { Vn[mt] = (f32x4){0.f, 0.f, 0.f, 0.f};
#pragma unroll
                            for (int s2 = 0; s2 < 2; ++s2) Vn[mt] = __builtin_amdgcn_mfma_f32_16x16x32_bf16(*(const LAS pg8::bf16x8*)(B + 49152 + (mt * 2 + s2) * 1024), Rb[s2], Vn[mt], 0, 0, 0); }
                        pg8::bf16x8 Vnb[2], Vsb[2];
#pragma unroll
                        for (int s2 = 0; s2 < 2; ++s2) { const f32x4 g0 = *(const LAS f32x4*)(EGL + 32 * s2 + 4 * fq), g1 = *(const LAS f32x4*)(EGL + 32 * s2 + 16 + 4 * fq);
                            const float a8[8] = {Vn[2 * s2][0], Vn[2 * s2][1], Vn[2 * s2][2], Vn[2 * s2][3], Vn[2 * s2 + 1][0], Vn[2 * s2 + 1][1], Vn[2 * s2 + 1][2], Vn[2 * s2 + 1][3]};
                            const float b8[8] = {a8[0] * g0[0], a8[1] * g0[1], a8[2] * g0[2], a8[3] * g0[3], a8[4] * g1[0], a8[5] * g1[1], a8[6] * g1[2], a8[7] * g1[3]};
                            const u32x4 pa = pack8(a8), pb2 = pack8(b8); Vnb[s2] = __builtin_bit_cast(pg8::bf16x8, pa); Vsb[s2] = __builtin_bit_cast(pg8::bf16x8, pb2); }
#pragma unroll
                        for (int mt = 0; mt < 4; ++mt) { const f32x4 eg = *(const LAS f32x4*)(EG + 16 * mt + 4 * fq); f32x4 o = QS[mt] * eg * 0.08838834764831845f;
#pragma unroll
                            for (int s2 = 0; s2 < 2; ++s2) o = __builtin_amdgcn_mfma_f32_16x16x32_bf16(*(const LAS pg8::bf16x8*)(B + 57344 + (mt * 2 + s2) * 1024), Vnb[s2], o, 0, 0, 0);
                            float* op = ORAW + (size_t)(row0 + 16 * mt + 4 * fq) * D + hv * 64 + 16 * w + fr;
#pragma unroll
                            for (int r = 0; r < 4; ++r) op[(size_t)r * D] = o[r]; }
                        const float cd = EG[63];
#pragma unroll
                        for (int t = 0; t < 8; ++t) { Sacc[t] = Sacc[t] * cd;
#pragma unroll
                            for (int s2 = 0; s2 < 2; ++s2) Sacc[t] = __builtin_amdgcn_mfma_f32_16x16x32_bf16(*(const LAS pg8::bf16x8*)(B + 32768 + (t * 2 + s2) * 1024), Vsb[s2], Sacc[t], 0, 0, 0); }
                    }
                }
            }
            __syncthreads();
            {
                typedef fox::BlockRef<fox::TIN, fox::TOUT> BR;
                const fox::TIN *FQp = (const fox::TIN*)(T + TI_FQ * ACT_E), *FKp = (const fox::TIN*)(T + TI_FK * ACT_E), *FVp = (const fox::TIN*)(T + TI_FV * ACT_E); fox::TOUT* Op = (fox::TOUT*)YC;
                const char* FKB = (const char*)(ws + WS_FKB); const char* Z16 = (const char*)(ws + 256);
                const int bh = blk >> 2, xq = blk & 3, b = bh >> 4, h = bh & 15;
                if (blk < 256) {
#define FOX_REF(r, qb) do { const size_t row0 = (size_t)b * SEQ + (size_t)(qb) * 256; (r).Q = FQp + row0 * D + h * 128; (r).K = FKp + (size_t)b * SEQ * D + h * 128; (r).V = FVp + (size_t)b * SEQ * D + h * 128; \
                    (r).O = Op + row0 * D + h * 128; (r).FK = FKB + (size_t)bh * SEQ * 16; (r).Z16 = Z16; (r).P0 = (qb) * 256; } while (0)
                    BR cur, nxt; FOX_REF(cur, xq); FOX_REF(nxt, 7 - xq);
                    fox::Seam<fox::TIN> S;
                    fox::causal_swa_prime<fox::TIN, fox::TOUT>(cur, SEQ, (char*)lds_raw, S);
                    for (int pass = 0; pass < 2; ++pass) {
                        fox::causal_swa_block<fox::TIN, fox::TOUT>(cur, nxt, SEQ, SEQ, (char*)lds_raw, S);
                        cur = nxt;
                    }
#undef FOX_REF
                }
            }
        }
        SEAM(pb + 3);
        if (IN(pb + 4)) { PH_BEGIN LAYER_PTRS
            const float* nw = AIN(I_GNORMW) + l * 64; const bf16* GZ = T + TI_GZ * ACT_E;
            float nwv[8];
#pragma unroll
            for (int i = 0; i < 8; ++i) nwv[i] = nw[(lane & 7) * 8 + i];
            for (int it = gw; it < M * 4; it += NGW) { const size_t o = (size_t)(it >> 2) * D + (it & 3) * 512 + lane * 8;
                const f32x4 a = *(const f32x4*)(ORAW + o), b = *(const f32x4*)(ORAW + o + 4); float ov[8] = {a[0], a[1], a[2], a[3], b[0], b[1], b[2], b[3]}, z[8], y[8]; float ss = 0.f;
#pragma unroll
                for (int i = 0; i < 8; ++i) ss += ov[i] * ov[i];
                ss += __shfl_xor(ss, 1); ss += __shfl_xor(ss, 2); ss += __shfl_xor(ss, 4);
                const float rn = __builtin_amdgcn_rsqf(ss * (1.f / 64.f) + NORM_EPS); unpack8(*(const u32x4*)(GZ + o), z);
#pragma unroll
                for (int i = 0; i < 8; ++i) y[i] = ov[i] * rn * nwv[i] * fsilu(z[i]);
                *(u32x4*)(YB + o) = pack8(y); }
        }
        SEAM(pb + 4);
        if (IN(pb + 5)) { PH_BEGIN LAYER_PTRS
            pg8::StaticOrder S; S.init(M, D, G, blk);
            { pg8::Gemm g{YA, (const bf16*)(wl + W_A), M, D, D}; pg8::EpiMerge<0> E{T + TI_MA * ACT_E, MACC, MG}; pg8::gemm_phase<pg8::EpiMerge<0>, pg8::StaticOrder, true, true>(lds, g, S, E); }
            { pg8::Gemm g{YB, (const bf16*)(wl + W_B), M, D, D}; pg8::EpiMerge<1> E{T + TI_MB * ACT_E, MACC, MG}; pg8::gemm_phase<pg8::EpiMerge<1>, pg8::StaticOrder, true, true>(lds, g, S, E); }
            { pg8::Gemm g{YC, (const bf16*)(wl + W_C), M, D, D}; pg8::EpiMerge<2> E{T + TI_MC * ACT_E, MACC, MG}; pg8::gemm_phase<pg8::EpiMerge<2>, pg8::StaticOrder, true, true>(lds, g, S, E); }
        }
        SEAM(pb + 5);
        if (IN(pb + 6)) { PH_BEGIN LAYER_PTRS
            pg8::Gemm g{MG, (const bf16*)(wl + W_O), M, D, D}; pg8::StaticOrder S; S.init(M, D, G, blk);
            pg8::EpiResid E{Xin, modl + 2 * D, PRE, ALPHA};
            pg8::gemm_phase<pg8::EpiResid, pg8::StaticOrder, true, true>(lds, g, S, E);
        }
        SEAM(pb + 6);
        if (IN(pb + 7)) { PH_BEGIN LAYER_PTRS
            const float* g1 = AIN(I_LN1G) + (size_t)l * D; const float* b1 = AIN(I_LN1B) + (size_t)l * D;
            for (int m = gw; m < M; m += NGW) { const float* mb = modl + (size_t)(m >> 11) * MODW; ln_mod_row(PRE + (size_t)m * D, g1, b1, X + (size_t)m * D, U + (size_t)m * D, mb + 3 * D, mb + 4 * D, lane); }
        }
        SEAM(pb + 7);
        if (IN(pb + 8)) { PH_BEGIN LAYER_PTRS
            pg8::Gemm g{U, (const bf16*)(wl + W_1), M, FF, D}; pg8::StaticOrder S; S.init(M, FF, G, blk);
            pg8::EpiRelu2 E{H, FF};
            pg8::gemm_phase<pg8::EpiRelu2, pg8::StaticOrder, true, true>(lds, g, S, E);
        }
        SEAM(pb + 8);
        if (IN(pb + 9)) { PH_BEGIN LAYER_PTRS
            pg8::Gemm g{H, (const bf16*)(wl + W_2), M, D, FF}; pg8::StaticOrder S; S.init(M, D, G, blk);
            pg8::EpiResid E{X, modl + 5 * D, PRE, ALPHA};
            pg8::gemm_phase<pg8::EpiResid, pg8::StaticOrder, true, true>(lds, g, S, E);
        }
        SEAM(pb + 9);
        if (IN(pb + 10)) { PH_BEGIN LAYER_PTRS
            const float* g2 = AIN(I_LN2G) + (size_t)l * D; const float* b2 = AIN(I_LN2B) + (size_t)l * D; const bool last = (l == DEPTH - 1);
            float* xo = last ? ((float*)(GAS float*)ap->out) : X; const float* modn = mod + (size_t)(last ? l : l + 1) * 4 * MODW;
            for (int m = gw; m < M; m += NGW) { const float* mb = modn + (size_t)(m >> 11) * MODW; ln_mod_row(PRE + (size_t)m * D, g2, b2, xo + (size_t)m * D, last ? (bf16*)nullptr : U + (size_t)m * D, mb, mb + D, lane); }
        }
        SEAM(pb + 10);
}

__global__ void __launch_bounds__(NT, 2) fwd_kernel(Args args) {
    extern __shared__ __attribute__((aligned(16))) unsigned char lds_raw[];
    LAS unsigned char* lds = (LAS unsigned char*)lds_raw;
    const int G = gridDim.x, blk = blockIdx.x, NGW = G * NWAVES, NGT = G * NT;
    volatile LAS unsigned* MISC = (volatile LAS unsigned*)(lds + MISC_OFF);
    if (threadIdx.x < 128) ((LAS unsigned*)(lds + MISC_OFF))[threadIdx.x] = 0u;
    __syncthreads();
    XcdBarrier bar = xcd_barrier_post((unsigned*)((gu32*)(args.ws + WS_CTL) + CW_BAR), MISC + 8);
    const int lo = args.ph_lo, hi = args.ph_hi;
    if (IN(0)) { PH_BEGIN
        LAS f32x4* ca = (LAS f32x4*)lds;
        const float* c = AIN(I_C);
        for (int k = tid; k < D; k += NT) { f32x4 v; for (int b = 0; b < 4; ++b) { const float cv = c[b * D + k]; v[b] = cv / (1.f + expf(-cv)); } ca[k] = v; }
        __syncthreads();
        const float* w_ada = AIN(I_WADA);
        for (int it = gw; it < 1536; it += NGW) {
            const int l = it / 768, r = it % 768, jblk = r >> 4, kc = r & 15;
            const float* W = w_ada + ((size_t)(l * D + kc * 128)) * MODW + jblk * 256 + lane * 4;
            f32x4 a0 = {0.f, 0.f, 0.f, 0.f}, a1 = a0, a2 = a0, a3 = a0;
#pragma unroll 8
            for (int k = 0; k < 128; ++k) { const f32x4 w = *(const f32x4*)(W + (size_t)k * MODW); const f32x4 cv = ca[kc * 128 + k]; a0 += w * cv[0]; a1 += w * cv[1]; a2 += w * cv[2]; a3 += w * cv[3]; }
            float* P = modp + ((size_t)((l * 16 + kc) * 4)) * MODW + jblk * 256 + lane * 4;
            *(f32x4*)(P) = a0; *(f32x4*)(P + MODW) = a1; *(f32x4*)(P + 2 * MODW) = a2; *(f32x4*)(P + 3 * MODW) = a3;
        }
    }
    SEAM(0);
    if (IN(1)) { PH_BEGIN
        const float* b_ada = AIN(I_BADA);
        for (int i = gtid; i < DEPTH * 4 * MODW; i += NGT) { const int l = i / (4 * MODW), r = i % (4 * MODW), b = r / MODW, j = r % MODW; float s = b_ada[l * MODW + j];
            for (int kc = 0; kc < 16; ++kc) s += modp[((size_t)((l * 16 + kc) * 4 + b)) * MODW + j];
            mod[i] = s; }
        constexpr int I_IN = 13 * 32 * 64, I_TAIL = 96, I_SQ = 4 * 32 * 64, I_F1 = 32 * 256, I_F2 = 128 * 64, I_L = I_IN + I_TAIL + I_SQ + I_F1 + I_F2;
        for (int it = gw; it < DEPTH * I_L; it += NGW) {
            const int l = it / I_L; int r = it % I_L; unsigned char* wl = ws + WS_W + (size_t)l * W_LAYER;
            if (r < I_IN) { const int t = r >> 11, q = r & 2047; tr_item(AIN(I_WIN) + (size_t)l * D * INW + src_off(t), INW, (bf16*)(wl + W_IN) + (size_t)t * D * D, D, q >> 6, q & 63, lane); continue; } r -= I_IN;
            if (r < I_TAIL) { const int nb = r >> 5, kb = r & 31; tr_item(AIN(I_WIN) + (size_t)l * D * INW + (nb < 2 ? SRC_GB + 32 * nb : SRC_FF), INW, (bf16*)(wl + W_IN) + (size_t)(13 * D + 32 * nb) * D, D, kb, 0, lane); continue; } r -= I_TAIL;
            if (r < I_SQ) { const int t = r >> 11, q = r & 2047; tr_item((t == 0 ? AIN(I_WA) : t == 1 ? AIN(I_WB) : t == 2 ? AIN(I_WC) : AIN(I_WO)) + (size_t)l * D * D, D, (bf16*)(wl + W_A + (size_t)t * 8 * MiB), D, q >> 6, q & 63, lane); continue; } r -= I_SQ;
            if (r < I_F1) { tr_item(AIN(I_W1) + (size_t)l * D * FF, FF, (bf16*)(wl + W_1), D, r >> 8, r & 255, lane); continue; } r -= I_F1;
            tr_item(AIN(I_W2) + (size_t)l * FF * D, D, (bf16*)(wl + W_2), FF, r >> 6, r & 63, lane);
        }
        for (int i = gtid; i < DEPTH * 160 * (D / 8); i += NGT) { const int l = i / (160 * 256), r = i % (160 * 256); bf16* p = (bf16*)(ws + WS_W + (size_t)l * W_LAYER + W_IN) + (size_t)(13 * D + 96 + (r >> 8)) * D + (r & 255) * 8;
            *(u32x4*)p = (u32x4){0u, 0u, 0u, 0u}; }
    }
    SEAM(1);
    if (IN(2)) { PH_BEGIN
        for (int m = gw; m < M; m += NGW) { const float* mb = mod + (size_t)(m >> 11) * MODW; modulate_row(x_in + (size_t)m * D, U + (size_t)m * D, mb, mb + D, lane); }
    }
    SEAM(2);

    layer_phases<0>(lo, hi, bar, lds, lds_raw, blk, G, NGW, NGT);
    layer_phases<1>(lo, hi, bar, lds, lds_raw, blk, G, NGW, NGT);
#undef IN
#undef SEAM
}

#ifndef MK_ONE_LAUNCH
#define MK_ONE_LAUNCH 0
#endif
#ifndef PROBE_LAYER_MASK
#define PROBE_LAYER_MASK 0
#endif
#ifndef PROBE_PRO_MASK
#define PROBE_PRO_MASK 0
#endif
extern "C" void kernel_launch(void* const* d_in, const int* in_sizes, int n_in, void* d_out, int out_size, void* d_ws, size_t ws_size, hipStream_t stream) {
    static int grid = 0;
    if (grid == 0) {
        if (n_in != N_IN || out_size != M * D || ws_size < WS_END) { fprintf(stderr, "kernel_launch: unexpected shapes: n_in %d out %d ws %zu (need %zu)\n", n_in, out_size, ws_size, (size_t)WS_END); grid = -1; return; }
        int dev = 0, cus = 0, per_cu = 0;
        if (hipGetDevice(&dev) != hipSuccess || hipDeviceGetAttribute(&cus, hipDeviceAttributeMultiprocessorCount, dev) != hipSuccess) { grid = -1; return; }
        if (hipFuncSetAttribute((const void*)fwd_kernel, hipFuncAttributeMaxDynamicSharedMemorySize, LDS_BYTES) != hipSuccess) { fprintf(stderr, "kernel_launch: hipFuncSetAttribute failed\n"); grid = -1; return; }
        if (hipOccupancyMaxActiveBlocksPerMultiprocessor(&per_cu, (const void*)fwd_kernel, NT, LDS_BYTES) != hipSuccess || per_cu < 1) fprintf(stderr, "kernel_launch: occupancy query says %d\n", per_cu);
        (void)hipGetLastError();
        grid = cus;
        if (grid != 256) fprintf(stderr, "kernel_launch: %d CUs (built for 256)\n", grid);
    }
    if (grid < 0) return;
    (void)hipMemsetAsync((char*)d_ws + WS_CTL, 0, CTL_ZERO_BYTES, stream);
    Args a{};
    for (int i = 0; i < N_IN; ++i) a.in[i] = (const float*)d_in[i];
    a.out = (float*)d_out; a.ws = (unsigned char*)d_ws;
#if MK_ONE_LAUNCH
    a.ph_lo = 0; a.ph_hi = NPH;
    hipLaunchKernelGGL(fwd_kernel, dim3(grid), dim3(NT), LDS_BYTES, stream, a);
#else
    for (int p = 0; p < NPH; ++p) { a.ph_lo = p; a.ph_hi = p + 1; const int k = p < 3 ? -1 : (p - 3) % NPL;
        const int reps = (p < 3 ? ((PROBE_PRO_MASK >> p) & 1) : ((PROBE_LAYER_MASK >> k) & 1)) ? 2 : 1;
        for (int r = 0; r < reps; ++r) hipLaunchKernelGGL(fwd_kernel, dim3(grid), dim3(NT), LDS_BYTES, stream, a); }
#endif
}
```

```cpp
#include <hip/hip_runtime.h>
#include <cstdio>
#include <cstdint>
#define MK_ONE_LAUNCH 1
namespace pg8 {
#define PG8_LAS __attribute__((address_space(3)))
typedef unsigned short bf16_t;
typedef short bf16x8 __attribute__((ext_vector_type(8)));
typedef float f32x4 __attribute__((ext_vector_type(4)));
typedef unsigned u32x4 __attribute__((ext_vector_type(4)));
constexpr int BM = 256, BK = 64, HALF = 128, HTB = HALF * BK * 2  , STAGE_BYTES = 8 * HTB, NXCD = 8, WGM = 8;

__host__ __device__ __forceinline__ int lds_byte(int r, int c) { const int st = (r >> 4) * 2 + (c >> 5), rr = r & 15, cc = c & 31, ob = rr * 64 + cc * 2; return st * 1024 + (ob ^ (((ob >> 9) & 1) << 5)); }
__host__ __device__ __forceinline__ void stage_rc(int b, int& R, int& C) { const int st = b / 1024, sb = b % 1024, swz = sb ^ (((sb >> 9) & 1) << 5); R = (st >> 1) * 16 + swz / 64; C = (st & 1) * 32 + (swz % 64) / 2; }
__host__ __device__ __forceinline__ int perm32(int rho) { const int n = rho >> 4, i = rho & 15; return 8 * (i >> 2) + 4 * n + (i & 3); }

struct Unit { int pm, pn; };
struct Gemm { const bf16_t* A; const bf16_t* Bt; int M, N, K; };

struct StaticOrder {
    int nM, nN, nwg, G, c;
    __host__ __device__ void init(int M, int N, int G_, int c_) { nM = M / BM; nN = N / BM; nwg = nM * nN; G = G_; c = c_; }
    __host__ __device__ bool next(int i, Unit& u) const {
        const long L = (long)i * G + c; if (L >= nwg) return false;
        int wgid = (int)L; { const int q = nwg / NXCD, r = nwg % NXCD, xcd = wgid % NXCD, off = wgid / NXCD; wgid = (xcd < r ? xcd * (q + 1) : r * (q + 1) + (xcd - r) * q) + off; }
        const int nig = WGM * nN, gid = wgid / nig, fm = gid * WGM, gsz = (nM - fm) < WGM ? (nM - fm) : WGM;
        u.pm = fm + ((wgid % nig) % gsz); u.pn = (wgid % nig) / gsz; return true;
    }
    __device__ __forceinline__ void a_ready(const Unit&) const {}
    __device__ __forceinline__ void done(const Unit&) const {}
};

__device__ __forceinline__ unsigned cvt_pk_bf16(float lo, float hi) { unsigned r; asm volatile("v_cvt_pk_bf16_f32 %0, %1, %2" : "=v"(r) : "v"(lo), "v"(hi)); return r; }
typedef float f32x2 __attribute__((ext_vector_type(2)));
__device__ __forceinline__ f32x2 gelu_pk(f32x2 v) {
    const f32x2 av = __builtin_elementwise_abs(v), d = av * 0.2316418882f + 1.0f;
    f32x2 t; t.x = __builtin_amdgcn_rcpf(d.x); t.y = __builtin_amdgcn_rcpf(d.y);
    f32x2 q = t * 0.5307027145f + (-0.7265760135f); q = q * t + 0.7107068705f; q = q * t + (-0.142248368f); q = q * t + 0.127414796f; q = q * t;
    const f32x2 s = (v * v) * (-0.72134752044f);
    f32x2 e; e.x = __builtin_amdgcn_exp2f(s.x); e.y = __builtin_amdgcn_exp2f(s.y);
    const f32x2 m = v * (q * e), r = v - m;
    f32x2 o; o.x = v.x < 0.f ? m.x : r.x; o.y = v.y < 0.f ? m.y : r.y; return o;
}

template <int ACT  > struct EpiBf16 {
    static constexpr bool PERM = true, AFTER_DRAIN = false; static_assert(ACT == 0 || ACT == 1, "EpiBf16: ACT is 0 (none) or 1 (gelu_pk)");
    bf16_t* O; int ldc; const float* bias; int split_cols; size_t split_stride; float scale0;
    __device__ __forceinline__ void operator()(const f32x4 (&acc)[2][2][4][2], const Unit& u, int wr, int wc, int fr, int fq) const {
        const int row0 = u.pm * BM + wr * 64 + fr; int colt = u.pn * BM; bf16_t* base = O;
        float sc = 1.f; if (split_cols) { const int t = colt / split_cols; base += (size_t)t * split_stride; colt -= t * split_cols; if (t == 0) sc = scale0; }
        const int col0 = colt + wc * 32 + 8 * fq, bcol0 = u.pn * BM + wc * 32 + 8 * fq;
        f32x4 bv[2][2];
#pragma unroll
        for (int bj = 0; bj < 2; ++bj)
#pragma unroll
            for (int n = 0; n < 2; ++n) bv[bj][n] = bias ? *(const f32x4*)(bias + bcol0 + bj * HALF + 4 * n) : (f32x4){0.f, 0.f, 0.f, 0.f};
#pragma unroll
        for (int ai = 0; ai < 2; ++ai)
#pragma unroll
            for (int m = 0; m < 4; ++m) { bf16_t* rowp = base + (size_t)(row0 + ai * HALF + m * 16) * ldc + col0;
#pragma unroll
                for (int bj = 0; bj < 2; ++bj) { f32x4 v0 = acc[ai][bj][m][0] + bv[bj][0], v1 = acc[ai][bj][m][1] + bv[bj][1];
                    if (ACT == 1) { f32x2 a = gelu_pk((f32x2){v0[0], v0[1]}), b = gelu_pk((f32x2){v0[2], v0[3]}), c = gelu_pk((f32x2){v1[0], v1[1]}), d = gelu_pk((f32x2){v1[2], v1[3]});
                        v0 = (f32x4){a.x, a.y, b.x, b.y}; v1 = (f32x4){c.x, c.y, d.x, d.y}; }
                    v0 = v0 * sc; v1 = v1 * sc; u32x4 w; w.x = cvt_pk_bf16(v0[0], v0[1]); w.y = cvt_pk_bf16(v0[2], v0[3]); w.z = cvt_pk_bf16(v1[0], v1[1]); w.w = cvt_pk_bf16(v1[2], v1[3]);
                    *(u32x4*)(rowp + bj * HALF) = w; } }
    }
};


template <class Epi, class Sched, bool ALIGN_EPI = false, bool SP2 = false>
__device__ __forceinline__ void gemm_phase(PG8_LAS unsigned char* lds, const Gemm g, const Sched& S, const Epi& E) {
    int tid_l = threadIdx.x; asm volatile("" : "+v"(tid_l));
    const int tid = tid_l, wid = __builtin_amdgcn_readfirstlane(tid >> 6), lane = tid & 63, wr = wid >> 2, wc = wid & 3, fr = lane & 15, fq = lane >> 4;
    const int K = g.K, nt = K / BK;
    unsigned voffA[2], voffB[2];
#pragma unroll
    for (int i = 0; i < 2; ++i) { int R, C; stage_rc(tid * 16 + i * 8192, R, C); const int Rb = Epi::PERM ? ((R & ~31) + perm32(R & 31)) : R;
        voffA[i] = (unsigned)(R * K + C) * 2u; voffB[i] = (unsigned)(Rb * K + C) * 2u; }
    const size_t kstep = (size_t)(BK * 2);
    const size_t hstep = (size_t)HALF * K * 2;
    const size_t tstep = 2 * hstep;
    const unsigned ldsw = (unsigned)wid * 1024u;
    const int aoff = lds_byte(wr * 64 + fr, fq * 8), boff = lds_byte(wc * 32 + fr, fq * 8);
#define PG8_SA(b, h) (((b) * 2 + (h)) * HTB)
#define PG8_SB(b, h) ((4 + (b) * 2 + (h)) * HTB)
#define PG8_STAGE(bufoff, gbase, voff) do { _Pragma("unroll") for (int _i = 0; _i < 2; ++_i) \
        __builtin_amdgcn_global_load_lds((const unsigned*)((const char*)(gbase) + (voff)[_i]), (PG8_LAS unsigned*)(lds + (bufoff) + ldsw + _i * 8192), 16, 0, 0); } while (0)
#define PG8_LDA(dst, b, h) do { _Pragma("unroll") for (int m = 0; m < 4; ++m) _Pragma("unroll") for (int k = 0; k < 2; ++k) dst[m][k] = *(const PG8_LAS bf16x8*)(lds + PG8_SA(b, h) + aoff + m * 2048 + k * 1024); } while (0)
#define PG8_LDB(dst, b, h) do { _Pragma("unroll") for (int n = 0; n < 2; ++n) _Pragma("unroll") for (int k = 0; k < 2; ++k) dst[n][k] = *(const PG8_LAS bf16x8*)(lds + PG8_SB(b, h) + boff + n * 2048 + k * 1024); } while (0)
#define PG8_MMA(ai, bj, At, Bt) do { __builtin_amdgcn_s_setprio(1); _Pragma("unroll") for (int m = 0; m < 4; ++m) _Pragma("unroll") for (int n = 0; n < 2; ++n) _Pragma("unroll") for (int k = 0; k < 2; ++k) \
        acc[ai][bj][m][n] = __builtin_amdgcn_mfma_f32_16x16x32_bf16(Bt[n][k], At[m][k], acc[ai][bj][m][n], 0, 0, 0); __builtin_amdgcn_s_setprio(0); } while (0)
#define PG8_WAIT_V(n) asm volatile("s_waitcnt vmcnt(" #n ")" ::: "memory")
#define PG8_WAIT_L(n) asm volatile("s_waitcnt lgkmcnt(" #n ")" ::: "memory")
#define PG8_BAR __builtin_amdgcn_s_barrier()
#define PG8_SCHED __builtin_amdgcn_sched_barrier(0)
    Unit cur, nxt; int ui = 0;
    if (!S.next(0, cur)) return;
    f32x4 acc[2][2][4][2];
#pragma unroll
    for (int a = 0; a < 2; ++a)
#pragma unroll
        for (int b = 0; b < 2; ++b)
#pragma unroll
            for (int m = 0; m < 4; ++m)
#pragma unroll
                for (int n = 0; n < 2; ++n) acc[a][b][m][n] = (f32x4){0.f, 0.f, 0.f, 0.f};
    bf16x8 At[4][2], B0[2][2], B1[2][2];
    const char* cA = (const char*)g.A + (size_t)cur.pm * tstep; const char* cB = (const char*)g.Bt + (size_t)cur.pn * tstep;
    S.a_ready(cur);
    if constexpr (SP2) {
        PG8_STAGE(PG8_SB(0, 0), cB, voffB); PG8_STAGE(PG8_SB(0, 1), cB + hstep, voffB); PG8_STAGE(PG8_SA(0, 0), cA, voffA); PG8_STAGE(PG8_SA(0, 1), cA + hstep, voffA);
        if (wr == 1) PG8_BAR;
        PG8_WAIT_V(2); PG8_BAR;
        PG8_STAGE(PG8_SB(1, 0), cB + kstep, voffB); PG8_STAGE(PG8_SA(1, 0), cA + kstep, voffA); PG8_STAGE(PG8_SB(1, 1), cB + hstep + kstep, voffB);
        PG8_WAIT_V(6); PG8_BAR;
    } else {
        PG8_STAGE(PG8_SB(0, 0), cB, voffB); PG8_STAGE(PG8_SA(0, 0), cA, voffA); PG8_STAGE(PG8_SB(0, 1), cB + hstep, voffB); PG8_STAGE(PG8_SA(0, 1), cA + hstep, voffA);
        if (wr == 1) PG8_BAR;
        PG8_WAIT_V(4); PG8_BAR;
        PG8_STAGE(PG8_SB(1, 0), cB + kstep, voffB); PG8_STAGE(PG8_SA(1, 0), cA + kstep, voffA); PG8_STAGE(PG8_SB(1, 1), cB + hstep + kstep, voffB);
        PG8_WAIT_V(6); PG8_BAR;
    }
    for (;;) {
        const bool has_next = S.next(ui + 1, nxt);
        const char* nA = has_next ? (const char*)g.A + (size_t)nxt.pm * tstep : cA; const char* nB = has_next ? (const char*)g.Bt + (size_t)nxt.pn * tstep : cB;
        for (int t = 0; t < nt; t += 2) {
            const bool last = (t == nt - 2);
            const char* a1 = cA + (size_t)(t + 1) * kstep;
            const char* a2 = last ? nA : cA + (size_t)(t + 2) * kstep; const char* b2 = last ? nB : cB + (size_t)(t + 2) * kstep;
            const char* a3 = a2 + kstep; const char* b3 = b2 + kstep;
            if (last && has_next) S.a_ready(nxt);
            if constexpr (SP2) {
            PG8_LDB(B0, 0, 0); PG8_LDB(B1, 0, 1); PG8_SCHED; PG8_LDA(At, 0, 0); PG8_STAGE(PG8_SA(1, 1), a1 + hstep, voffA);
            PG8_WAIT_V(8); PG8_WAIT_L(0); PG8_BAR; PG8_MMA(0, 0, At, B0); PG8_MMA(0, 1, At, B1); PG8_BAR; PG8_SCHED;
            PG8_LDA(At, 0, 1); PG8_STAGE(PG8_SB(0, 0), b2, voffB); PG8_STAGE(PG8_SB(0, 1), b2 + hstep, voffB); PG8_STAGE(PG8_SA(0, 0), a2, voffA);
            PG8_WAIT_V(8); PG8_WAIT_L(0); PG8_BAR; PG8_MMA(1, 0, At, B0); PG8_MMA(1, 1, At, B1); PG8_BAR; PG8_SCHED;
            PG8_LDB(B0, 1, 0); PG8_LDB(B1, 1, 1); PG8_SCHED; PG8_LDA(At, 1, 0); PG8_STAGE(PG8_SA(0, 1), a2 + hstep, voffA);
            PG8_WAIT_V(8); PG8_WAIT_L(0); PG8_BAR; PG8_MMA(0, 0, At, B0); PG8_MMA(0, 1, At, B1); PG8_BAR; PG8_SCHED;
            PG8_LDA(At, 1, 1); PG8_STAGE(PG8_SB(1, 0), b3, voffB); PG8_STAGE(PG8_SB(1, 1), b3 + hstep, voffB); PG8_STAGE(PG8_SA(1, 0), a3, voffA);
            PG8_WAIT_V(8); PG8_WAIT_L(0); PG8_BAR; PG8_MMA(1, 0, At, B0); PG8_MMA(1, 1, At, B1); PG8_BAR; PG8_SCHED;
            } else {
            PG8_LDB(B0, 0, 0); PG8_SCHED; PG8_LDA(At, 0, 0); PG8_STAGE(PG8_SA(1, 1), a1 + hstep, voffA);
            PG8_WAIT_L(8); PG8_BAR; PG8_WAIT_L(0); PG8_MMA(0, 0, At, B0); PG8_BAR; PG8_SCHED;
            PG8_LDB(B1, 0, 1); PG8_STAGE(PG8_SB(0, 0), b2, voffB);
            PG8_BAR; PG8_WAIT_L(0); PG8_MMA(0, 1, At, B1); PG8_BAR;
            PG8_LDA(At, 0, 1); PG8_STAGE(PG8_SA(0, 0), a2, voffA);
            PG8_BAR; PG8_WAIT_L(0); PG8_MMA(1, 0, At, B0); PG8_BAR; PG8_SCHED;
            PG8_STAGE(PG8_SB(0, 1), b2 + hstep, voffB);
            PG8_WAIT_V(6); PG8_BAR; PG8_MMA(1, 1, At, B1); PG8_BAR;
            PG8_LDB(B0, 1, 0); PG8_SCHED; PG8_LDA(At, 1, 0); PG8_STAGE(PG8_SA(0, 1), a2 + hstep, voffA);
            PG8_WAIT_L(8); PG8_BAR; PG8_WAIT_L(0); PG8_MMA(0, 0, At, B0); PG8_BAR; PG8_SCHED;
            PG8_LDB(B1, 1, 1); PG8_STAGE(PG8_SB(1, 0), b3, voffB);
            PG8_BAR; PG8_WAIT_L(0); PG8_MMA(0, 1, At, B1); PG8_BAR;
            PG8_LDA(At, 1, 1); PG8_STAGE(PG8_SA(1, 0), a3, voffA);
            PG8_BAR; PG8_WAIT_L(0); PG8_MMA(1, 0, At, B0); PG8_BAR; PG8_SCHED;
            PG8_STAGE(PG8_SB(1, 1), b3 + hstep, voffB);
            PG8_WAIT_V(6); PG8_BAR; PG8_MMA(1, 1, At, B1); PG8_BAR;
            }
        }
        if constexpr (ALIGN_EPI) { if (wr == 0) PG8_BAR; }
        if constexpr (!Epi::AFTER_DRAIN) { E(acc, cur, wr, wc, fr, fq); S.done(cur); }
        if (!has_next) break;
#pragma unroll
        for (int a = 0; a < 2; ++a)
#pragma unroll
            for (int b = 0; b < 2; ++b)
#pragma unroll
                for (int m = 0; m < 4; ++m)
#pragma unroll
                    for (int n = 0; n < 2; ++n) acc[a][b][m][n] = (f32x4){0.f, 0.f, 0.f, 0.f};
        cur = nxt; cA = nA; cB = nB; ++ui;
        if constexpr (ALIGN_EPI) { if (wr == 1) PG8_BAR; }
    }
    PG8_WAIT_V(0);
    if constexpr (!ALIGN_EPI) { if (wr == 0) PG8_BAR; }
    PG8_BAR;
    if constexpr (Epi::AFTER_DRAIN) { E.fused(acc, cur, wr, wc, fr, fq, lds, wid, lane); S.done(cur); }
#undef PG8_SA
#undef PG8_SB
#undef PG8_STAGE
#undef PG8_LDA
#undef PG8_LDB
#undef PG8_MMA
#undef PG8_WAIT_V
#undef PG8_WAIT_L
#undef PG8_BAR
#undef PG8_SCHED
}
}

namespace pg8 {
__device__ __forceinline__ float bf_lo(unsigned w) { return __builtin_bit_cast(float, w << 16); }
__device__ __forceinline__ float bf_hi(unsigned w) { return __builtin_bit_cast(float, w & 0xffff0000u); }
__device__ __forceinline__ float fsigmoid(float x) { return __builtin_amdgcn_rcpf(1.f + __expf(-x)); }

struct EpiInProj {
    static constexpr bool PERM = true, AFTER_DRAIN = false;
    bf16_t* T0; float* SMALL; size_t tstride;
    __device__ __forceinline__ void operator()(const f32x4 (&acc)[2][2][4][2], const Unit& u, int wr, int wc, int fr, int fq) const {
        const int t = u.pn >> 3; const int row0 = u.pm * BM + wr * 64 + fr;
        if (t < 13) {
            bf16_t* base = T0 + (size_t)t * tstride; const int col0 = (u.pn & 7) * BM + wc * 32 + 8 * fq; const bool sg = t >= 10;
#pragma unroll
            for (int ai = 0; ai < 2; ++ai)
#pragma unroll
                for (int m = 0; m < 4; ++m) { bf16_t* rowp = base + (size_t)(row0 + ai * HALF + m * 16) * 2048 + col0;
#pragma unroll
                    for (int bj = 0; bj < 2; ++bj) { f32x4 v0 = acc[ai][bj][m][0], v1 = acc[ai][bj][m][1];
                        if (sg) { v0 = (f32x4){fsigmoid(v0[0]), fsigmoid(v0[1]), fsigmoid(v0[2]), fsigmoid(v0[3])}; v1 = (f32x4){fsigmoid(v1[0]), fsigmoid(v1[1]), fsigmoid(v1[2]), fsigmoid(v1[3])}; }
                        u32x4 w; w.x = cvt_pk_bf16(v0[0], v0[1]); w.y = cvt_pk_bf16(v0[2], v0[3]); w.z = cvt_pk_bf16(v1[0], v1[1]); w.w = cvt_pk_bf16(v1[2], v1[3]);
                        *(u32x4*)(rowp + bj * HALF) = w; } }
        } else {
            const int col0 = wc * 32 + 8 * fq;
#pragma unroll
            for (int ai = 0; ai < 2; ++ai)
#pragma unroll
                for (int m = 0; m < 4; ++m) { float* rowp = SMALL + (size_t)(row0 + ai * HALF + m * 16) * 256 + col0;
#pragma unroll
                    for (int bj = 0; bj < 2; ++bj) { *(f32x4*)(rowp + bj * HALF) = acc[ai][bj][m][0]; *(f32x4*)(rowp + bj * HALF + 4) = acc[ai][bj][m][1]; } }
        }
    }
};

template <int STEP> struct EpiMerge {
    static constexpr bool PERM = true, AFTER_DRAIN = false;
    const bf16_t* G; float* MACC; bf16_t* OUT;
    __device__ __forceinline__ void operator()(const f32x4 (&acc)[2][2][4][2], const Unit& u, int wr, int wc, int fr, int fq) const {
        const int row0 = u.pm * BM + wr * 64 + fr, col0 = u.pn * BM + wc * 32 + 8 * fq;
#pragma unroll
        for (int ai = 0; ai < 2; ++ai)
#pragma unroll
            for (int m = 0; m < 4; ++m) { const size_t ro = (size_t)(row0 + ai * HALF + m * 16) * 2048 + col0;
#pragma unroll
                for (int bj = 0; bj < 2; ++bj) { const size_t o = ro + bj * HALF;
                    const u32x4 g = *(const u32x4*)(G + o);
                    f32x4 r0 = acc[ai][bj][m][0] * (f32x4){bf_lo(g.x), bf_hi(g.x), bf_lo(g.y), bf_hi(g.y)};
                    f32x4 r1 = acc[ai][bj][m][1] * (f32x4){bf_lo(g.z), bf_hi(g.z), bf_lo(g.w), bf_hi(g.w)};
                    if (STEP > 0) { r0 += *(const f32x4*)(MACC + o); r1 += *(const f32x4*)(MACC + o + 4); }
                    if (STEP < 2) { *(f32x4*)(MACC + o) = r0; *(f32x4*)(MACC + o + 4) = r1; }
                    else { u32x4 w; w.x = cvt_pk_bf16(r0[0], r0[1]); w.y = cvt_pk_bf16(r0[2], r0[3]); w.z = cvt_pk_bf16(r1[0], r1[1]); w.w = cvt_pk_bf16(r1[2], r1[3]); *(u32x4*)(OUT + o) = w; } } }
    }
};

struct EpiResid {
    static constexpr bool PERM = false, AFTER_DRAIN = false;
    const float* Xin; const float* gate; float* PRE; float alpha;
    __device__ __forceinline__ void operator()(const f32x4 (&acc)[2][2][4][2], const Unit& u, int wr, int wc, int fr, int fq) const {
        const int row0 = u.pm * BM + wr * 64 + fr, col0 = u.pn * BM + wc * 32 + 4 * fq; const float* gp = gate + (size_t)(u.pm >> 3) * 12288 + col0;
        f32x4 gv[2][2];
#pragma unroll
        for (int bj = 0; bj < 2; ++bj)
#pragma unroll
            for (int n = 0; n < 2; ++n) gv[bj][n] = *(const f32x4*)(gp + bj * HALF + n * 16);
#pragma unroll
        for (int ai = 0; ai < 2; ++ai)
#pragma unroll
            for (int m = 0; m < 4; ++m) { const size_t ro = (size_t)(row0 + ai * HALF + m * 16) * 2048 + col0;
#pragma unroll
                for (int bj = 0; bj < 2; ++bj)
#pragma unroll
                    for (int n = 0; n < 2; ++n) { const size_t o = ro + bj * HALF + n * 16; const f32x4 xv = *(const f32x4*)(Xin + o);
                        *(f32x4*)(PRE + o) = xv * alpha + gv[bj][n] * acc[ai][bj][m][n]; } }
    }
};

struct EpiRelu2 {
    static constexpr bool PERM = true, AFTER_DRAIN = false;
    bf16_t* O; int ldc;
    __device__ __forceinline__ void operator()(const f32x4 (&acc)[2][2][4][2], const Unit& u, int wr, int wc, int fr, int fq) const {
        const int row0 = u.pm * BM + wr * 64 + fr, col0 = u.pn * BM + wc * 32 + 8 * fq;
#pragma unroll
        for (int ai = 0; ai < 2; ++ai)
#pragma unroll
            for (int m = 0; m < 4; ++m) { bf16_t* rowp = O + (size_t)(row0 + ai * HALF + m * 16) * ldc + col0;
#pragma unroll
                for (int bj = 0; bj < 2; ++bj) { f32x4 v0 = acc[ai][bj][m][0], v1 = acc[ai][bj][m][1];
                    v0 = __builtin_elementwise_max(v0, (f32x4){0.f, 0.f, 0.f, 0.f}); v1 = __builtin_elementwise_max(v1, (f32x4){0.f, 0.f, 0.f, 0.f}); v0 = v0 * v0; v1 = v1 * v1;
                    u32x4 w; w.x = cvt_pk_bf16(v0[0], v0[1]); w.y = cvt_pk_bf16(v0[2], v0[3]); w.z = cvt_pk_bf16(v1[0], v1[1]); w.w = cvt_pk_bf16(v1[2], v1[3]);
                    *(u32x4*)(rowp + bj * HALF) = w; } }
    }
};
}

#define GAS __attribute__((address_space(1)))
#define LAS __attribute__((address_space(3)))
typedef unsigned short bf16;
typedef unsigned v4u __attribute__((ext_vector_type(4)));
typedef float f32x4 __attribute__((ext_vector_type(4)));
typedef short bf16x8 __attribute__((ext_vector_type(8)));
typedef GAS unsigned gu32;
typedef GAS unsigned long long gu64;
#define RLX_AGENT __ATOMIC_RELAXED, __HIP_MEMORY_SCOPE_AGENT
#define LDS_WAIT() asm volatile("s_waitcnt lgkmcnt(0)" ::: "memory")
#define VM_WAIT() asm volatile("s_waitcnt vmcnt(0)" ::: "memory")
__device__ __forceinline__ unsigned long long rt() { return __builtin_amdgcn_s_memrealtime(); }
__device__ __forceinline__ unsigned f2bf(float f) { unsigned u = __builtin_bit_cast(unsigned, f); return (u + 0x7fffu + ((u >> 16) & 1u)) >> 16; }
__device__ __forceinline__ unsigned pk2(float lo, float hi) { return f2bf(lo) | (f2bf(hi) << 16); }

#define XB_TMO      128
#define XB_XCNT(j)  (256  + 64 * (j))
#define XB_XSUB(j)  (1280 + 64 * (j))
#define XB_XGEN(j)  (2304 + 64 * (j))
#define XB_TOP      3328
#define XB_TOPGEN   3392
#define XCD_BAR_WORDS 3456
#define XB_SPIN_CAP (1u << 18)

__device__ __forceinline__ unsigned xb_ld(unsigned* p)              { return __hip_atomic_load(p, __ATOMIC_RELAXED, __HIP_MEMORY_SCOPE_AGENT); }
__device__ __forceinline__ unsigned xb_add(unsigned* p, unsigned v) { return __hip_atomic_fetch_add(p, v, __ATOMIC_RELAXED, __HIP_MEMORY_SCOPE_AGENT); }
__device__ __forceinline__ unsigned xb_xcc_id() { return (unsigned)__builtin_amdgcn_s_getreg((3 << 11) | 20) & 0xFu; }
#define XB_SPIN(cond, bar) do { unsigned _sp = 0; while (cond) { __builtin_amdgcn_s_sleep(1); \
    if ((++_sp & 255u) == 0u) { if (xb_ld(&(bar)[XB_TMO])) break; if (_sp > XB_SPIN_CAP) { atomicAdd(&(bar)[XB_TMO], 1u); break; } } } } while (0)

struct XcdBarrier {
    unsigned* bar; unsigned x;
    volatile LAS unsigned* st;
};

__device__ __forceinline__ XcdBarrier xcd_barrier_post(unsigned* bar, volatile LAS unsigned* st) {
    XcdBarrier b; b.bar = bar; b.x = xb_xcc_id(); b.st = st;
    if (threadIdx.x == 0) (void)xb_add(&bar[XB_XCNT(b.x)], 1u);
    return b;
}
__device__ __forceinline__ void xcd_barrier_complete(unsigned* bar, unsigned x, unsigned& nloc, unsigned& nx) {
    const unsigned G = gridDim.x * gridDim.y * gridDim.z;
    unsigned sum, cnt, mine, sp = 0u;
    for (;;) {
        sum = 0u; cnt = 0u; mine = 0u;
#pragma unroll
        for (unsigned j = 0; j < 16; ++j) { const unsigned c = xb_ld(&bar[XB_XCNT(j)]); sum += c; cnt += (c > 0u) ? 1u : 0u; mine = (j == x) ? c : mine; }
        if (sum == G) break;
        __builtin_amdgcn_s_sleep(1);
        if ((++sp & 255u) == 0u) { if (xb_ld(&bar[XB_TMO])) break; if (sp > XB_SPIN_CAP) { atomicAdd(&bar[XB_TMO], 1u); break; } }
    }
    nloc = mine > 0u ? mine : 1u; nx = cnt > 0u ? cnt : 1u;
}

__device__ __forceinline__ void xcd_barrier(const XcdBarrier& b) {
    asm volatile("s_waitcnt vmcnt(0)" ::: "memory");
    __syncthreads();
    if (threadIdx.x == 0) {
        unsigned* bar = b.bar;
        __builtin_amdgcn_s_waitcnt(0);
        unsigned nloc = b.st[0], nx = b.st[1];
        if (nloc == 0u) { xcd_barrier_complete(bar, b.x, nloc, nx); b.st[0] = nloc; b.st[1] = nx; }
        const unsigned old = xb_add(&bar[XB_XSUB(b.x)], 1u);
        const unsigned gen = old / nloc;
        if (old + 1u == (gen + 1u) * nloc) {
            __builtin_amdgcn_fence(__ATOMIC_RELEASE, "agent");
            asm volatile("s_waitcnt vmcnt(0)" ::: "memory");
            const unsigned og = xb_add(&bar[XB_TOP], 1u);
            const unsigned tg = og / nx;
            if (og + 1u == (tg + 1u) * nx) xb_add(&bar[XB_TOPGEN], 1u);
            else XB_SPIN(xb_ld(&bar[XB_TOPGEN]) == tg, bar);
            __builtin_amdgcn_fence(__ATOMIC_ACQUIRE, "agent");
            xb_add(&bar[XB_XGEN(b.x)], 1u);
            asm volatile("s_waitcnt vmcnt(0)" ::: "memory");
        } else {
            XB_SPIN(xb_ld(&bar[XB_XGEN(b.x)]) == gen, bar);
            __builtin_amdgcn_fence(__ATOMIC_ACQUIRE, "agent");
            asm volatile("s_waitcnt vmcnt(0)" ::: "memory");
        }
    }
    __syncthreads();
}

#include <hip/hip_bf16.h>
namespace fox {
using TIN = __hip_bfloat16; using TOUT = __hip_bfloat16;
constexpr int D = 128, PITCH = 2048;
constexpr float THR = 8.f;
constexpr bool WSKIP = false;
constexpr float SCALE = 0.08838834764831845f;
constexpr int NW = 8, QBLK = 32, KVBLK = 64, QB = NW * QBLK;
constexpr int SHM_V = KVBLK * D * 2, SHM_K = KVBLK * D * 2;
constexpr int ATT_LDS_BYTES = 2 * SHM_V + 2 * SHM_K + NW * 64 * 4;


using bf16 = __hip_bfloat16;
typedef short bf16x8 __attribute__((ext_vector_type(8)));
typedef short s16x4 __attribute__((ext_vector_type(4)));
typedef float f32x16 __attribute__((ext_vector_type(16)));
typedef float f32x4 __attribute__((ext_vector_type(4)));
typedef unsigned u32x4 __attribute__((ext_vector_type(4)));
template <class A, class Bt> struct same_t { static constexpr bool v = false; };
template <class A> struct same_t<A, A> { static constexpr bool v = true; };

__device__ __forceinline__ void glds16(const void* gsrc, unsigned lds_dst) { unsigned keep;
    asm volatile("s_mov_b32 %0, m0\n\ts_mov_b32 m0, %2\n\ts_nop 0\n\tglobal_load_lds_dwordx4 %1, off\n\ts_mov_b32 m0, %0" : "=&s"(keep) : "v"(gsrc), "s"(lds_dst) : "memory"); }
#define KSWZ(row, colB) ((row) * 256 + ((colB) ^ (((row) & 7) << 4)))
#define SBAR() __builtin_amdgcn_sched_barrier(0)
__device__ __forceinline__ int v_st(int k, int c) { const int kk = (k & ~0xC) | ((k & 4) << 1) | ((k & 8) >> 1); return ((kk >> 3) * 4 + (c >> 5)) * 512 + ((kk & 7) * 32 + (c & 31)) * 2; }
__device__ __forceinline__ int v_rd_base(int lane) { return ((lane & 3) << 3) | (((lane >> 2) & 3) << 6) | (((lane >> 4) & 1) << 5) | (((lane >> 5) & 1) << 8); }
constexpr int v_rd_off(int d0, int ks, int half) { return d0 * 512 + ks * 4096 + half * 2048; }
__device__ __forceinline__ int crow(int r, int hi) { return (r & 3) + 8 * (r >> 2) + 4 * hi; }
__device__ __forceinline__ unsigned cvtpk(float lo, float hi) {
    unsigned r; asm volatile("v_cvt_pk_bf16_f32 %0, %1, %2" : "=v"(r) : "v"(lo), "v"(hi)); return r;
}
__device__ __forceinline__ bf16x8 pack8(f32x4 a, f32x4 b) {
    u32x4 w = {cvtpk(a[0], a[1]), cvtpk(a[2], a[3]), cvtpk(b[0], b[1]), cvtpk(b[2], b[3])};
    return *reinterpret_cast<bf16x8*>(&w);
}
template <class T> __device__ __forceinline__ bf16x8 load8(const T* p) {
    if constexpr (same_t<T, float>::v) { return pack8(*(const f32x4*)p, *(const f32x4*)(p + 4)); }
    else { return *reinterpret_cast<const bf16x8*>(p); }
}
__device__ __forceinline__ void mask_tile(f32x16& p0, f32x16& p1, int dq, unsigned W) {
    const float NEG = -__builtin_inff();
#pragma unroll
    for (int r = 0; r < 16; ++r) {
        const int c = (r & 3) + 8 * (r >> 2);
        if ((unsigned)(dq - c) >= W) p0[r] = NEG;
        if ((unsigned)(dq - c - 32) >= W) p1[r] = NEG;
    }
}
__device__ __forceinline__ void partialSM(f32x16& p0, f32x16& p1, float& m_reg, float& mn, float& alpha) {
    float pmax = p0[0]; for (int r = 1; r < 16; ++r) pmax = fmaxf(pmax, p0[r]); for (int r = 0; r < 16; ++r) pmax = fmaxf(pmax, p1[r]);
    { auto rr = __builtin_amdgcn_permlane32_swap(__float_as_uint(pmax), __float_as_uint(pmax), false, false);
      pmax = fmaxf(__uint_as_float(rr[0]), __uint_as_float(rr[1])); }
    constexpr float C2 = 1.4426950408889634f * SCALE;
    if (__builtin_expect(__all((pmax - m_reg) * SCALE <= THR), 1)) { mn = m_reg; alpha = 1.f; }
    else { mn = fmaxf(m_reg, pmax); alpha = __builtin_amdgcn_exp2f((m_reg - mn) * C2); m_reg = mn; }
    const float mnL = -mn * C2;
    for (int r = 0; r < 16; ++r) p0[r] = fmaf(p0[r], C2, mnL); for (int r = 0; r < 16; ++r) p1[r] = fmaf(p1[r], C2, mnL);
    for (int r = 0; r < 16; ++r) p0[r] = __builtin_amdgcn_exp2f(p0[r]);
}
__device__ __forceinline__ void finishSM(f32x16& p0, f32x16& p1, float alpha, float& l_reg, bf16x8& pa0, bf16x8& pa1, bf16x8& pa2, bf16x8& pa3) {
    for (int r = 0; r < 16; ++r) p1[r] = __builtin_amdgcn_exp2f(p1[r]);
    float ps = 0; for (int r = 0; r < 16; ++r) ps += p0[r]; for (int r = 0; r < 16; ++r) ps += p1[r];
    { auto rr = __builtin_amdgcn_permlane32_swap(__float_as_uint(ps), __float_as_uint(ps), false, false);
      ps = __uint_as_float(rr[0]) + __uint_as_float(rr[1]); }
    l_reg = l_reg * alpha + ps;
#define PK4(P, B_, OUT) do { unsigned a0 = cvtpk(P[B_+0], P[B_+1]), a1 = cvtpk(P[B_+2], P[B_+3]);                          \
        unsigned b0 = cvtpk(P[B_+4], P[B_+5]), b1 = cvtpk(P[B_+6], P[B_+7]);                                             \
        auto r0 = __builtin_amdgcn_permlane32_swap(a0, b0, false, false); auto r1 = __builtin_amdgcn_permlane32_swap(a1, b1, false, false); \
        u32x4 w = {r0[0], r1[0], r0[1], r1[1]}; OUT = *reinterpret_cast<bf16x8*>(&w); } while (0)
    PK4(p0, 0, pa0); PK4(p0, 8, pa1); PK4(p1, 0, pa2); PK4(p1, 8, pa3);
#undef PK4
}
template <int KB, bool SK>
__device__ __forceinline__ void qkt(f32x16& p0, f32x16& p1, const char* K_lds, int r32, int hi, const char* qr, bool act, const char* B_lds, int lane) {
    if (SK && !act) { const float NEG = -__builtin_inff();
#pragma unroll
        for (int r = 0; r < 16; ++r) { p0[r] = NEG; p1[r] = NEG; } return; }
    p0 = f32x16{}; p1 = f32x16{};
    const char* kb[4];
#pragma unroll
    for (int dd = 0; dd < 4; ++dd) kb[dd] = K_lds + KB * SHM_K + KSWZ(r32, (dd * 16 + hi * 8) * 2);
#pragma unroll
    for (int d0 = 0; d0 < 8; ++d0) { const char* a = kb[d0 & 3] + (d0 >> 2) * 128;
        bf16x8 b0 = *reinterpret_cast<const bf16x8*>(a);
        bf16x8 b1 = *reinterpret_cast<const bf16x8*>(a + 32 * 256);
        const bf16x8 qf = *reinterpret_cast<const bf16x8*>(qr + d0 * 1024);
        p0 = __builtin_amdgcn_mfma_f32_32x32x16_bf16(b0, qf, p0, 0, 0, 0);
        p1 = __builtin_amdgcn_mfma_f32_32x32x16_bf16(b1, qf, p1, 0, 0, 0); }
    { const unsigned o1 = hi ? 0u : 0x3F803F80u, o2 = hi ? 0u : 0x3F80u; const u32x4 qw = {o1, o2, 0u, 0u}; const bf16x8 qo = *reinterpret_cast<const bf16x8*>(&qw);
      const bf16x8 bk0 = *reinterpret_cast<const bf16x8*>(B_lds + KB * 2048 + lane * 16), bk1 = *reinterpret_cast<const bf16x8*>(B_lds + KB * 2048 + 1024 + lane * 16);
      p0 = __builtin_amdgcn_mfma_f32_32x32x16_bf16(bk0, qo, p0, 0, 0, 0);
      p1 = __builtin_amdgcn_mfma_f32_32x32x16_bf16(bk1, qo, p1, 0, 0, 0); }
}
template <int VB, bool SK>
__device__ __forceinline__ void pv_tile(f32x16* o, int vb0, bf16x8 pa0, bf16x8 pa1, bf16x8 pa2, bf16x8 pa3, bool act) {
    if (SK && !act) return;
#define TRRD(dst, off) asm volatile("ds_read_b64_tr_b16 %0, %1 offset:%2" : "=&v"(dst) : "v"(vb0), "i"(off) : "memory")
#define PV_D0(d0) do { s16x4 l0, l1, l2, l3, h0, h1, h2, h3; constexpr int b_ = VB * SHM_V + v_rd_off(d0, 0, 0);     \
        TRRD(l0, b_); TRRD(h0, b_ + 2048); TRRD(l1, b_ + 4096); TRRD(h1, b_ + 6144); TRRD(l2, b_ + 8192); TRRD(h2, b_ + 10240); TRRD(l3, b_ + 12288); TRRD(h3, b_ + 14336); \
        asm volatile("s_waitcnt lgkmcnt(0)" ::: "memory"); SBAR();                 \
        o[d0] = __builtin_amdgcn_mfma_f32_32x32x16_bf16(pa0, (bf16x8){l0[0], l0[1], l0[2], l0[3], h0[0], h0[1], h0[2], h0[3]}, o[d0], 0, 0, 0);   \
        o[d0] = __builtin_amdgcn_mfma_f32_32x32x16_bf16(pa1, (bf16x8){l1[0], l1[1], l1[2], l1[3], h1[0], h1[1], h1[2], h1[3]}, o[d0], 0, 0, 0);   \
        o[d0] = __builtin_amdgcn_mfma_f32_32x32x16_bf16(pa2, (bf16x8){l2[0], l2[1], l2[2], l2[3], h2[0], h2[1], h2[2], h2[3]}, o[d0], 0, 0, 0);   \
        o[d0] = __builtin_amdgcn_mfma_f32_32x32x16_bf16(pa3, (bf16x8){l3[0], l3[1], l3[2], l3[3], h3[0], h3[1], h3[2], h3[3]}, o[d0], 0, 0, 0); } while (0)
    PV_D0(0); PV_D0(1); PV_D0(2); PV_D0(3);
#undef PV_D0
#undef TRRD
}

template <class TIn, class TOut> struct BlockRef { const TIn* Q; const TIn* K; const TIn* V; TOut* O; const char* FK; const char* Z16; int P0; };
template <class TIn> struct Seam {
    bf16x8 st_v0, st_v1, st_k0, st_k1; f32x4 sf0, sf1, sf2, sf3;
    f32x4 tq[16];
};
__device__ __forceinline__ int swa_jlo(int P0, int W) { const int lowk = P0 - W + 1; return lowk > 0 ? lowk / KVBLK : 0; }
#define ROW(p, k0, rr) ((p) + (size_t)((k0) + (rr)) * PITCH + sc)
#define VMW() asm volatile("s_waitcnt vmcnt(0)" ::: "memory")
#define VMWN(n) asm volatile("s_waitcnt vmcnt(%0)" :: "i"(n) : "memory")
#define SLOAD_H(Kp, Vp, k0) do { S.st_v0 = load8<TIn>(ROW(Vp, k0, sr)); S.st_v1 = load8<TIn>(ROW(Vp, k0, 32 + sr));              \
                         S.st_k0 = load8<TIn>(ROW(Kp, k0, sr)); S.st_k1 = load8<TIn>(ROW(Kp, k0, 32 + sr)); } while (0)
#define LOADB(ref, k0, bf) do { if (wid == 0) { const char* g0_ = hi ? (ref).Z16 : (ref).FK + (size_t)((k0) + r32) * 16; const char* g1_ = hi ? (ref).Z16 : (ref).FK + (size_t)((k0) + 32 + r32) * 16; \
        const unsigned l0_ = (unsigned)(uintptr_t)B_lds + (bf) * 2048; glds16(g0_, l0_); glds16(g1_, l0_ + 1024); } } while (0)
#define SWRITE_HK(bf) do { *(bf16x8*)(K_lds + (bf) * SHM_K + kws) = S.st_k0; *(bf16x8*)(K_lds + (bf) * SHM_K + kws + 32 * 256) = S.st_k1; } while (0)
#define SWRITE_HV(bf) do { *(bf16x8*)(V_lds + (bf) * SHM_V + vst0) = S.st_v0; *(bf16x8*)(V_lds + (bf) * SHM_V + vst1) = S.st_v1; } while (0)
#define SWRITE_H(bf) do { SWRITE_HV(bf); SWRITE_HK(bf); } while (0)
#define SLOAD_F(p, k0) do { S.sf0 = *(const f32x4*)ROW(p, k0, sr); S.sf1 = *(const f32x4*)(ROW(p, k0, sr) + 4);                \
                            S.sf2 = *(const f32x4*)ROW(p, k0, 32 + sr); S.sf3 = *(const f32x4*)(ROW(p, k0, 32 + sr) + 4); } while (0)
#define SWRITE_KF(bf) do { *(bf16x8*)(K_lds + (bf) * SHM_K + kws) = pack8(S.sf0, S.sf1); *(bf16x8*)(K_lds + (bf) * SHM_K + kws + 32 * 256) = pack8(S.sf2, S.sf3); } while (0)
#define SWRITE_VF(bf) do { *(bf16x8*)(V_lds + (bf) * SHM_V + vst0) = pack8(S.sf0, S.sf1); *(bf16x8*)(V_lds + (bf) * SHM_V + vst1) = pack8(S.sf2, S.sf3); } while (0)
template <class TIn, class TOut>
__device__ __forceinline__ void causal_swa_prime(const BlockRef<TIn, TOut>& cur, int W, char* lds, Seam<TIn>& S) {
    constexpr bool F32 = same_t<TIn, float>::v;
    int tid_l = threadIdx.x; asm volatile("" : "+v"(tid_l));
    const int tid = tid_l, wid = __builtin_amdgcn_readfirstlane(tid >> 6), lane = tid & 63, r32 = lane & 31, hi = lane >> 5;
    const int sr = tid >> 4, sc = (tid & 15) * 8, kws = KSWZ(sr, sc * 2); char* K_lds = lds + 2 * SHM_V; char* B_lds = lds + ATT_LDS_BYTES;
    const int kb0 = swa_jlo(cur.P0, W) * KVBLK;
    for (int d0 = 0; d0 < 8; ++d0) glds16(cur.Q + (size_t)(wid * QBLK + r32) * PITCH + d0 * 16 + hi * 8, (unsigned)(uintptr_t)(lds + ATT_LDS_BYTES + 4096) + wid * 8192 + d0 * 1024);
    LOADB(cur, kb0, 0);
    if constexpr (F32) { SLOAD_F((const float*)cur.K, kb0); VMW(); SWRITE_KF(0); SBAR(); SLOAD_F((const float*)cur.V, kb0); }
    else { SLOAD_H(cur.K, cur.V, kb0); VMW(); SWRITE_HK(0); }
    __syncthreads();
}
template <class TIn, class TOut>
__device__ __forceinline__ void causal_swa_block(const BlockRef<TIn, TOut>& cur, const BlockRef<TIn, TOut>& nxt, int skv, int W, char* lds, Seam<TIn>& S) {
    constexpr bool F32 = same_t<TIn, float>::v;
    int tid_l = threadIdx.x; asm volatile("" : "+v"(tid_l));
    const int tid = tid_l, wid = __builtin_amdgcn_readfirstlane(tid >> 6), lane = tid & 63, r32 = lane & 31, hi = lane >> 5;
    const int j_lo = swa_jlo(cur.P0, W);
    int j_hi = (cur.P0 + QB - 1) / KVBLK + 1; if (j_hi > skv / KVBLK) j_hi = skv / KVBLK;
    const int NT = j_hi - j_lo;
    const int kbn = swa_jlo(nxt.P0, W) * KVBLK;
    const int qlo = cur.P0 + wid * QBLK, qm = qlo + r32 - 4 * hi;
    char* V_lds = lds; char* K_lds = lds + 2 * SHM_V; const char* Qw = lds + ATT_LDS_BYTES + 4096 + wid * 8192 + lane * 16;
    char* B_lds = lds + ATT_LDS_BYTES;
    float* ws = (float*)(lds + 2 * SHM_V + 2 * SHM_K) + wid * 64; float* li_l = ws, * al_l = ws + 32;
    float m_reg = -1e30f, l_reg = 0; f32x16 o[4] = {};
    const int sr = tid >> 4, sc = (tid & 15) * 8, vst0 = v_st(sr, sc), vst1 = v_st(32 + sr, sc), kws = KSWZ(sr, sc * 2);
    const int vb0 = (int)(uintptr_t)V_lds + v_rd_base(lane);
    const TIn* Kh = cur.K; const TIn* Vh = cur.V;
#define RESC(a) do { if (__any((a) < 1.f)) { if (hi == 0) al_l[r32] = (a); asm volatile("s_waitcnt lgkmcnt(0)" ::: "memory");              \
                     for (int d_ = 0; d_ < 4; ++d_) for (int r = 0; r < 16; ++r) o[d_][r] *= al_l[crow(r, hi)]; } } while (0)
#define KBASE(t) ((j_lo + (t)) * KVBLK)
#define ACT(t) (KBASE(t) <= qlo + QBLK - 1 && KBASE(t) + KVBLK - 1 >= qlo - W + 1)
#define MASKT(P0_, P1_, t) do { const int kb_ = KBASE(t); if ((!SK || ACT(t)) && (kb_ + KVBLK - 1 > qlo || kb_ <= qlo + QBLK - 1 - W)) mask_tile(P0_, P1_, qm - kb_, (unsigned)W); } while (0)
    constexpr int NQL = F32 ? 16 : 8;
    constexpr bool SK = WSKIP && !F32;
#define SEAM_K0() do { VMWN(NQL); if constexpr (F32) { SWRITE_KF(0); SBAR(); SLOAD_F((const float*)nxt.V, kbn); } else { SWRITE_HK(0); } SBAR(); } while (0)
    f32x16 pA0, pA1, pB0, pB1; float mnA, mnB, alA, alB; bf16x8 pa0, pa1, pa2, pa3;
    if constexpr (F32) { VMW(); SWRITE_VF(0); SBAR(); } else { VMW(); SWRITE_HV(0); SBAR(); }
    if (NT > 1) { if constexpr (F32) SLOAD_F((const float*)Kh, KBASE(1)); else SLOAD_H(Kh, Vh, KBASE(1)); }
    SBAR(); qkt<0, SK>(pA0, pA1, K_lds, r32, hi, Qw, ACT(0), B_lds, lane); if (NT > 1) LOADB(cur, KBASE(1), 1);
    if constexpr (F32) { if (NT > 1) { VMW(); SWRITE_KF(1); SBAR(); SLOAD_F((const float*)Vh, KBASE(1)); } }
    MASKT(pA0, pA1, 0); partialSM(pA0, pA1, m_reg, mnA, alA);
    if (NT > 1) { VMW(); if constexpr (F32) { SWRITE_VF(1); SBAR(); if (NT > 2) SLOAD_F((const float*)Kh, KBASE(2)); } else SWRITE_H(1); }
    __syncthreads();
#define HALF_STEP(PX0, PX1, mnX, alX, PY0, PY1, alY, t, KB, VB, SB) do {                                                      \
        SBAR(); qkt<KB, SK>(PX0, PX1, K_lds, r32, hi, Qw, ACT(t), B_lds, lane);                                   \
        finishSM(PY0, PY1, alY, l_reg, pa0, pa1, pa2, pa3); SBAR();                                                           \
        if ((t) + 1 < NT) { if constexpr (F32) { VMW(); SWRITE_KF(SB); SBAR(); SLOAD_F((const float*)Vh, KBASE((t) + 1)); }  \
                            else { SLOAD_H(Kh, Vh, KBASE((t) + 1)); LOADB(cur, KBASE((t) + 1), SB); } SBAR(); }              \
        pv_tile<VB, SK>(o, vb0, pa0, pa1, pa2, pa3, ACT((t) - 1)); MASKT(PX0, PX1, (t)); partialSM(PX0, PX1, m_reg, mnX, alX);                                        \
        __syncthreads();                                                                                                      \
        if ((t) + 1 < NT) { VMW(); if constexpr (F32) { SWRITE_VF(SB); SBAR(); if ((t) + 2 < NT) SLOAD_F((const float*)Kh, KBASE((t) + 2)); } \
                            else { SWRITE_H(SB); } }                                                                          \
        RESC(alX); __syncthreads(); } while (0)
    for (int t = 1; t + 1 < NT; t += 2) {
        HALF_STEP(pB0, pB1, mnB, alB, pA0, pA1, alA, t, 1, 0, 0);
        HALF_STEP(pA0, pA1, mnA, alA, pB0, pB1, alB, t + 1, 0, 1, 1);
    }
    const bool even = (NT & 1) == 0;
    if (even) { SBAR(); qkt<1, SK>(pB0, pB1, K_lds, r32, hi, Qw, ACT(NT - 1), B_lds, lane); SBAR(); }
#define QROW(e) (nxt.Q + (size_t)(wid * QBLK + r32) * PITCH + ((e) >> 1) * 16 + hi * 8 + ((e) & 1) * 4)
    if constexpr (F32) { SLOAD_F((const float*)nxt.K, kbn); SBAR();
#pragma unroll
        for (int e = 0; e < 8; ++e) S.tq[e] = *(const f32x4*)QROW(e); }
    else { SLOAD_H(nxt.K, nxt.V, kbn); LOADB(nxt, kbn, 0); SBAR();
#pragma unroll
        for (int d0 = 0; d0 < 8; ++d0) glds16(nxt.Q + (size_t)(wid * QBLK + r32) * PITCH + d0 * 16 + hi * 8, (unsigned)(uintptr_t)(lds + ATT_LDS_BYTES + 4096) + wid * 8192 + d0 * 1024); }
    SBAR();
    finishSM(pA0, pA1, alA, l_reg, pa0, pa1, pa2, pa3); SBAR();
    if constexpr (F32) {
#pragma unroll
        for (int e = 8; e < 16; ++e) S.tq[e] = *(const f32x4*)QROW(e); SBAR(); }
#undef QROW
    pv_tile<0, SK>(o, vb0, pa0, pa1, pa2, pa3, ACT(even ? NT - 2 : NT - 1));
    if (even) { MASKT(pB0, pB1, NT - 1); partialSM(pB0, pB1, m_reg, mnB, alB); __syncthreads(); RESC(alB);
        finishSM(pB0, pB1, alB, l_reg, pa0, pa1, pa2, pa3); SBAR(); pv_tile<1, SK>(o, vb0, pa0, pa1, pa2, pa3, ACT(NT - 1)); }
    SBAR(); SEAM_K0();
    if (hi == 0) li_l[r32] = l_reg; asm volatile("s_waitcnt lgkmcnt(0)" ::: "memory");
    float rli[16];
#pragma unroll
    for (int r = 0; r < 16; ++r) rli[r] = __builtin_amdgcn_rcpf(li_l[crow(r, hi)]);
    TOut* Ow = cur.O + (size_t)(wid * QBLK) * PITCH;
#pragma unroll
    for (int r = 0; r < 16; ++r) { const int orow = crow(r, hi);
#pragma unroll
        for (int d0 = 0; d0 < 4; ++d0) { const float v = o[d0][r] * rli[r];
            if constexpr (same_t<TOut, float>::v) { Ow[(size_t)orow * PITCH + d0 * 32 + r32] = v; }
            else { const float vn = __shfl_xor(v, 1);
                   if ((r32 & 1) == 0) *(unsigned*)(Ow + (size_t)orow * PITCH + d0 * 32 + r32) = cvtpk(v, vn); } } }
    __syncthreads();
#undef RESC
#undef KBASE
#undef ACT
#undef MASKT
#undef SEAM_K0
#undef HALF_STEP
}
#undef ROW
#undef VMW
#undef VMWN
#undef SLOAD_H
#undef SWRITE_HK
#undef SWRITE_HV
#undef SWRITE_H
#undef SLOAD_F
#undef SWRITE_KF
#undef SWRITE_VF

#undef LOADB
}

constexpr int NWAVES = 8, NT = NWAVES * 64;
constexpr int BATCH = 4, SEQ = 2048, D = 2048, M = BATCH * SEQ, FF = 8192, DEPTH = 2;
constexpr int INW = 26704, NPAD = 26880, NMAIN = 26624;
constexpr int MODW = 6 * D;
constexpr float LN_EPS = 1e-5f, NORM_EPS = 1e-6f, ALPHA = 1.4142135623730951f;
constexpr size_t MiB = 1u << 20;
constexpr size_t ACT_E = (size_t)M * D;
constexpr size_t WS_CTL = 0, CTL_ZERO_BYTES = 1 * MiB;
constexpr size_t WS_MODP = 2 * MiB;
constexpr size_t WS_MOD = 8 * MiB;
constexpr size_t WS_SMALL = 10 * MiB;
constexpr size_t WS_CUM = 18 * MiB;
constexpr size_t WS_BETA = 19 * MiB, WS_GG = 20 * MiB;
constexpr size_t WS_FKB = 21 * MiB;
constexpr size_t WS_W = 32 * MiB;
constexpr size_t W_LAYER = 201 * MiB, W_IN = 0, W_A = 105 * MiB, W_B = 113 * MiB, W_C = 121 * MiB, W_O = 129 * MiB, W_1 = 137 * MiB, W_2 = 169 * MiB;
constexpr size_t WS_U = 448 * MiB;
constexpr size_t WS_X = 480 * MiB;
constexpr size_t WS_PRE = 544 * MiB;
constexpr size_t WS_T = 608 * MiB;
constexpr size_t WS_H = 608 * MiB;
constexpr size_t WS_YA = 1024 * MiB, WS_YB = 1056 * MiB, WS_YC = 1088 * MiB, WS_MG = 1120 * MiB;
constexpr size_t WS_MACC = 1152 * MiB;
constexpr size_t WS_QNB = 1216 * MiB, WS_KNB = 1248 * MiB;
constexpr size_t WS_KTP = 1280 * MiB;
constexpr size_t WS_VTP = 1312 * MiB;
constexpr size_t WS_TP = 1344 * MiB, WS_IP = 1376 * MiB;
constexpr size_t WS_ORAW = 1408 * MiB;
constexpr size_t WS_GCUM = 24 * MiB;
constexpr size_t WS_END = 1472 * MiB;
constexpr int CW_BAR = 4096;
constexpr int LDS_BYTES = 147456, MISC_OFF = LDS_BYTES - 512;
enum { TI_CB = 0, TI_CC, TI_CH, TI_GQ, TI_GK, TI_GV, TI_GZ, TI_FQ, TI_FK, TI_FV, TI_MA, TI_MB, TI_MC };
__host__ __device__ constexpr int src_off(int t) { return t < 7 ? 2048 * t : (t < 10 ? 14400 + 2048 * (t - 7) : 20560 + 2048 * (t - 10)); }
constexpr int SRC_GB = 14336, SRC_FF = 20544;
enum { I_X = 0, I_C, I_WADA, I_BADA, I_WIN, I_CONVW, I_GCONVW, I_ALOG, I_DTB, I_GNORMW, I_FBIAS, I_WA, I_WB, I_WC, I_WO, I_LN1G, I_LN1B, I_W1, I_W2, I_LN2G, I_LN2B, N_IN };

typedef unsigned u32x4 __attribute__((ext_vector_type(4)));
typedef unsigned u32x2 __attribute__((ext_vector_type(2)));
__device__ __forceinline__ float wave_sum(float v) {
#pragma unroll
    for (int o = 1; o < 64; o <<= 1) v += __shfl_xor(v, o);
    return v;
}
__device__ __forceinline__ float wave_max(float v) {
#pragma unroll
    for (int o = 1; o < 64; o <<= 1) v = fmaxf(v, __shfl_xor(v, o));
    return v;
}
__device__ __forceinline__ float bflo(unsigned w) { return __builtin_bit_cast(float, w << 16); }
__device__ __forceinline__ float bfhi(unsigned w) { return __builtin_bit_cast(float, w & 0xffff0000u); }
__device__ __forceinline__ void unpack8(const u32x4 w, float (&f)[8]) { f[0] = bflo(w.x); f[1] = bfhi(w.x); f[2] = bflo(w.y); f[3] = bfhi(w.y); f[4] = bflo(w.z); f[5] = bfhi(w.z); f[6] = bflo(w.w); f[7] = bfhi(w.w); }
__device__ __forceinline__ u32x4 pack8(const float (&f)[8]) { u32x4 w; w.x = pg8::cvt_pk_bf16(f[0], f[1]); w.y = pg8::cvt_pk_bf16(f[2], f[3]); w.z = pg8::cvt_pk_bf16(f[4], f[5]); w.w = pg8::cvt_pk_bf16(f[6], f[7]); return w; }
__device__ __forceinline__ float fsilu(float x) { return x * __builtin_amdgcn_rcpf(1.f + __expf(-x)); }

__device__ __forceinline__ void tr_item(const float* __restrict__ W, size_t ldw, bf16* __restrict__ WT, size_t K, int kb, int nb, int lane) {
    const int kq = lane & 7, nq = lane >> 3;
    const float* src = W + (size_t)(kb * 64 + kq * 8) * ldw + nb * 32 + nq * 4;
    f32x4 v[8];
#pragma unroll
    for (int i = 0; i < 8; ++i) v[i] = *(const f32x4*)(src + (size_t)i * ldw);
    bf16* dst = WT + (size_t)(nb * 32 + nq * 4) * K + kb * 64 + kq * 8;
#pragma unroll
    for (int j = 0; j < 4; ++j) { u32x4 o; o.x = pg8::cvt_pk_bf16(v[0][j], v[1][j]); o.y = pg8::cvt_pk_bf16(v[2][j], v[3][j]); o.z = pg8::cvt_pk_bf16(v[4][j], v[5][j]); o.w = pg8::cvt_pk_bf16(v[6][j], v[7][j]);
        *(u32x4*)(dst + (size_t)j * K) = o; }
}

__device__ __forceinline__ void modulate_row(const float* __restrict__ xr, bf16* __restrict__ ur, const float* __restrict__ shift, const float* __restrict__ scale, int lane) {
#pragma unroll
    for (int j = 0; j < 8; ++j) { const int c = 4 * lane + 256 * j; const f32x4 v = *(const f32x4*)(xr + c), sc = *(const f32x4*)(scale + c), sh = *(const f32x4*)(shift + c);
        const f32x4 y = v * (sc + 1.f) + sh; u32x2 o; o.x = pg8::cvt_pk_bf16(y[0], y[1]); o.y = pg8::cvt_pk_bf16(y[2], y[3]); *(u32x2*)(ur + c) = o; }
}
__device__ __forceinline__ void ln_mod_row(const float* __restrict__ pre, const float* __restrict__ g, const float* __restrict__ bt, float* __restrict__ xo, bf16* __restrict__ uo,
                                           const float* __restrict__ shift, const float* __restrict__ scale, int lane) {
    f32x4 v[8]; float s = 0.f;
#pragma unroll
    for (int j = 0; j < 8; ++j) { v[j] = *(const f32x4*)(pre + 4 * lane + 256 * j); s += (v[j][0] + v[j][1]) + (v[j][2] + v[j][3]); }
    const float mean = wave_sum(s) * (1.f / D); float s2 = 0.f;
#pragma unroll
    for (int j = 0; j < 8; ++j) { v[j] = v[j] - mean; s2 += (v[j][0] * v[j][0] + v[j][1] * v[j][1]) + (v[j][2] * v[j][2] + v[j][3] * v[j][3]); }
    const float rstd = 1.f / sqrtf(wave_sum(s2) * (1.f / D) + LN_EPS);
#pragma unroll
    for (int j = 0; j < 8; ++j) { const int c = 4 * lane + 256 * j; const f32x4 y = v[j] * rstd * *(const f32x4*)(g + c) + *(const f32x4*)(bt + c);
        *(f32x4*)(xo + c) = y;
        if (uo) { const f32x4 u = y * (*(const f32x4*)(scale + c) + 1.f) + *(const f32x4*)(shift + c); u32x2 o; o.x = pg8::cvt_pk_bf16(u[0], u[1]); o.y = pg8::cvt_pk_bf16(u[2], u[3]); *(u32x2*)(uo + c) = o; } }
}

struct Args { const float* in[N_IN]; float* out; unsigned char* ws; int ph_lo, ph_hi, sub, pad; };
constexpr int NPL = 11, NPH = 3 + DEPTH * NPL;

#define IN(k) (lo <= (k) && (k) < hi)
#define SEAM(k) do { if (IN(k) && IN((k) + 1)) xcd_barrier(bar); } while (0)
#define CAS __attribute__((address_space(4)))
#define AIN(i) ((const float*)(GAS const float*)ap->in[i])
#define PH_BEGIN \
    int tid = threadIdx.x; asm volatile("" : "+v"(tid)); const int lane = tid & 63, wave = __builtin_amdgcn_readfirstlane(tid >> 6); \
    const int gw = blk * NWAVES + wave, gtid = blk * NT + tid; (void)gw; (void)gtid; (void)lane; \
    const CAS Args* ap = (const CAS Args*)__builtin_amdgcn_kernarg_segment_ptr(); asm volatile("" : "+s"(ap));     \
    GAS unsigned char* ws_g = (GAS unsigned char*)ap->ws; asm volatile("" : "+s"(ws_g)); unsigned char* ws = (unsigned char*)ws_g;     \
    const float* x_in = AIN(I_X); (void)x_in; \
    float* modp = (float*)(ws + WS_MODP); float* mod = (float*)(ws + WS_MOD); float* SMALL = (float*)(ws + WS_SMALL); (void)modp; (void)mod; (void)SMALL; \
    float* CUM = (float*)(ws + WS_CUM); float* BETA = (float*)(ws + WS_BETA); float* GG = (float*)(ws + WS_GG); (void)CUM; (void)BETA; (void)GG; \
    bf16* U = (bf16*)(ws + WS_U); float* X = (float*)(ws + WS_X); float* PRE = (float*)(ws + WS_PRE); (void)U; (void)X; (void)PRE; \
    bf16* T = (bf16*)(ws + WS_T); bf16* H = (bf16*)(ws + WS_H); (void)T; (void)H; \
    bf16* YA = (bf16*)(ws + WS_YA); bf16* YB = (bf16*)(ws + WS_YB); bf16* YC = (bf16*)(ws + WS_YC); bf16* MG = (bf16*)(ws + WS_MG); (void)YA; (void)YB; (void)YC; (void)MG; \
    float* MACC = (float*)(ws + WS_MACC); bf16* QNB = (bf16*)(ws + WS_QNB); bf16* KNB = (bf16*)(ws + WS_KNB); bf16* KTP = (bf16*)(ws + WS_KTP); bf16* VTP = (bf16*)(ws + WS_VTP); \
    bf16* TP = (bf16*)(ws + WS_TP); bf16* IP = (bf16*)(ws + WS_IP); float* ORAW = (float*)(ws + WS_ORAW); float* GCUM = (float*)(ws + WS_GCUM); \
    (void)MACC; (void)QNB; (void)KNB; (void)KTP; (void)VTP; (void)TP; (void)IP; (void)ORAW; (void)GCUM;


template <int l> __device__ __forceinline__ void layer_phases(const int lo, const int hi, const XcdBarrier& bar, LAS unsigned char* lds, unsigned char* lds_raw, const int blk, const int G, const int NGW, const int NGT) {
        const int pb = 3 + l * NPL;
#define LAYER_PTRS unsigned char* wl = ws + WS_W + (size_t)l * W_LAYER; const float* modl = mod + (size_t)l * 4 * MODW; const float* Xin = (l == 0) ? x_in : X; (void)wl; (void)modl; (void)Xin;
        if (IN(pb + 0)) { PH_BEGIN LAYER_PTRS
            pg8::Gemm g{U, (const bf16*)(wl + W_IN), M, NMAIN, D}; pg8::StaticOrder S; S.init(M, NMAIN, G, blk);
            pg8::EpiInProj E{T, SMALL, ACT_E};
            pg8::gemm_phase<pg8::EpiInProj, pg8::StaticOrder, true, true>(lds, g, S, E);
            { const int fr = lane & 15, fq = lane >> 4, rt = wave & 1, kq4 = wave >> 1; LAS f32x4* part = (LAS f32x4*)lds; const bf16* Wsm = (const bf16*)(wl + W_IN) + (size_t)13 * D * D;
              for (int rb = blk; rb < M / 32; rb += G) {
                f32x4 acc[5];
#pragma unroll
                for (int nt = 0; nt < 5; ++nt) acc[nt] = (f32x4){0.f, 0.f, 0.f, 0.f};
                const bf16* Ap = U + (size_t)(rb * 32 + rt * 16 + fr) * D + kq4 * 512 + 8 * fq; const bf16* Bp = Wsm + (size_t)fr * D + kq4 * 512 + 8 * fq;
#pragma unroll 4
                for (int ks = 0; ks < 16; ++ks) { const pg8::bf16x8 av = *(const pg8::bf16x8*)(Ap + 32 * ks);
#pragma unroll
                    for (int nt = 0; nt < 5; ++nt) acc[nt] = __builtin_amdgcn_mfma_f32_16x16x32_bf16(av, *(const pg8::bf16x8*)(Bp + (size_t)nt * 16 * D + 32 * ks), acc[nt], 0, 0, 0); }
                __syncthreads();
#pragma unroll
                for (int nt = 0; nt < 5; ++nt) part[((kq4 * 2 + rt) * 5 + nt) * 64 + lane] = acc[nt];
                __syncthreads();
                for (int o = tid; o < 2 * 5 * 64; o += NT) { const int rt2 = o / 320, rem = o % 320, nt = rem >> 6, ln = rem & 63;
                    const f32x4 s = (part[((0 * 2 + rt2) * 5 + nt) * 64 + ln] + part[((1 * 2 + rt2) * 5 + nt) * 64 + ln]) + (part[((2 * 2 + rt2) * 5 + nt) * 64 + ln] + part[((3 * 2 + rt2) * 5 + nt) * 64 + ln]);
                    float* sp = SMALL + (size_t)(rb * 32 + rt2 * 16 + 4 * (ln >> 4)) * 256 + 16 * nt + (ln & 15);
#pragma unroll
                    for (int r = 0; r < 4; ++r) sp[(size_t)r * 256] = s[r]; }
              } }
        }
        SEAM(pb + 0);
        if (IN(pb + 1)) { PH_BEGIN LAYER_PTRS
            const int sub = ap->sub;
            if (sub & 1) { const float* cw = AIN(I_CONVW) + (size_t)l * 3 * D; const bf16 *CB = T + TI_CB * ACT_E, *CC = T + TI_CC * ACT_E, *CH = T + TI_CH * ACT_E;
              for (int it = gtid; it < (M / 8) * 256; it += NGT) {
                const int col = (it & 255) * 8, m0 = (it >> 8) * 8; const bool first = (m0 & (SEQ - 1)) == 0;
                float w0[8], w1[8], w2[8], p2[8], p1[8];
#pragma unroll
                for (int i = 0; i < 8; ++i) { w0[i] = cw[col + i]; w1[i] = cw[D + col + i]; w2[i] = cw[2 * D + col + i]; p2[i] = 0.f; p1[i] = 0.f; }
                if (!first) { float a[8], b[8];
                    unpack8(*(const u32x4*)(CC + (size_t)(m0 - 2) * D + col), a); unpack8(*(const u32x4*)(CH + (size_t)(m0 - 2) * D + col), b);
#pragma unroll
                    for (int i = 0; i < 8; ++i) p2[i] = a[i] * b[i];
                    unpack8(*(const u32x4*)(CC + (size_t)(m0 - 1) * D + col), a); unpack8(*(const u32x4*)(CH + (size_t)(m0 - 1) * D + col), b);
#pragma unroll
                    for (int i = 0; i < 8; ++i) p1[i] = a[i] * b[i]; }
                for (int r = 0; r < 8; ++r) { const size_t o = (size_t)(m0 + r) * D + col; float a[8], b[8], g[8], y[8];
                    unpack8(*(const u32x4*)(CC + o), a); unpack8(*(const u32x4*)(CH + o), b); unpack8(*(const u32x4*)(CB + o), g);
#pragma unroll
                    for (int i = 0; i < 8; ++i) { const float p0 = a[i] * b[i]; y[i] = g[i] * (w0[i] * p2[i] + w1[i] * p1[i] + w2[i] * p0); p2[i] = p1[i]; p1[i] = p0; }
                    *(u32x4*)(YA + o) = pack8(y); }
              } }
            if (sub & 2) { const float* gcw = AIN(I_GCONVW) + (size_t)l * 4 * 6144;
              for (int it = gw; it < 6144; it += NGW) {
                const int cgp = it & 3, ten = (it >> 2) % 3, rb = it / 12; const int ch = cgp * 512 + lane * 8; const int m0 = rb * 16; const bool first = (m0 & (SEQ - 1)) == 0;
                const bf16* src = T + (size_t)(TI_GQ + ten) * ACT_E; bf16* dst = (ten == 0) ? QNB : KNB;
                const int bb = m0 >> 11, nn = (m0 & (SEQ - 1)) >> 6; bf16* tdst = (ten == 1) ? KTP + ((size_t)((bb * 32 + nn) * 16) * 128 + ch) * 64 : VTP + ((size_t)((bb * 32 + nn) * 32) * 64 + ch) * 64;
                float w[4][8], h3[8], h2[8], h1[8], yb[3][8];
#pragma unroll
                for (int i = 0; i < 8; ++i) { w[0][i] = gcw[ten * D + ch + i]; w[1][i] = gcw[6144 + ten * D + ch + i]; w[2][i] = gcw[2 * 6144 + ten * D + ch + i]; w[3][i] = gcw[3 * 6144 + ten * D + ch + i]; h3[i] = 0.f; h2[i] = 0.f; h1[i] = 0.f; }
                if (!first) { unpack8(*(const u32x4*)(src + (size_t)(m0 - 3) * D + ch), h3); unpack8(*(const u32x4*)(src + (size_t)(m0 - 2) * D + ch), h2); unpack8(*(const u32x4*)(src + (size_t)(m0 - 1) * D + ch), h1); }
#pragma unroll
                for (int r = 0; r < 16; ++r) { const size_t o = (size_t)(m0 + r) * D + ch; float h0[8], y[8]; unpack8(*(const u32x4*)(src + o), h0); float ss = 0.f;
#pragma unroll
                    for (int i = 0; i < 8; ++i) { const float a = w[0][i] * h3[i] + w[1][i] * h2[i] + w[2][i] * h1[i] + w[3][i] * h0[i]; y[i] = fsilu(a); ss += y[i] * y[i]; h3[i] = h2[i]; h2[i] = h1[i]; h1[i] = h0[i]; }
                    if (ten < 2) { ss += __shfl_xor(ss, 1); ss += __shfl_xor(ss, 2); ss += __shfl_xor(ss, 4); ss += __shfl_xor(ss, 8); const float rn = __builtin_amdgcn_rsqf(ss + NORM_EPS);
#pragma unroll
                        for (int i = 0; i < 8; ++i) y[i] *= rn;
                        *(u32x4*)(dst + o) = pack8(y); }
                    if (ten >= 1 && !(sub & 32)) {
                        if ((r & 3) < 3) {
#pragma unroll
                            for (int i = 0; i < 8; ++i) yb[r & 3][i] = y[i];
                        } else {
                            const int pos4 = ((m0 & 63) + r - 3), pp = (pos4 & 32) + 8 * ((pos4 >> 2) & 3) + 4 * ((pos4 >> 4) & 1);
#pragma unroll
                            for (int i = 0; i < 8; ++i) { u32x2 v; v.x = pg8::cvt_pk_bf16(yb[0][i], yb[1][i]); v.y = pg8::cvt_pk_bf16(yb[2][i], y[i]); *(u32x2*)(tdst + (size_t)i * 64 + pp) = v; }
                        } } }
              } }
            if (sub & 4) { const float* alog = AIN(I_ALOG) + l * 32; const float* dtb = AIN(I_DTB) + l * 32;
              for (int i = gtid; i < M * 32; i += NGT) { const int m = i >> 5, hv = i & 31; const float bl = SMALL[(size_t)m * 256 + hv], al = SMALL[(size_t)m * 256 + 32 + hv];
                BETA[i] = __builtin_amdgcn_rcpf(1.f + __expf(-bl)); const float xx = al + dtb[hv]; const float sp = fmaxf(xx, 0.f) + __logf(1.f + __expf(-fabsf(xx))); GG[i] = -__expf(alog[hv]) * sp; } }
            if (sub & 8) { const float* fbias = AIN(I_FBIAS) + l * 16; LAS float* wsum = (LAS float*)lds;
              for (int it = blk; it < 64; it += G) { const int b = it >> 4, h = it & 15; const float fb = fbias[h]; const size_t m0 = (size_t)b * SEQ + 4 * tid; float ls[4];
#pragma unroll
                for (int i = 0; i < 4; ++i) { const float xx = SMALL[(m0 + i) * 256 + 64 + h] + fb; ls[i] = fminf(xx, 0.f) - __logf(1.f + __expf(-fabsf(xx))); }
                const float s4 = (ls[0] + ls[1]) + (ls[2] + ls[3]); float inc = s4;
#pragma unroll
                for (int o = 1; o < 64; o <<= 1) { const float nb = __shfl_up(inc, o); if (lane >= o) inc += nb; }
                __syncthreads();
                if (lane == 63) wsum[wave] = inc;
                __syncthreads();
                float run = inc - s4;
                for (int w2 = 0; w2 < wave; ++w2) run += wsum[w2];
#pragma unroll
                for (int i = 0; i < 4; ++i) { run += ls[i];
                    const float xq = run * 11.313708498984761f; const unsigned h1 = f2bf(xq); const float r1 = xq - __builtin_bit_cast(float, h1 << 16); const unsigned h2 = f2bf(r1); const float r2 = r1 - __builtin_bit_cast(float, h2 << 16); const unsigned h3 = f2bf(r2);
                    const unsigned n1 = h1 ^ 0x8000u, n2 = h2 ^ 0x8000u, n3 = h3 ^ 0x8000u;
                    *((u32x4*)(ws + WS_FKB) + ((size_t)it * SEQ + 4 * tid + i)) = (u32x4){n1 | (n2 << 16), n3, 0u, 0u}; }
              } }
        }
        SEAM(pb + 1);
        if (IN(pb + 2)) { PH_BEGIN LAYER_PTRS
            LAS float* Ll = (LAS float*)lds;
            LAS float* GCl = (LAS float*)(lds + 131072);
            LAS float* BTl = GCl + 512;
            const int lane_o = lane;
            for (int it = blk; it < 512; it += G) {
                int lane = lane_o; asm volatile("" : "+v"(lane));
                const int fr = lane & 15, fq = lane >> 4;
                const int b = it >> 7, hk = (it >> 3) & 15, cq = it & 7; const int row0 = b * SEQ + cq * 256;
                __syncthreads();
                { const int e = wave >> 2, c = wave & 3, hv = 2 * hk + e; const size_t mm = (size_t)row0 + c * 64 + lane;
                  float gv = GG[mm * 32 + hv]; const float bv = BETA[mm * 32 + hv];
#pragma unroll
                  for (int o = 1; o < 64; o <<= 1) { const float nb = __shfl_up(gv, o); if (lane >= o) gv += nb; }
                  GCl[e * 256 + c * 64 + lane] = gv; BTl[e * 256 + c * 64 + lane] = bv; GCUM[mm * 32 + hv] = gv; }
                __syncthreads();
                { const int c = wave >> 1, P = wave & 1, n = cq * 4 + c; const bf16* Kb = KNB + ((size_t)row0 + c * 64) * D + hk * 128; const bf16* Qb = QNB + ((size_t)row0 + c * 64) * D + hk * 128;
                  pg8::bf16x8 Kf[4][4];
#pragma unroll
                  for (int t = 0; t < 4; ++t)
#pragma unroll
                      for (int s = 0; s < 4; ++s) Kf[t][s] = *(const pg8::bf16x8*)(Kb + (size_t)(16 * t + fr) * D + 32 * s + 8 * fq);
                  if (P == 0) {
#pragma unroll
                      for (int a = 0; a < 4; ++a)
#pragma unroll
                          for (int b2 = 0; b2 <= a; ++b2) { f32x4 acc = {0.f, 0.f, 0.f, 0.f};
#pragma unroll
                              for (int s = 0; s < 4; ++s) acc = __builtin_amdgcn_mfma_f32_16x16x32_bf16(Kf[a][s], Kf[b2][s], acc, 0, 0, 0);
#pragma unroll
                              for (int e = 0; e < 2; ++e) { const f32x4 gi = *(const LAS f32x4*)(GCl + e * 256 + c * 64 + 16 * a + 4 * fq), bi = *(const LAS f32x4*)(BTl + e * 256 + c * 64 + 16 * a + 4 * fq); const float gj = GCl[e * 256 + c * 64 + 16 * b2 + fr];
#pragma unroll
                                  for (int r = 0; r < 4; ++r) { const int i = 16 * a + 4 * fq + r, j = 16 * b2 + fr; Ll[((c * 2 + e) * 64 + i) * 64 + j] = (i > j) ? bi[r] * acc[r] * __expf(gi[r] - gj) : 0.f; } } }
                  } else {
#pragma unroll
                      for (int nt = 0; nt < 4; ++nt) { pg8::bf16x8 Qf[4];
#pragma unroll
                          for (int s = 0; s < 4; ++s) Qf[s] = *(const pg8::bf16x8*)(Qb + (size_t)(16 * nt + fr) * D + 32 * s + 8 * fq);
#pragma unroll
                          for (int mt = 0; mt < 4; ++mt) { f32x4 acc = {0.f, 0.f, 0.f, 0.f};
                              if (mt <= nt) {
#pragma unroll
                                  for (int s = 0; s < 4; ++s) acc = __builtin_amdgcn_mfma_f32_16x16x32_bf16(Kf[mt][s], Qf[s], acc, 0, 0, 0); }
#pragma unroll
                              for (int e = 0; e < 2; ++e) { const int hv = 2 * hk + e, i = 16 * nt + fr; float y[4] = {0.f, 0.f, 0.f, 0.f};
                                  if (mt <= nt) { const float gi = GCl[e * 256 + c * 64 + i]; const f32x4 gj = *(const LAS f32x4*)(GCl + e * 256 + c * 64 + 16 * mt + 4 * fq);
#pragma unroll
                                      for (int r = 0; r < 4; ++r) { const int j = 16 * mt + 4 * fq + r; y[r] = (i >= j) ? acc[r] * 0.08838834764831845f * __expf(gi - gj[r]) : 0.f; } }
                                  u32x2 v; v.x = pg8::cvt_pk_bf16(y[0], y[1]); v.y = pg8::cvt_pk_bf16(y[2], y[3]);
                                  *(u32x2*)(IP + ((size_t)((b * 32 + n) * 32 + hv)) * 4096 + i * 64 + 32 * (mt >> 1) + 8 * fq + 4 * (mt & 1)) = v; } } }
                  } }
                __syncthreads();
                { const int c = wave >> 1, e = wave & 1, hv = 2 * hk + e, n = cq * 4 + c; LAS float* L = Ll + (c * 2 + e) * 4096;
                  float Tc[64];
#pragma unroll
                  for (int i = 0; i < 64; ++i) { float acc = (i == lane) ? 1.f : 0.f;
#pragma unroll
                      for (int j4 = 0; j4 < (i + 3) / 4; ++j4) { const f32x4 lv = *(const LAS f32x4*)(L + i * 64 + 4 * j4);
#pragma unroll
                          for (int k = 0; k < 4; ++k) if (4 * j4 + k < i) acc -= lv[k] * Tc[4 * j4 + k]; }
                      Tc[i] = acc; }
                  const float bc = BTl[e * 256 + c * 64 + lane]; const int pp = (lane & 32) + 8 * ((lane >> 2) & 3) + 4 * ((lane >> 4) & 1) + (lane & 3);
                  LAS unsigned short* Tl = (LAS unsigned short*)L;
                  asm volatile("s_waitcnt lgkmcnt(0)" ::: "memory");
#pragma unroll
                  for (int i = 0; i < 64; ++i) Tl[i * 64 + pp] = (unsigned short)f2bf(Tc[i] * bc);
                  asm volatile("s_waitcnt lgkmcnt(0)" ::: "memory");
                  bf16* tp = TP + ((size_t)((b * 32 + n) * 32 + hv)) * 4096;
#pragma unroll
                  for (int k = 0; k < 8; ++k) *(u32x4*)(tp + (k * 64 + lane) * 8) = *(const LAS u32x4*)((const LAS unsigned char*)L + (k * 64 + lane) * 16); }
            }
        }
        SEAM(pb + 2);
        if (IN(pb + 3)) { PH_BEGIN LAYER_PTRS
            const int sub = ap->sub;
            if (blk < 128 && (sub & 1)) {
                const int b = blk >> 5, hv = blk & 31, hk = hv >> 1, fr = lane & 15, fq = lane >> 4;
                LAS float* EGl = (LAS float*)(lds + 131072);
                if (wave >= 4) {
                    const int lw = wave - 4;
                    for (int n = 0; n < 32; ++n) {
                        const int row0 = b * SEQ + n * 64; const unsigned dstb = (unsigned)(uintptr_t)(lds) + (unsigned)((n & 1) * 65536);
                        if (sub & 32) {   } else
                        if (lw < 2) { const bf16* srcb = (lw == 0 ? KNB : QNB) + (size_t)row0 * D + hk * 128;
#pragma unroll
                            for (int f = 0; f < 16; ++f) fox::glds16(srcb + (size_t)(16 * (f >> 2) + fr) * D + 32 * (f & 3) + 8 * fq, dstb + lw * 16384 + f * 1024);
                        } else if (lw == 2) { const bf16* srcb = KTP + ((size_t)((b * 32 + n) * 16 + hk)) * 8192;
#pragma unroll
                            for (int f = 0; f < 16; ++f) { const int tau = f >> 1, s2 = f & 1, dkr = 32 * (tau >> 1) + 8 * (fr >> 2) + 4 * (tau & 1) + (fr & 3); fox::glds16(srcb + (size_t)dkr * 64 + 32 * s2 + 8 * fq, dstb + 32768 + f * 1024); }
                        } else { const bf16* st = TP + ((size_t)((b * 32 + n) * 32 + hv)) * 4096; const bf16* si = IP + ((size_t)((b * 32 + n) * 32 + hv)) * 4096;
#pragma unroll
                            for (int f = 0; f < 8; ++f) { fox::glds16(st + (16 * (f >> 1) + fr) * 64 + 32 * (f & 1) + 8 * fq, dstb + 49152 + f * 1024); fox::glds16(si + (16 * (f >> 1) + fr) * 64 + 32 * (f & 1) + 8 * fq, dstb + 57344 + f * 1024); }
                            const float gc = GCUM[(size_t)(row0 + lane) * 32 + hv], gl = GCUM[(size_t)(row0 + 63) * 32 + hv];
                            EGl[(n & 1) * 128 + lane] = __expf(gc); EGl[(n & 1) * 128 + 64 + lane] = __expf(gl - gc); }
                        asm volatile("s_waitcnt vmcnt(0) lgkmcnt(0)" ::: "memory");
                        __builtin_amdgcn_s_barrier();
                    }
                } else {
                    const int w = wave;
                    f32x4 Sacc[8];
#pragma unroll
                    for (int t = 0; t < 8; ++t) Sacc[t] = (f32x4){0.f, 0.f, 0.f, 0.f};
                    const bf16* vb = VTP + ((size_t)(b * 32) * 32 + hv) * 4096 + (size_t)(16 * w + fr) * 64 + 8 * fq;
                    u32x4 vnx0 = *(const u32x4*)(vb), vnx1 = *(const u32x4*)(vb + 32);
                    for (int n = 0; n < 32; ++n) {
                        asm volatile("s_waitcnt lgkmcnt(0)" ::: "memory");
                        __builtin_amdgcn_s_barrier();
                        asm volatile("" ::: "memory");
                        if (sub & 64) continue;
                        const LAS unsigned char* B = lds + (n & 1) * 65536 + lane * 16; const LAS float* EG = EGl + (n & 1) * 128; const LAS float* EGL = EG + 64; const int row0 = b * SEQ + n * 64;
                        const u32x4 vc0 = vnx0, vc1 = vnx1;
                        if (n + 1 < 32) { vnx0 = *(const u32x4*)(vb + (size_t)(n + 1) * 32 * 4096); vnx1 = *(const u32x4*)(vb + (size_t)(n + 1) * 32 * 4096 + 32); }
#define LDF(dst, off, nfr) do { _Pragma("unroll") for (int f_ = 0; f_ < (nfr); ++f_) dst[f_] = *(const LAS pg8::bf16x8*)(B + (off) + f_ * 1024); } while (0)
#define SB() __builtin_amdgcn_sched_barrier(0)
                        pg8::bf16x8 FA[16], FB[16], FC[8];
                        LDF(FA, 0, 16); SB();
                        pg8::bf16x8 Sb[4];
#pragma unroll
                        for (int s = 0; s < 4; ++s) { const float t8[8] = {Sacc[2 * s][0], Sacc[2 * s][1], Sacc[2 * s][2], Sacc[2 * s][3], Sacc[2 * s + 1][0], Sacc[2 * s + 1][1], Sacc[2 * s + 1][2], Sacc[2 * s + 1][3]}; const u32x4 pk = pack8(t8); Sb[s] = __builtin_bit_cast(pg8::bf16x8, pk); }
                        SB(); LDF(FC, 49152, 8); SB();
                        f32x4 KS[4];
#pragma unroll
                        for (int mt = 0; mt < 4; ++mt) { KS[mt] = (f32x4){0.f, 0.f, 0.f, 0.f};
#pragma unroll
                            for (int s = 0; s < 4; ++s) KS[mt] = __builtin_amdgcn_mfma_f32_16x16x32_bf16(FA[mt * 4 + s], Sb[s], KS[mt], 0, 0, 0); }
                        SB(); LDF(FB, 32768, 16); SB();
                        pg8::bf16x8 Rb[2];
#pragma unroll
                        for (int s2 = 0; s2 < 2; ++s2) { const f32x4 e0 = *(const LAS f32x4*)(EG + 32 * s2 + 4 * fq), e1 = *(const LAS f32x4*)(EG + 32 * s2 + 16 + 4 * fq); float v8[8]; unpack8(s2 ? vc1 : vc0, v8); float r8[8];
#pragma unroll
                            for (int k = 0; k < 4; ++k) { r8[k] = v8[k] - e0[k] * KS[2 * s2][k]; r8[4 + k] = v8[4 + k] - e1[k] * KS[2 * s2 + 1][k]; }
                            const u32x4 pk = pack8(r8); Rb[s2] = __builtin_bit_cast(pg8::bf16x8, pk); }
                        f32x4 Vn[4];
#pragma unroll
                        for (int mt = 0; mt < 4; ++mt) { Vn[mt] = (f32x4){0.f, 0.f, 0.f, 0.f};
#pragma unroll
                            for (int s2 = 0; s2 < 2; ++s2) Vn[mt] = __builtin_amdgcn_mfma_f32_16x16x32_bf16(FC[mt * 2 + s2], Rb[s2], Vn[mt], 0, 0, 0); }
                        SB(); LDF(FA, 16384, 16); SB();
                        pg8::bf16x8 Vnb[2], Vsb[2];
#pragma unroll
                        for (int s2 = 0; s2 < 2; ++s2) { const f32x4 g0 = *(const LAS f32x4*)(EGL + 32 * s2 + 4 * fq), g1 = *(const LAS f32x4*)(EGL + 32 * s2 + 16 + 4 * fq);
                            const float a8[8] = {Vn[2 * s2][0], Vn[2 * s2][1], Vn[2 * s2][2], Vn[2 * s2][3], Vn[2 * s2 + 1][0], Vn[2 * s2 + 1][1], Vn[2 * s2 + 1][2], Vn[2 * s2 + 1][3]};
                            const float b8[8] = {a8[0] * g0[0], a8[1] * g0[1], a8[2] * g0[2], a8[3] * g0[3], a8[4] * g1[0], a8[5] * g1[1], a8[6] * g1[2], a8[7] * g1[3]};
                            const u32x4 pa = pack8(a8), pb2 = pack8(b8); Vnb[s2] = __builtin_bit_cast(pg8::bf16x8, pa); Vsb[s2] = __builtin_bit_cast(pg8::bf16x8, pb2); }
                        const float cd = EG[63];
#pragma unroll
                        for (int t = 0; t < 8; ++t) { Sacc[t] = Sacc[t] * cd;
#pragma unroll
                            for (int s2 = 0; s2 < 2; ++s2) Sacc[t] = __builtin_amdgcn_mfma_f32_16x16x32_bf16(FB[t * 2 + s2], Vsb[s2], Sacc[t], 0, 0, 0); }
                        SB(); LDF(FC, 57344, 8); SB();
                        f32x4 QS[4];
#pragma unroll
                        for (int mt = 0; mt < 4; ++mt) { QS[mt] = (f32x4){0.f, 0.f, 0.f, 0.f};
#pragma unroll
                            for (int s = 0; s < 4; ++s) QS[mt] = __builtin_amdgcn_mfma_f32_16x16x32_bf16(FA[mt * 4 + s], Sb[s], QS[mt], 0, 0, 0); }
#pragma unroll
                        for (int mt = 0; mt < 4; ++mt) { const f32x4 eg = *(const LAS f32x4*)(EG + 16 * mt + 4 * fq); f32x4 o = QS[mt] * eg * 0.08838834764831845f;
#pragma unroll
                            for (int s2 = 0; s2 < 2; ++s2) o = __builtin_amdgcn_mfma_f32_16x16x32_bf16(FC[mt * 2 + s2], Vnb[s2], o, 0, 0, 0);
                            float* op = ((sub & 128) ? (float*)(ws + WS_MACC) : ORAW) + (size_t)(row0 + 16 * mt + 4 * fq) * D + hv * 64 + 16 * w + fr;
#pragma unroll
                            for (int r = 0; r < 4; ++r) op[(size_t)r * D] = o[r]; }
#undef LDF
#undef SB
                    }
                }
            }
            __syncthreads();
            {
                typedef fox::BlockRef<fox::TIN, fox::TOUT> BR;
                const fox::TIN *FQp = (const fox::TIN*)(T + TI_FQ * ACT_E), *FKp = (const fox::TIN*)(T + TI_FK * ACT_E), *FVp = (const fox::TIN*)(T + TI_FV * ACT_E); fox::TOUT* Op = (fox::TOUT*)YC;
                const char* FKB = (const char*)(ws + WS_FKB); const char* Z16 = (const char*)(ws + 256);
                const int bh = blk >> 2, xq = blk & 3, b = bh >> 4, h = bh & 15;
                if (blk < 256 && (sub & 2)) {
#define FOX_REF(r, qb) do { const size_t row0 = (size_t)b * SEQ + (size_t)(qb) * 256; (r).Q = FQp + row0 * D + h * 128; (r).K = FKp + (size_t)b * SEQ * D + h * 128; (r).V = FVp + (size_t)b * SEQ * D + h * 128; \
                    (r).O = Op + row0 * D + h * 128; (r).FK = FKB + (size_t)bh * SEQ * 16; (r).Z16 = Z16; (r).P0 = (qb) * 256; } while (0)
                    BR cur, nxt; FOX_REF(cur, xq); FOX_REF(nxt, 7 - xq);
                    fox::Seam<fox::TIN> S;
                    fox::causal_swa_prime<fox::TIN, fox::TOUT>(cur, SEQ, (char*)lds_raw, S);
                    for (int pass = 0; pass < 2; ++pass) {
                        fox::causal_swa_block<fox::TIN, fox::TOUT>(cur, nxt, SEQ, SEQ, (char*)lds_raw, S);
                        cur = nxt;
                    }
#undef FOX_REF
                }
            }
        }
        SEAM(pb + 3);
        if (IN(pb + 4)) { PH_BEGIN LAYER_PTRS
            const float* nw = AIN(I_GNORMW) + l * 64; const bf16* GZ = T + TI_GZ * ACT_E;
            float nwv[8];
#pragma unroll
            for (int i = 0; i < 8; ++i) nwv[i] = nw[(lane & 7) * 8 + i];
            for (int it = gw; it < M * 4; it += NGW) { const size_t o = (size_t)(it >> 2) * D + (it & 3) * 512 + lane * 8;
                const f32x4 a = *(const f32x4*)(ORAW + o), b = *(const f32x4*)(ORAW + o + 4); float ov[8] = {a[0], a[1], a[2], a[3], b[0], b[1], b[2], b[3]}, z[8], y[8]; float ss = 0.f;
#pragma unroll
                for (int i = 0; i < 8; ++i) ss += ov[i] * ov[i];
                ss += __shfl_xor(ss, 1); ss += __shfl_xor(ss, 2); ss += __shfl_xor(ss, 4);
                const float rn = __builtin_amdgcn_rsqf(ss * (1.f / 64.f) + NORM_EPS); unpack8(*(const u32x4*)(GZ + o), z);
#pragma unroll
                for (int i = 0; i < 8; ++i) y[i] = ov[i] * rn * nwv[i] * fsilu(z[i]);
                *(u32x4*)(YB + o) = pack8(y); }
        }
        SEAM(pb + 4);
        if (IN(pb + 5)) { PH_BEGIN LAYER_PTRS
            pg8::StaticOrder S; S.init(M, D, G, blk);
            { pg8::Gemm g{YA, (const bf16*)(wl + W_A), M, D, D}; pg8::EpiMerge<0> E{T + TI_MA * ACT_E, MACC, MG}; pg8::gemm_phase<pg8::EpiMerge<0>, pg8::StaticOrder, true, true>(lds, g, S, E); }
            { pg8::Gemm g{YB, (const bf16*)(wl + W_B), M, D, D}; pg8::EpiMerge<1> E{T + TI_MB * ACT_E, MACC, MG}; pg8::gemm_phase<pg8::EpiMerge<1>, pg8::StaticOrder, true, true>(lds, g, S, E); }
            { pg8::Gemm g{YC, (const bf16*)(wl + W_C), M, D, D}; pg8::EpiMerge<2> E{T + TI_MC * ACT_E, MACC, MG}; pg8::gemm_phase<pg8::EpiMerge<2>, pg8::StaticOrder, true, true>(lds, g, S, E); }
        }
        SEAM(pb + 5);
        if (IN(pb + 6)) { PH_BEGIN LAYER_PTRS
            pg8::Gemm g{MG, (const bf16*)(wl + W_O), M, D, D}; pg8::StaticOrder S; S.init(M, D, G, blk);
            pg8::EpiResid E{Xin, modl + 2 * D, PRE, ALPHA};
            pg8::gemm_phase<pg8::EpiResid, pg8::StaticOrder, true, true>(lds, g, S, E);
        }
        SEAM(pb + 6);
        if (IN(pb + 7)) { PH_BEGIN LAYER_PTRS
            const float* g1 = AIN(I_LN1G) + (size_t)l * D; const float* b1 = AIN(I_LN1B) + (size_t)l * D;
            for (int m = gw; m < M; m += NGW) { const float* mb = modl + (size_t)(m >> 11) * MODW; ln_mod_row(PRE + (size_t)m * D, g1, b1, X + (size_t)m * D, U + (size_t)m * D, mb + 3 * D, mb + 4 * D, lane); }
        }
        SEAM(pb + 7);
        if (IN(pb + 8)) { PH_BEGIN LAYER_PTRS
            pg8::Gemm g{U, (const bf16*)(wl + W_1), M, FF, D}; pg8::StaticOrder S; S.init(M, FF, G, blk);
            pg8::EpiRelu2 E{H, FF};
            pg8::gemm_phase<pg8::EpiRelu2, pg8::StaticOrder, true, true>(lds, g, S, E);
        }
        SEAM(pb + 8);
        if (IN(pb + 9)) { PH_BEGIN LAYER_PTRS
            pg8::Gemm g{H, (const bf16*)(wl + W_2), M, D, FF}; pg8::StaticOrder S; S.init(M, D, G, blk);
            pg8::EpiResid E{X, modl + 5 * D, PRE, ALPHA};
            pg8::gemm_phase<pg8::EpiResid, pg8::StaticOrder, true, true>(lds, g, S, E);
        }
        SEAM(pb + 9);
        if (IN(pb + 10)) { PH_BEGIN LAYER_PTRS
            const float* g2 = AIN(I_LN2G) + (size_t)l * D; const float* b2 = AIN(I_LN2B) + (size_t)l * D; const bool last = (l == DEPTH - 1);
            float* xo = last ? ((float*)(GAS float*)ap->out) : X; const float* modn = mod + (size_t)(last ? l : l + 1) * 4 * MODW;
            for (int m = gw; m < M; m += NGW) { const float* mb = modn + (size_t)(m >> 11) * MODW; ln_mod_row(PRE + (size_t)m * D, g2, b2, xo + (size_t)m * D, last ? (bf16*)nullptr : U + (size_t)m * D, mb, mb + D, lane); }
        }
        SEAM(pb + 10);
}

__global__ void __launch_bounds__(NT, 2) fwd_kernel(Args args) {
    extern __shared__ __attribute__((aligned(16))) unsigned char lds_raw[];
    LAS unsigned char* lds = (LAS unsigned char*)lds_raw;
    const int G = gridDim.x, blk = blockIdx.x, NGW = G * NWAVES, NGT = G * NT;
    volatile LAS unsigned* MISC = (volatile LAS unsigned*)(lds + MISC_OFF);
    if (threadIdx.x < 128) ((LAS unsigned*)(lds + MISC_OFF))[threadIdx.x] = 0u;
    __syncthreads();
    XcdBarrier bar = xcd_barrier_post((unsigned*)((gu32*)(args.ws + WS_CTL) + CW_BAR), MISC + 8);
    const int lo = args.ph_lo, hi = args.ph_hi;
    if (IN(0)) { PH_BEGIN
        LAS f32x4* ca = (LAS f32x4*)lds;
        const float* c = AIN(I_C);
        for (int k = tid; k < D; k += NT) { f32x4 v; for (int b = 0; b < 4; ++b) { const float cv = c[b * D + k]; v[b] = cv / (1.f + expf(-cv)); } ca[k] = v; }
        __syncthreads();
        const float* w_ada = AIN(I_WADA);
        for (int it = gw; it < 1536; it += NGW) {
            const int l = it / 768, r = it % 768, jblk = r >> 4, kc = r & 15;
            const float* W = w_ada + ((size_t)(l * D + kc * 128)) * MODW + jblk * 256 + lane * 4;
            f32x4 a0 = {0.f, 0.f, 0.f, 0.f}, a1 = a0, a2 = a0, a3 = a0;
#pragma unroll 8
            for (int k = 0; k < 128; ++k) { const f32x4 w = *(const f32x4*)(W + (size_t)k * MODW); const f32x4 cv = ca[kc * 128 + k]; a0 += w * cv[0]; a1 += w * cv[1]; a2 += w * cv[2]; a3 += w * cv[3]; }
            float* P = modp + ((size_t)((l * 16 + kc) * 4)) * MODW + jblk * 256 + lane * 4;
            *(f32x4*)(P) = a0; *(f32x4*)(P + MODW) = a1; *(f32x4*)(P + 2 * MODW) = a2; *(f32x4*)(P + 3 * MODW) = a3;
        }
    }
    SEAM(0);
    if (IN(1)) { PH_BEGIN
        const float* b_ada = AIN(I_BADA);
        for (int i = gtid; i < DEPTH * 4 * MODW; i += NGT) { const int l = i / (4 * MODW), r = i % (4 * MODW), b = r / MODW, j = r % MODW; float s = b_ada[l * MODW + j];
            for (int kc = 0; kc < 16; ++kc) s += modp[((size_t)((l * 16 + kc) * 4 + b)) * MODW + j];
            mod[i] = s; }
        constexpr int I_IN = 13 * 32 * 64, I_TAIL = 96, I_SQ = 4 * 32 * 64, I_F1 = 32 * 256, I_F2 = 128 * 64, I_L = I_IN + I_TAIL + I_SQ + I_F1 + I_F2;
        for (int it = gw; it < DEPTH * I_L; it += NGW) {
            const int l = it / I_L; int r = it % I_L; unsigned char* wl = ws + WS_W + (size_t)l * W_LAYER;
            if (r < I_IN) { const int t = r >> 11, q = r & 2047; tr_item(AIN(I_WIN) + (size_t)l * D * INW + src_off(t), INW, (bf16*)(wl + W_IN) + (size_t)t * D * D, D, q >> 6, q & 63, lane); continue; } r -= I_IN;
            if (r < I_TAIL) { const int nb = r >> 5, kb = r & 31; tr_item(AIN(I_WIN) + (size_t)l * D * INW + (nb < 2 ? SRC_GB + 32 * nb : SRC_FF), INW, (bf16*)(wl + W_IN) + (size_t)(13 * D + 32 * nb) * D, D, kb, 0, lane); continue; } r -= I_TAIL;
            if (r < I_SQ) { const int t = r >> 11, q = r & 2047; tr_item((t == 0 ? AIN(I_WA) : t == 1 ? AIN(I_WB) : t == 2 ? AIN(I_WC) : AIN(I_WO)) + (size_t)l * D * D, D, (bf16*)(wl + W_A + (size_t)t * 8 * MiB), D, q >> 6, q & 63, lane); continue; } r -= I_SQ;
            if (r < I_F1) { tr_item(AIN(I_W1) + (size_t)l * D * FF, FF, (bf16*)(wl + W_1), D, r >> 8, r & 255, lane); continue; } r -= I_F1;
            tr_item(AIN(I_W2) + (size_t)l * FF * D, D, (bf16*)(wl + W_2), FF, r >> 6, r & 63, lane);
        }
        for (int i = gtid; i < DEPTH * 160 * (D / 8); i += NGT) { const int l = i / (160 * 256), r = i % (160 * 256); bf16* p = (bf16*)(ws + WS_W + (size_t)l * W_LAYER + W_IN) + (size_t)(13 * D + 96 + (r >> 8)) * D + (r & 255) * 8;
            *(u32x4*)p = (u32x4){0u, 0u, 0u, 0u}; }
    }
    SEAM(1);
    if (IN(2)) { PH_BEGIN
        for (int m = gw; m < M; m += NGW) { const float* mb = mod + (size_t)(m >> 11) * MODW; modulate_row(x_in + (size_t)m * D, U + (size_t)m * D, mb, mb + D, lane); }
    }
    SEAM(2);

    layer_phases<0>(lo, hi, bar, lds, lds_raw, blk, G, NGW, NGT);
    layer_phases<1>(lo, hi, bar, lds, lds_raw, blk, G, NGW, NGT);
#undef IN
#undef SEAM
}

#ifndef MK_ONE_LAUNCH
#define MK_ONE_LAUNCH 0
#endif
#ifndef PROBE_LAYER_MASK
#define PROBE_LAYER_MASK 0
#endif
#ifndef PROBE_PRO_MASK
#define PROBE_PRO_MASK 0
#endif
#ifndef PROBE_SUB
#define PROBE_SUB 15
#endif
extern "C" void kernel_launch(void* const* d_in, const int* in_sizes, int n_in, void* d_out, int out_size, void* d_ws, size_t ws_size, hipStream_t stream) {
    static int grid = 0;
    if (grid == 0) {
        if (n_in != N_IN || out_size != M * D || ws_size < WS_END) { fprintf(stderr, "kernel_launch: unexpected shapes: n_in %d out %d ws %zu (need %zu)\n", n_in, out_size, ws_size, (size_t)WS_END); grid = -1; return; }
        int dev = 0, cus = 0, per_cu = 0;
        if (hipGetDevice(&dev) != hipSuccess || hipDeviceGetAttribute(&cus, hipDeviceAttributeMultiprocessorCount, dev) != hipSuccess) { grid = -1; return; }
        if (hipFuncSetAttribute((const void*)fwd_kernel, hipFuncAttributeMaxDynamicSharedMemorySize, LDS_BYTES) != hipSuccess) { fprintf(stderr, "kernel_launch: hipFuncSetAttribute failed\n"); grid = -1; return; }
        if (hipOccupancyMaxActiveBlocksPerMultiprocessor(&per_cu, (const void*)fwd_kernel, NT, LDS_BYTES) != hipSuccess || per_cu < 1) fprintf(stderr, "kernel_launch: occupancy query says %d\n", per_cu);
        (void)hipGetLastError();
        grid = cus;
        if (grid != 256) fprintf(stderr, "kernel_launch: %d CUs (built for 256)\n", grid);
    }
    if (grid < 0) return;
    (void)hipMemsetAsync((char*)d_ws + WS_CTL, 0, CTL_ZERO_BYTES, stream);
    Args a{};
    for (int i = 0; i < N_IN; ++i) a.in[i] = (const float*)d_in[i];
    a.out = (float*)d_out; a.ws = (unsigned char*)d_ws; a.sub = 15; a.pad = 0;
#if MK_ONE_LAUNCH
    a.ph_lo = 0; a.ph_hi = NPH;
    hipLaunchKernelGGL(fwd_kernel, dim3(grid), dim3(NT), LDS_BYTES, stream, a);
#else
    for (int p = 0; p < NPH; ++p) { a.ph_lo = p; a.ph_hi = p + 1; const int k = p < 3 ? -1 : (p - 3) % NPL;
        const int reps = (p < 3 ? ((PROBE_PRO_MASK >> p) & 1) : ((PROBE_LAYER_MASK >> k) & 1)) ? 2 : 1;
        for (int r = 0; r < reps; ++r) { a.sub = (r == 1) ? PROBE_SUB : 15; hipLaunchKernelGGL(fwd_kernel, dim3(grid), dim3(NT), LDS_BYTES, stream, a); } }
#endif
}
```
